# Optimizing an MI355X kernel written in HIP

```python
import jax, jax.numpy as jnp
from jax import lax
import numpy as np

D_MODEL = 1024
BATCH = 2
SEQ = 8192
DEPTH = 1

D_MIX = D_MODEL
D_CONV = D_MIX // 2
D_ATTN = D_MIX - D_CONV
HEAD_DIM = 64
N_HEADS = D_ATTN // HEAD_DIM
CONV_KERNEL = 31
DILATED_BRANCHES = ((128, 1), (512, 4), (2048, 16))
ROPE_THETA = 10000.0
N_EXPERTS = 32
TOP_K = 4
D_FF = D_MODEL
SWIGLU_LIMIT = 7.0
SWIGLU_ALPHA = 1.702
EXPERT_BLOCK = 128
LN_EPS = 1e-5
DEEPNORM_ALPHA = float((2 * DEPTH) ** 0.25)
DEEPNORM_BETA = float((8 * DEPTH) ** -0.25)
D_IN_PROJ = 2 * D_CONV + 3 * D_ATTN

kernel_name = "hymba_conformer_dilated_moe_deepnorm"


def layer_norm(x, g, b):
    xf = x.astype(jnp.float32)
    mu = jnp.mean(xf, axis=-1, keepdims=True)
    var = jnp.mean(jnp.square(xf - mu), axis=-1, keepdims=True)
    y = (xf - mu) * lax.rsqrt(var + LN_EPS) * g.astype(jnp.float32) + b.astype(jnp.float32)
    return y.astype(x.dtype)


def rope(t, positions):
    e = t.shape[-1]
    inv_freq = ROPE_THETA ** (-jnp.arange(0, e, 2, dtype=jnp.float32) / e)
    ang = positions.astype(jnp.float32)[..., None] * inv_freq
    cos = jnp.concatenate([jnp.cos(ang), jnp.cos(ang)], axis=-1)[:, :, None, :]
    sin = jnp.concatenate([jnp.sin(ang), jnp.sin(ang)], axis=-1)[:, :, None, :]
    t1, t2 = jnp.split(t.astype(jnp.float32), 2, axis=-1)
    rot = jnp.concatenate([-t2, t1], axis=-1)
    return (t.astype(jnp.float32) * cos + rot * sin).astype(t.dtype)


def dilated_branch(q, k, v, window, dilation):
    b, s, h, e = q.shape
    w = window // dilation
    sub_len = s // dilation
    n_blk = -(-sub_len // w)
    pad_len = n_blk * w

    def to_sub(t):
        t = t.reshape(b, sub_len, dilation, h, e).transpose(0, 2, 3, 1, 4)
        t = jnp.pad(t, ((0, 0), (0, 0), (0, 0), (0, pad_len - sub_len), (0, 0)))
        return t.reshape(b, dilation, h, n_blk, w, e)

    def with_prev(t):
        prev = jnp.pad(t, ((0, 0), (0, 0), (0, 0), (1, 0), (0, 0), (0, 0)))[:, :, :, :-1]
        return jnp.concatenate([prev, t], axis=4)

    qs = to_sub(q)
    kb = with_prev(to_sub(k))
    vb = with_prev(to_sub(v))
    scale = 1.0 / np.sqrt(e)
    scores = jnp.einsum('brhnqe,brhnke->brhnqk', qs.astype(jnp.float32),
                        kb.astype(jnp.float32)) * scale
    qi = jnp.arange(w)[:, None]
    ki = jnp.arange(2 * w)[None, :]
    rel = qi + w - ki
    band = (rel >= 0) & (rel <= w)
    blk = jnp.arange(n_blk)[:, None, None]
    mask = band[None] & ((blk > 0) | (ki[None] >= w))
    scores = jnp.where(mask, scores, -jnp.inf)
    m = jnp.max(scores, axis=-1, keepdims=True)
    p = jnp.exp(scores - m)
    den = jnp.sum(p, axis=-1)
    o = jnp.einsum('brhnqk,brhnke->brhnqe', p, vb.astype(jnp.float32)) / den[..., None]
    lse = m[..., 0] + jnp.log(den)
    o = o.reshape(b, dilation, h, pad_len, e)[:, :, :, :sub_len]
    o = o.transpose(0, 3, 1, 2, 4).reshape(b, s, h, e)
    lse = lse.reshape(b, dilation, h, pad_len)[..., :sub_len]
    lse = lse.transpose(0, 3, 1, 2).reshape(b, s, h)
    return o, lse


def hybrid_mixer(x, positions, w_in, conv_w, conv_b, conv_ln_g, conv_ln_b,
                 conv_pw_w, conv_pw_b, w_out):
    b, s, _ = x.shape
    proj = x @ w_in
    splits = np.cumsum([D_CONV, D_CONV, D_ATTN, D_ATTN])
    a, gt, q, k, v = jnp.split(proj, splits, axis=-1)

    u = a * jax.nn.sigmoid(gt)
    u = lax.conv_general_dilated(
        u, conv_w[:, None, :], window_strides=(1,),
        padding=[(CONV_KERNEL - 1, 0)],
        dimension_numbers=('NWC', 'WIO', 'NWC'),
        feature_group_count=D_CONV) + conv_b
    u = jax.nn.silu(layer_norm(u, conv_ln_g, conv_ln_b))
    conv_out = u @ conv_pw_w + conv_pw_b

    q = rope(q.reshape(b, s, N_HEADS, HEAD_DIM), positions)
    k = rope(k.reshape(b, s, N_HEADS, HEAD_DIM), positions)
    v = v.reshape(b, s, N_HEADS, HEAD_DIM)
    outs = []
    lses = []
    for window, dilation in DILATED_BRANCHES:
        o, l = dilated_branch(q, k, v, window, dilation)
        outs.append(o)
        lses.append(l)
    wts = jax.nn.softmax(jnp.stack(lses, axis=0), axis=0)
    attn = jnp.sum(jnp.stack(outs, axis=0) * wts[..., None], axis=0)
    attn_out = attn.reshape(b, s, D_ATTN).astype(x.dtype)

    return jnp.concatenate([conv_out, attn_out], axis=-1) @ w_out


def moe_ffn(x, router_w, router_b, w_gate, b_gate, w_up, b_up, w_down, b_down):
    b, s, dm = x.shape
    xt = x.reshape(-1, dm)
    n_tok = xt.shape[0]
    logits = (xt @ router_w + router_b).astype(jnp.float32)
    top_logit, top_idx = lax.top_k(logits, TOP_K)
    gate = jax.nn.softmax(top_logit, axis=-1)

    n_assign = n_tok * TOP_K
    flat_e = top_idx.reshape(-1)
    flat_tok = jnp.repeat(jnp.arange(n_tok, dtype=jnp.int32), TOP_K)
    flat_g = gate.reshape(-1)
    order = jnp.argsort(flat_e, stable=True)
    sorted_e = flat_e[order]
    counts = jnp.bincount(flat_e, length=N_EXPERTS)
    padded = (counts + EXPERT_BLOCK - 1) // EXPERT_BLOCK * EXPERT_BLOCK
    starts = jnp.cumsum(counts) - counts
    pends = jnp.cumsum(padded)
    pstarts = pends - padded
    dest = pstarts[sorted_e] + (jnp.arange(n_assign) - starts[sorted_e])
    n_rows = (-(-n_assign // EXPERT_BLOCK)) * EXPERT_BLOCK + N_EXPERTS * EXPERT_BLOCK
    n_blocks = n_rows // EXPERT_BLOCK
    buf_tok = jnp.zeros((n_rows,), jnp.int32).at[dest].set(flat_tok[order])
    buf_g = jnp.zeros((n_rows,), jnp.float32).at[dest].set(flat_g[order])
    blk_expert = jnp.minimum(
        jnp.searchsorted(pends, jnp.arange(n_blocks) * EXPERT_BLOCK, side='right'),
        N_EXPERTS - 1)
    xs = xt[buf_tok].reshape(n_blocks, EXPERT_BLOCK, dm)

    def expert_block(args):
        xb, e = args
        g = xb @ w_gate[e] + b_gate[e]
        u = xb @ w_up[e] + b_up[e]
        g = jnp.minimum(g, SWIGLU_LIMIT)
        u = jnp.clip(u, -SWIGLU_LIMIT, SWIGLU_LIMIT)
        hdn = (u + 1.0) * g * jax.nn.sigmoid(SWIGLU_ALPHA * g)
        return hdn @ w_down[e] + b_down[e]

    ys = lax.map(expert_block, (xs, blk_expert)).reshape(n_rows, dm)
    ys = ys.astype(jnp.float32) * buf_g[:, None]
    out = jnp.zeros((n_tok, dm), jnp.float32).at[buf_tok].add(ys)
    return out.astype(x.dtype).reshape(b, s, dm)


def setup_inputs(seed: int = 0) -> dict:
    key = jax.random.key(seed)
    ks = jax.random.split(key, 24)

    def nrm(k, shape, scale):
        return jax.random.normal(k, shape, jnp.float32) * scale

    L = DEPTH
    w_in = nrm(ks[2], (L, D_MODEL, D_IN_PROJ), D_MODEL ** -0.5)
    v_scale = jnp.concatenate([jnp.ones((D_IN_PROJ - D_ATTN,), jnp.float32),
                               jnp.full((D_ATTN,), DEEPNORM_BETA, jnp.float32)])
    w_in = w_in * v_scale
    positions = jnp.broadcast_to(jnp.arange(SEQ, dtype=jnp.int32), (BATCH, SEQ))
    return {
        "x": nrm(ks[0], (BATCH, SEQ, D_MODEL), 1.0),
        "positions": positions,
        "w_in": w_in,
        "conv_w": nrm(ks[3], (L, CONV_KERNEL, D_CONV), CONV_KERNEL ** -0.5),
        "conv_b": nrm(ks[4], (L, D_CONV), 0.02),
        "conv_ln_g": 1.0 + nrm(ks[5], (L, D_CONV), 0.02),
        "conv_ln_b": nrm(ks[6], (L, D_CONV), 0.02),
        "conv_pw_w": nrm(ks[7], (L, D_CONV, D_CONV), D_CONV ** -0.5 * DEEPNORM_BETA),
        "conv_pw_b": nrm(ks[8], (L, D_CONV), 0.02),
        "w_out": nrm(ks[9], (L, D_MIX, D_MODEL), D_MIX ** -0.5 * DEEPNORM_BETA),
        "ln1_g": 1.0 + nrm(ks[10], (L, D_MODEL), 0.02),
        "ln1_b": nrm(ks[11], (L, D_MODEL), 0.02),
        "router_w": nrm(ks[12], (L, D_MODEL, N_EXPERTS), D_MODEL ** -0.5),
        "router_b": nrm(ks[13], (L, N_EXPERTS), 0.01),
        "exp_w_gate": nrm(ks[14], (L, N_EXPERTS, D_MODEL, D_FF), D_MODEL ** -0.5),
        "exp_b_gate": nrm(ks[15], (L, N_EXPERTS, D_FF), 0.02),
        "exp_w_up": nrm(ks[16], (L, N_EXPERTS, D_MODEL, D_FF), D_MODEL ** -0.5),
        "exp_b_up": nrm(ks[17], (L, N_EXPERTS, D_FF), 0.02),
        "exp_w_down": nrm(ks[18], (L, N_EXPERTS, D_FF, D_MODEL), D_FF ** -0.5 * DEEPNORM_BETA),
        "exp_b_down": nrm(ks[19], (L, N_EXPERTS, D_MODEL), 0.02),
        "ln2_g": 1.0 + nrm(ks[20], (L, D_MODEL), 0.02),
        "ln2_b": nrm(ks[21], (L, D_MODEL), 0.02),
    }


def reference(x, positions, w_in, conv_w, conv_b, conv_ln_g, conv_ln_b, conv_pw_w,
              conv_pw_b, w_out, ln1_g, ln1_b, router_w, router_b, exp_w_gate,
              exp_b_gate, exp_w_up, exp_b_up, exp_w_down, exp_b_down, ln2_g, ln2_b):
    for l in range(DEPTH):
        mix = hybrid_mixer(x, positions, w_in[l], conv_w[l], conv_b[l], conv_ln_g[l],
                           conv_ln_b[l], conv_pw_w[l], conv_pw_b[l], w_out[l])
        x = layer_norm(DEEPNORM_ALPHA * x + mix, ln1_g[l], ln1_b[l])
        ffn = moe_ffn(x, router_w[l], router_b[l], exp_w_gate[l], exp_b_gate[l],
                      exp_w_up[l], exp_b_up[l], exp_w_down[l], exp_b_down[l])
        x = layer_norm(DEEPNORM_ALPHA * x + ffn, ln2_g[l], ln2_b[l])
    return x
```

```cpp
#include <hip/hip_runtime.h>
#include <cstdio>
#include <cstdint>

#define GAS __attribute__((address_space(1)))
#define LAS __attribute__((address_space(3)))
typedef unsigned short bf16_t;
typedef short bf16x8 __attribute__((ext_vector_type(8)));
typedef short s16x4 __attribute__((ext_vector_type(4)));
typedef float f32x4 __attribute__((ext_vector_type(4)));
typedef float f32x2 __attribute__((ext_vector_type(2)));
typedef float f32x16 __attribute__((ext_vector_type(16)));
typedef unsigned u32x4 __attribute__((ext_vector_type(4)));
typedef unsigned u32x2 __attribute__((ext_vector_type(2)));
typedef __bf16 bf16x2_t __attribute__((ext_vector_type(2)));

#ifndef MK_N_LAUNCHES
#define MK_N_LAUNCHES 1
#endif
constexpr int N_LAUNCHES = MK_N_LAUNCHES;
constexpr int PER_PHASE = 9;

constexpr int BATCH = 2, SEQ = 8192, DM = 1024, NTOK = BATCH * SEQ;
constexpr int DCONV = 512, DATT = 512, NHEAD = 8, HD = 64, NPROJ = 2560, CONVK = 31;
constexpr int NEXP = 32, TOPK = 4, DFF = 1024;
constexpr float LN_EPS = 1e-5f;
constexpr float DN_ALPHA = 1.189207115002721f;
constexpr float SWI_LIMIT = 7.0f, SWI_ALPHA = 1.702f;
constexpr float QSCALE = 0.125f * 1.4426950408889634f;
constexpr int MAXSLOT = NTOK * TOPK + NEXP * 256;

constexpr size_t MiB = 1u << 20;
constexpr size_t WS_CTL = 0, CTL_ZERO_BYTES = 1 * MiB;
constexpr size_t WS_TOKE = 1 * MiB;
constexpr size_t WS_TOKG = WS_TOKE + 256 * 1024;
constexpr size_t WS_LIST = 2 * MiB;
constexpr size_t WS_ROPE = 4 * MiB;
constexpr size_t WS_WIN = 8 * MiB;
constexpr size_t WS_WPW = 13 * MiB;
constexpr size_t WS_WOUT = 14 * MiB;
constexpr size_t WS_WD = 16 * MiB;
constexpr size_t WS_WGU = 80 * MiB;
constexpr size_t WS_AO = 208 * MiB;
constexpr size_t WS_Y = 80 * MiB;
constexpr size_t WS_Z = 240 * MiB;
constexpr size_t WS_X1B = 304 * MiB;
constexpr size_t WS_XB = 336 * MiB;
constexpr size_t WS_U = 368 * MiB;
constexpr size_t WS_Q = 384 * MiB, WS_K = 400 * MiB, WS_V = 416 * MiB;
constexpr size_t WS_S = 432 * MiB;
constexpr size_t WS_OB = 448 * MiB;
constexpr size_t WS_LSE = 496 * MiB;
constexpr size_t WS_H = 336 * MiB;
constexpr size_t WS_END = 498 * MiB;
static_assert(WS_Y + (size_t)MAXSLOT * DM * 2 <= WS_Z && WS_H + (size_t)MAXSLOT * DM * 2 <= WS_LSE, "ws overlays");
constexpr int CW_TMO = 0, CW_CODE = 1;
constexpr int CW_GCNT = 64;
constexpr int CW_BAR = 4096;

constexpr int LDS_BYTES = 163840;
constexpr int MISC_OFF = LDS_BYTES - 1024;
constexpr int RING_BYTES = 131072;

#define RLX_AGENT __ATOMIC_RELAXED, __HIP_MEMORY_SCOPE_AGENT
#define LDS_WAIT() asm volatile("s_waitcnt lgkmcnt(0)" ::: "memory")
#define VM_WAIT() asm volatile("s_waitcnt vmcnt(0)" ::: "memory")
typedef GAS unsigned gu32;

__device__ __forceinline__ unsigned cvtpk(float lo, float hi) { f32x2 v = {lo, hi}; bf16x2_t b = __builtin_convertvector(v, bf16x2_t); return __builtin_bit_cast(unsigned, b); }
__device__ __forceinline__ float bf2f(bf16_t h) { return __uint_as_float((unsigned)h << 16); }
__device__ __forceinline__ float bflo(unsigned w) { return __uint_as_float(w << 16); }
__device__ __forceinline__ float bfhi(unsigned w) { return __uint_as_float(w & 0xffff0000u); }
__device__ __forceinline__ float wave_sum(float v) {
#pragma unroll
    for (int o = 1; o < 64; o <<= 1) v += __shfl_xor(v, o);
    return v;
}
__device__ __forceinline__ float fsigmoid(float x) { return __builtin_amdgcn_rcpf(1.0f + __builtin_amdgcn_exp2f(-1.4426950408889634f * x)); }

namespace pg8 {
constexpr int BM = 256, BK = 64, HALF = 128, HTB = HALF * BK * 2, STAGE_BYTES = 8 * HTB, NXCD = 8, WGM = 8;
__host__ __device__ __forceinline__ int lds_byte(int r, int c) { const int st = (r >> 4) * 2 + (c >> 5), rr = r & 15, cc = c & 31, ob = rr * 64 + cc * 2; return st * 1024 + (ob ^ (((ob >> 9) & 1) << 5)); }
__host__ __device__ __forceinline__ void stage_rc(int b, int& R, int& C) { const int st = b / 1024, sb = b % 1024, swz = sb ^ (((sb >> 9) & 1) << 5); R = (st >> 1) * 16 + swz / 64; C = (st & 1) * 32 + (swz % 64) / 2; }
__host__ __device__ __forceinline__ int perm32(int rho) { const int n = rho >> 4, i = rho & 15; return 8 * (i >> 2) + 4 * n + (i & 3); }

struct Unit { int pm, pn, e; };

struct DenseOrder {
    int nM, nN, nwg, G, c, K; const char* Bt;
    __device__ void init(int M, int N, int K_, int G_, int c_, const void* Bt_) { nM = M / BM; nN = N / BM; nwg = nM * nN; G = G_; c = c_; K = K_; Bt = (const char*)Bt_; }
    __device__ __forceinline__ bool next(int i, Unit& u) const {
        const long L = (long)i * G + c; if (L >= nwg) return false;
        int wgid = (int)L; { const int q = nwg / NXCD, r = nwg % NXCD, xcd = wgid % NXCD, off = wgid / NXCD; wgid = (xcd < r ? xcd * (q + 1) : r * (q + 1) + (xcd - r) * q) + off; }
        const int nig = WGM * nN, gid = wgid / nig, fm = gid * WGM, gsz = (nM - fm) < WGM ? (nM - fm) : WGM;
        u.pm = fm + ((wgid % nig) % gsz); u.pn = (wgid % nig) / gsz; u.e = 0; return true;
    }
    __device__ __forceinline__ const char* b_base(const Unit& u) const { return Bt + (size_t)u.pn * BM * K * 2; }
    __device__ __forceinline__ void a_off(const Unit& u, const int (&R)[2], const int (&C)[2], unsigned (&v)[2][2]) const {
#pragma unroll
        for (int h = 0; h < 2; ++h)
#pragma unroll
            for (int i = 0; i < 2; ++i) v[h][i] = (unsigned)((u.pm * BM + h * HALF + R[i]) * K + C[i]) * 2u;
    }
};
struct MoeOrder {
    const volatile LAS int* tp;
    const volatile LAS int* cnt;
    const int* list;
    const char* Bt; int NT, nrowB;
    int vcu, G;
    __device__ __forceinline__ bool next(int i, Unit& u) const {
        const int Ltot = tp[32] * NT, CH = (Ltot + 7) >> 3, per = G >> 3, x = vcu / per, c = vcu % per;
        const int loc = i * per + c; if (loc >= CH) return false;
        const int L = x * CH + loc; if (L >= Ltot) return false;
        int e = 0;
        for (int j = 1; j < 32; ++j) e += (tp[j] * NT <= L) ? 1 : 0;
        const int te = tp[e + 1] - tp[e], q = L - tp[e] * NT;
        u.e = e; u.pn = q / te; u.pm = q % te; return true;
    }
    __device__ __forceinline__ const char* b_base(const Unit& u) const { return Bt + ((size_t)u.e * nrowB + (size_t)u.pn * BM) * DM * 2; }
    __device__ __forceinline__ void a_off(const Unit& u, const int (&R)[2], const int (&C)[2], unsigned (&v)[2][2]) const {
        const int ce = cnt[u.e], p0 = tp[u.e] * BM;
#pragma unroll
        for (int h = 0; h < 2; ++h)
#pragma unroll
            for (int i = 0; i < 2; ++i) {
                const int r = u.pm * BM + h * HALF + R[i];
                int row;
                if (list) { row = 0; if (r < ce) row = list[u.e * NTOK + r]; } else row = p0 + r;
                v[h][i] = (unsigned)(row * DM + C[i]) * 2u;
            }
    }
};

template <class Epi, class Sched, bool ALIGN_EPI>
__device__ __forceinline__ void gemm_phase(LAS unsigned char* lds, const void* Abase_, int K, const Sched& S, const Epi& E) {
    const char* Abase = (const char*)Abase_;
    const int tid = threadIdx.x, wid = __builtin_amdgcn_readfirstlane(tid >> 6), lane = tid & 63, wr = wid >> 2, wc = wid & 3, fr = lane & 15, fq = lane >> 4;
    const int nt = K / BK;
    int R[2], C[2]; unsigned voffB[2];
#pragma unroll
    for (int i = 0; i < 2; ++i) { stage_rc(tid * 16 + i * 8192, R[i], C[i]); const int Rb = Epi::PERM ? ((R[i] & ~31) + perm32(R[i] & 31)) : R[i]; voffB[i] = (unsigned)(Rb * K + C[i]) * 2u; }
    const size_t kstep = (size_t)(BK * 2);
    const size_t hstep = (size_t)HALF * K * 2;
    const unsigned ldsw = (unsigned)wid * 1024u;
    const int aoff = lds_byte(wr * 64 + fr, fq * 8), boff = lds_byte(wc * 32 + fr, fq * 8);
#define PG8_SA(b, h) (((b) * 2 + (h)) * HTB)
#define PG8_SB(b, h) ((4 + (b) * 2 + (h)) * HTB)
#define PG8_STAGEB(bufoff, gbase) do { _Pragma("unroll") for (int _i = 0; _i < 2; ++_i) \
        __builtin_amdgcn_global_load_lds((const unsigned*)((const char*)(gbase) + voffB[_i]), (LAS unsigned*)(lds + (bufoff) + ldsw + _i * 8192), 16, 0, 0); } while (0)
#define PG8_STAGEA(bufoff, vo, h, kb) do { _Pragma("unroll") for (int _i = 0; _i < 2; ++_i) \
        __builtin_amdgcn_global_load_lds((const unsigned*)(Abase + (size_t)(vo)[h][_i] + (kb)), (LAS unsigned*)(lds + (bufoff) + ldsw + _i * 8192), 16, 0, 0); } while (0)
#define PG8_LDA(dst, b, h) do { _Pragma("unroll") for (int m = 0; m < 4; ++m) _Pragma("unroll") for (int k = 0; k < 2; ++k) dst[m][k] = *(const LAS bf16x8*)(lds + PG8_SA(b, h) + aoff + m * 2048 + k * 1024); } while (0)
#define PG8_LDB(dst, b, h) do { _Pragma("unroll") for (int n = 0; n < 2; ++n) _Pragma("unroll") for (int k = 0; k < 2; ++k) dst[n][k] = *(const LAS bf16x8*)(lds + PG8_SB(b, h) + boff + n * 2048 + k * 1024); } while (0)
#define PG8_MMA(ai, bj, At, Bt) do { __builtin_amdgcn_s_setprio(1); _Pragma("unroll") for (int m = 0; m < 4; ++m) _Pragma("unroll") for (int n = 0; n < 2; ++n) _Pragma("unroll") for (int k = 0; k < 2; ++k) \
        acc[ai][bj][m][n] = __builtin_amdgcn_mfma_f32_16x16x32_bf16(Bt[n][k], At[m][k], acc[ai][bj][m][n], 0, 0, 0); __builtin_amdgcn_s_setprio(0); } while (0)
#define PG8_WAIT_V(n) asm volatile("s_waitcnt vmcnt(" #n ")" ::: "memory")
#define PG8_WAIT_L(n) asm volatile("s_waitcnt lgkmcnt(" #n ")" ::: "memory")
#define PG8_BAR __builtin_amdgcn_s_barrier()
#define PG8_SCHED __builtin_amdgcn_sched_barrier(0)
    Unit cur, nxt; int ui = 0;
    if (!S.next(0, cur)) return;
    f32x4 acc[2][2][4][2];
#pragma unroll
    for (int a = 0; a < 2; ++a)
#pragma unroll
        for (int b = 0; b < 2; ++b)
#pragma unroll
            for (int m = 0; m < 4; ++m)
#pragma unroll
                for (int n = 0; n < 2; ++n) acc[a][b][m][n] = (f32x4){0.f, 0.f, 0.f, 0.f};
    bf16x8 At[4][2], B0[2][2], B1[2][2];
    unsigned vA[2][2], vN[2][2];
    S.a_off(cur, R, C, vA);
    const char* cB = S.b_base(cur);
    PG8_STAGEB(PG8_SB(0, 0), cB); PG8_STAGEB(PG8_SB(0, 1), cB + hstep); PG8_STAGEA(PG8_SA(0, 0), vA, 0, 0); PG8_STAGEA(PG8_SA(0, 1), vA, 1, 0);
    if (wr == 1) PG8_BAR;
    PG8_WAIT_V(2); PG8_BAR;
    PG8_STAGEB(PG8_SB(1, 0), cB + kstep); PG8_STAGEA(PG8_SA(1, 0), vA, 0, kstep); PG8_STAGEB(PG8_SB(1, 1), cB + hstep + kstep);
    PG8_WAIT_V(6); PG8_BAR;
    for (;;) {
        const bool has_next = S.next(ui + 1, nxt);
        const char* nB = cB;
#pragma unroll
        for (int h = 0; h < 2; ++h)
#pragma unroll
            for (int i = 0; i < 2; ++i) vN[h][i] = vA[h][i];
        if (has_next) { S.a_off(nxt, R, C, vN); nB = S.b_base(nxt); }
        for (int t = 0; t < nt; t += 2) {
            const bool last = (t == nt - 2);
            const size_t k1 = (size_t)(t + 1) * kstep;
            const size_t k2 = last ? 0 : (size_t)(t + 2) * kstep, k3 = k2 + kstep;
            const char* b2 = last ? nB : cB + (size_t)(t + 2) * kstep; const char* b3 = b2 + kstep;
            unsigned v2[2][2];
#pragma unroll
            for (int h = 0; h < 2; ++h)
#pragma unroll
                for (int i = 0; i < 2; ++i) v2[h][i] = last ? vN[h][i] : vA[h][i];
            PG8_LDB(B0, 0, 0); PG8_LDB(B1, 0, 1); PG8_SCHED; PG8_LDA(At, 0, 0); PG8_STAGEA(PG8_SA(1, 1), vA, 1, k1);
            PG8_WAIT_V(8); PG8_WAIT_L(0); PG8_BAR; PG8_MMA(0, 0, At, B0); PG8_MMA(0, 1, At, B1); PG8_BAR; PG8_SCHED;
            PG8_LDA(At, 0, 1); PG8_STAGEB(PG8_SB(0, 0), b2); PG8_STAGEB(PG8_SB(0, 1), b2 + hstep); PG8_STAGEA(PG8_SA(0, 0), v2, 0, k2);
            PG8_WAIT_V(8); PG8_WAIT_L(0); PG8_BAR; PG8_MMA(1, 0, At, B0); PG8_MMA(1, 1, At, B1); PG8_BAR; PG8_SCHED;
            PG8_LDB(B0, 1, 0); PG8_LDB(B1, 1, 1); PG8_SCHED; PG8_LDA(At, 1, 0); PG8_STAGEA(PG8_SA(0, 1), v2, 1, k2);
            PG8_WAIT_V(8); PG8_WAIT_L(0); PG8_BAR; PG8_MMA(0, 0, At, B0); PG8_MMA(0, 1, At, B1); PG8_BAR; PG8_SCHED;
            PG8_LDA(At, 1, 1); PG8_STAGEB(PG8_SB(1, 0), b3); PG8_STAGEB(PG8_SB(1, 1), b3 + hstep); PG8_STAGEA(PG8_SA(1, 0), v2, 0, k3);
            PG8_WAIT_V(8); PG8_WAIT_L(0); PG8_BAR; PG8_MMA(1, 0, At, B0); PG8_MMA(1, 1, At, B1); PG8_BAR; PG8_SCHED;
        }
        if constexpr (ALIGN_EPI) { if (wr == 0) PG8_BAR; }
        E(acc, cur, wr, wc, fr, fq);
        if (!has_next) break;
#pragma unroll
        for (int a = 0; a < 2; ++a)
#pragma unroll
            for (int b = 0; b < 2; ++b)
#pragma unroll
                for (int m = 0; m < 4; ++m)
#pragma unroll
                    for (int n = 0; n < 2; ++n) acc[a][b][m][n] = (f32x4){0.f, 0.f, 0.f, 0.f};
        cur = nxt; cB = nB; ++ui;
#pragma unroll
        for (int h = 0; h < 2; ++h)
#pragma unroll
            for (int i = 0; i < 2; ++i) vA[h][i] = vN[h][i];
        if constexpr (ALIGN_EPI) { if (wr == 1) PG8_BAR; }
    }
    PG8_WAIT_V(0);
    if constexpr (!ALIGN_EPI) { if (wr == 0) PG8_BAR; }
    PG8_BAR;
#undef PG8_SA
#undef PG8_SB
#undef PG8_STAGEA
#undef PG8_STAGEB
#undef PG8_LDA
#undef PG8_LDB
#undef PG8_MMA
#undef PG8_WAIT_V
#undef PG8_WAIT_L
#undef PG8_BAR
#undef PG8_SCHED
}

typedef const f32x4 (&AccRef)[2][2][4][2];
__device__ __forceinline__ u32x4 pack8(f32x4 a, f32x4 b) { u32x4 w; w.x = cvtpk(a[0], a[1]); w.y = cvtpk(a[2], a[3]); w.z = cvtpk(b[0], b[1]); w.w = cvtpk(b[2], b[3]); return w; }

struct EpiInProj {
    static constexpr bool PERM = true;
    bf16_t *U, *Q, *Kb, *V; const float* rope;
    __device__ __forceinline__ void operator()(AccRef acc, const Unit& u, int wr, int wc, int fr, int fq) const {
        const int row0 = u.pm * BM + wr * 64 + fr;
        if (u.pn < 4) {
#pragma unroll
            for (int ai = 0; ai < 2; ++ai)
#pragma unroll
                for (int m = 0; m < 4; ++m) { const int row = row0 + ai * HALF + m * 16; f32x4 o[2];
#pragma unroll
                    for (int n = 0; n < 2; ++n)
#pragma unroll
                        for (int i = 0; i < 4; ++i) o[n][i] = acc[ai][0][m][n][i] * fsigmoid(acc[ai][1][m][n][i]);
                    *(u32x4*)(U + (size_t)row * DCONV + u.pn * 128 + wc * 32 + 8 * fq) = pack8(o[0], o[1]); }
        } else if (u.pn < 8) {
            const bool isq = u.pn < 6; bf16_t* dst = isq ? Q : Kb; const float sc = isq ? QSCALE : 1.0f;
            const int head = 4 * (u.pn & 1) + wc;
#pragma unroll
            for (int ai = 0; ai < 2; ++ai)
#pragma unroll
                for (int m = 0; m < 4; ++m) { const int row = row0 + ai * HALF + m * 16; f32x4 lo[2], hi[2];
#pragma unroll
                    for (int n = 0; n < 2; ++n) { const f32x4 cs = *(const f32x4*)(rope + (size_t)row * 32 + 8 * fq + 4 * n), sn = *(const f32x4*)(rope + (size_t)NTOK * 32 + (size_t)row * 32 + 8 * fq + 4 * n);
                        const f32x4 a = acc[ai][0][m][n], b = acc[ai][1][m][n];
                        lo[n] = (a * cs - b * sn) * sc; hi[n] = (b * cs + a * sn) * sc; }
                    bf16_t* p = dst + (size_t)row * DATT + head * 64 + 8 * fq;
                    *(u32x4*)p = pack8(lo[0], lo[1]); *(u32x4*)(p + 32) = pack8(hi[0], hi[1]); }
        } else {
#pragma unroll
            for (int ai = 0; ai < 2; ++ai)
#pragma unroll
                for (int m = 0; m < 4; ++m) { const int row = row0 + ai * HALF + m * 16;
#pragma unroll
                    for (int bj = 0; bj < 2; ++bj) *(u32x4*)(V + (size_t)row * DATT + (u.pn - 8) * 256 + bj * 128 + wc * 32 + 8 * fq) = pack8(acc[ai][bj][m][0], acc[ai][bj][m][1]); }
        }
    }
};
struct EpiBiasBf16 {
    static constexpr bool PERM = true;
    bf16_t* O; int ldc; const float* bias;
    __device__ __forceinline__ void operator()(AccRef acc, const Unit& u, int wr, int wc, int fr, int fq) const {
        const int row0 = u.pm * BM + wr * 64 + fr, col0 = u.pn * BM + wc * 32 + 8 * fq;
        f32x4 bv[2][2];
#pragma unroll
        for (int bj = 0; bj < 2; ++bj)
#pragma unroll
            for (int n = 0; n < 2; ++n) bv[bj][n] = *(const f32x4*)(bias + col0 + bj * HALF + 4 * n);
#pragma unroll
        for (int ai = 0; ai < 2; ++ai)
#pragma unroll
            for (int m = 0; m < 4; ++m) { bf16_t* rowp = O + (size_t)(row0 + ai * HALF + m * 16) * ldc + col0;
#pragma unroll
                for (int bj = 0; bj < 2; ++bj) *(u32x4*)(rowp + bj * HALF) = pack8(acc[ai][bj][m][0] + bv[bj][0], acc[ai][bj][m][1] + bv[bj][1]); }
    }
};
struct EpiResF32 {
    static constexpr bool PERM = false;
    const float* X; float* Z;
    __device__ __forceinline__ void operator()(AccRef acc, const Unit& u, int wr, int wc, int fr, int fq) const {
        const int row0 = u.pm * BM + wr * 64 + fr, col0 = u.pn * BM + wc * 32 + 4 * fq;
#pragma unroll
        for (int ai = 0; ai < 2; ++ai)
#pragma unroll
            for (int m = 0; m < 4; ++m) { const size_t off = (size_t)(row0 + ai * HALF + m * 16) * DM + col0;
#pragma unroll
                for (int bj = 0; bj < 2; ++bj)
#pragma unroll
                    for (int n = 0; n < 2; ++n) { const f32x4 xv = *(const f32x4*)(X + off + bj * HALF + n * 16); *(f32x4*)(Z + off + bj * HALF + n * 16) = xv * DN_ALPHA + acc[ai][bj][m][n]; }
                if (m & 1) asm volatile("" ::: "memory"); }
    }
};
struct EpiSwiglu {
    static constexpr bool PERM = true;
    bf16_t* H; const float *bg, *bu; const volatile LAS int* tp;
    __device__ __forceinline__ void operator()(AccRef acc, const Unit& u, int wr, int wc, int fr, int fq) const {
        const int row0 = tp[u.e] * BM + u.pm * BM + wr * 64 + fr, col0 = u.pn * 128 + wc * 32 + 8 * fq;
        f32x4 g4[2], u4[2];
#pragma unroll
        for (int n = 0; n < 2; ++n) { g4[n] = *(const f32x4*)(bg + (size_t)u.e * DFF + col0 + 4 * n); u4[n] = *(const f32x4*)(bu + (size_t)u.e * DFF + col0 + 4 * n); }
#pragma unroll
        for (int ai = 0; ai < 2; ++ai)
#pragma unroll
            for (int m = 0; m < 4; ++m) { f32x4 o[2];
#pragma unroll
                for (int n = 0; n < 2; ++n)
#pragma unroll
                    for (int i = 0; i < 4; ++i) { float g = acc[ai][0][m][n][i] + g4[n][i], up = acc[ai][1][m][n][i] + u4[n][i];
                        g = fminf(g, SWI_LIMIT); up = fminf(fmaxf(up, -SWI_LIMIT), SWI_LIMIT);
                        o[n][i] = (up + 1.0f) * g * fsigmoid(SWI_ALPHA * g); }
                *(u32x4*)(H + (size_t)(row0 + ai * HALF + m * 16) * DFF + col0) = pack8(o[0], o[1]); }
    }
};
struct EpiDown {
    static constexpr bool PERM = true;
    bf16_t* Y; const float* bd; const volatile LAS int* tp;
    __device__ __forceinline__ void operator()(AccRef acc, const Unit& u, int wr, int wc, int fr, int fq) const {
        const int row0 = tp[u.e] * BM + u.pm * BM + wr * 64 + fr, col0 = u.pn * BM + wc * 32 + 8 * fq;
        f32x4 bv[2][2];
#pragma unroll
        for (int bj = 0; bj < 2; ++bj)
#pragma unroll
            for (int n = 0; n < 2; ++n) bv[bj][n] = *(const f32x4*)(bd + (size_t)u.e * DM + col0 + bj * HALF + 4 * n);
#pragma unroll
        for (int ai = 0; ai < 2; ++ai)
#pragma unroll
            for (int m = 0; m < 4; ++m) { bf16_t* rowp = Y + (size_t)(row0 + ai * HALF + m * 16) * DM + col0;
#pragma unroll
                for (int bj = 0; bj < 2; ++bj) *(u32x4*)(rowp + bj * HALF) = pack8(acc[ai][bj][m][0] + bv[bj][0], acc[ai][bj][m][1] + bv[bj][1]); }
    }
};
}

#define XB_TMO      128
#define XB_XCNT(j)  (256  + 64 * (j))
#define XB_XSUB(j)  (1280 + 64 * (j))
#define XB_XGEN(j)  (2304 + 64 * (j))
#define XB_TOP      3328
#define XB_TOPGEN   3392
#define XCD_BAR_WORDS 3456
#define XB_SPIN_CAP (1u << 18)
__device__ __forceinline__ unsigned xb_ld(unsigned* p)              { return __hip_atomic_load(p, __ATOMIC_RELAXED, __HIP_MEMORY_SCOPE_AGENT); }
__device__ __forceinline__ unsigned xb_add(unsigned* p, unsigned v) { return __hip_atomic_fetch_add(p, v, __ATOMIC_RELAXED, __HIP_MEMORY_SCOPE_AGENT); }
__device__ __forceinline__ unsigned xb_xcc_id() { return (unsigned)__builtin_amdgcn_s_getreg((3 << 11) | 20) & 0xFu; }
#define XB_SPIN(cond, bar) do { unsigned _sp = 0; while (cond) { __builtin_amdgcn_s_sleep(1); \
    if ((++_sp & 255u) == 0u) { if (xb_ld(&(bar)[XB_TMO])) break; if (_sp > XB_SPIN_CAP) { atomicAdd(&(bar)[XB_TMO], 1u); break; } } } } while (0)
struct XcdBarrier { unsigned* bar; unsigned x; volatile LAS unsigned* st; };
__device__ __forceinline__ XcdBarrier xcd_barrier_post(unsigned* bar, volatile LAS unsigned* st) {
    XcdBarrier b; b.bar = bar; b.x = xb_xcc_id(); b.st = st;
    if (threadIdx.x == 0) (void)xb_add(&bar[XB_XCNT(b.x)], 1u);
    return b;
}
__device__ __forceinline__ void xcd_barrier_complete(unsigned* bar, unsigned x, unsigned& nloc, unsigned& nx) {
    const unsigned G = gridDim.x * gridDim.y * gridDim.z;
    unsigned sum, cnt, mine, sp = 0u;
    for (;;) {
        sum = 0u; cnt = 0u; mine = 0u;
#pragma unroll
        for (unsigned j = 0; j < 16; ++j) { const unsigned c = xb_ld(&bar[XB_XCNT(j)]); sum += c; cnt += (c > 0u) ? 1u : 0u; mine = (j == x) ? c : mine; }
        if (sum == G) break;
        __builtin_amdgcn_s_sleep(1);
        if ((++sp & 255u) == 0u) { if (xb_ld(&bar[XB_TMO])) break; if (sp > XB_SPIN_CAP) { atomicAdd(&bar[XB_TMO], 1u); break; } }
    }
    nloc = mine > 0u ? mine : 1u; nx = cnt > 0u ? cnt : 1u;
}
__device__ __forceinline__ void xcd_barrier(const XcdBarrier& b) {
    asm volatile("s_waitcnt vmcnt(0)" ::: "memory");
    __syncthreads();
    if (threadIdx.x == 0) {
        unsigned* bar = b.bar;
        __builtin_amdgcn_s_waitcnt(0);
        unsigned nloc = b.st[0], nx = b.st[1];
        if (nloc == 0u) { xcd_barrier_complete(bar, b.x, nloc, nx); b.st[0] = nloc; b.st[1] = nx; }
        const unsigned old = xb_add(&bar[XB_XSUB(b.x)], 1u);
        const unsigned gen = old / nloc;
        if (old + 1u == (gen + 1u) * nloc) {
            __builtin_amdgcn_fence(__ATOMIC_RELEASE, "agent");
            asm volatile("s_waitcnt vmcnt(0)" ::: "memory");
            const unsigned og = xb_add(&bar[XB_TOP], 1u);
            const unsigned tg = og / nx;
            if (og + 1u == (tg + 1u) * nx) xb_add(&bar[XB_TOPGEN], 1u);
            else XB_SPIN(xb_ld(&bar[XB_TOPGEN]) == tg, bar);
            __builtin_amdgcn_fence(__ATOMIC_ACQUIRE, "agent");
            xb_add(&bar[XB_XGEN(b.x)], 1u);
            asm volatile("s_waitcnt vmcnt(0)" ::: "memory");
        } else {
            XB_SPIN(xb_ld(&bar[XB_XGEN(b.x)]) == gen, bar);
            __builtin_amdgcn_fence(__ATOMIC_ACQUIRE, "agent");
            asm volatile("s_waitcnt vmcnt(0)" ::: "memory");
        }
    }
    __syncthreads();
}

struct Args { const void* in[22]; float* out; unsigned char* ws; int ph_lo, ph_hi, li, pad; };
struct Frame {
    LAS unsigned char* lds; volatile LAS unsigned* MISC; gu32* ctl;
    int tid, lane, wave, vcu, G;
    unsigned char* ws;
};

template <class RowMap>
__device__ __forceinline__ void tr_item(const float* W, int N, int K, bf16_t* WT, const RowMap& rm, LAS float* scr, int k0, int n0, int lane) {
    const int n4 = lane & 15, kr = lane >> 4;
    f32x4 v[16];
#pragma unroll
    for (int i = 0; i < 16; ++i) v[i] = *(const GAS f32x4*)(W + (size_t)(k0 + kr + 4 * i) * N + n0 + 4 * n4);
#pragma unroll
    for (int i = 0; i < 16; ++i) { LAS float* p = scr + (kr + 4 * i) * 65 + 4 * n4; p[0] = v[i][0]; p[1] = v[i][1]; p[2] = v[i][2]; p[3] = v[i][3]; }
    LDS_WAIT(); asm volatile("" ::: "memory");
    const int c = (lane & 3) + 4 * (lane >> 5), nn = (lane >> 2) & 7;
#pragma unroll
    for (int it = 0; it < 8; ++it) { const int n = nn + 8 * it; const LAS float* s = scr + (8 * c) * 65 + n;
        u32x4 o; o.x = cvtpk(s[0], s[65]); o.y = cvtpk(s[2 * 65], s[3 * 65]); o.z = cvtpk(s[4 * 65], s[5 * 65]); o.w = cvtpk(s[6 * 65], s[7 * 65]);
        *(GAS u32x4*)(WT + (size_t)rm(n0 + n) * K + k0 + 8 * c) = o; }
    LDS_WAIT(); asm volatile("" ::: "memory");
}
struct MapIdent { int off; __device__ __forceinline__ int operator()(int n) const { return off + n; } };
struct MapGateUp { int off; __device__ __forceinline__ int operator()(int n) const { return off + 256 * (n >> 7) + (n & 127); } };
struct MapInProj { __device__ __forceinline__ int operator()(int n) const {
    if (n < 512) return 256 * (n >> 7) + (n & 127);
    if (n < 1024) { const int c = n - 512; return 256 * (c >> 7) + 128 + (c & 127); }
    if (n < 2048) { const int c = (n - 1024) & 511, h = c >> 6, d = c & 63; return 256 * ((n < 1536 ? 4 : 6) + (h >> 2)) + 128 * (d >> 5) + (h & 3) * 32 + (d & 31); }
    return n; } };

__device__ __forceinline__ void sincos_d(double a, float& c, float& s) {
    const double TWO_PI = 6.283185307179586476925286766559, INV = 0.15915494309189533576888376337251;
    const double n = __builtin_rint(a * INV); double r = __builtin_fma(-n, TWO_PI, a); r = __builtin_fma(-n, 2.4492935982947064e-16, r) ;
    const double r2 = r * r; double sp = 0.0, cp = 0.0;
#pragma unroll
    for (int k = 13; k >= 1; --k) { sp = (sp + 1.0) * (-r2 / (double)((2 * k) * (2 * k + 1))); cp = (cp + 1.0) * (-r2 / (double)((2 * k - 1) * (2 * k))); }
    s = (float)(r * (1.0 + sp)); c = (float)(1.0 + cp);
}

__device__ __forceinline__ void p0_prologue(Frame& F, const Args& a) {
    LAS float* scr = (LAS float*)(F.lds + F.wave * 16640);
    const int gw = F.vcu * 8 + F.wave, NGW = F.G * 8;
    bf16_t* Win = (bf16_t*)(F.ws + WS_WIN); bf16_t* Wpw = (bf16_t*)(F.ws + WS_WPW); bf16_t* Wout = (bf16_t*)(F.ws + WS_WOUT);
    bf16_t* Wd = (bf16_t*)(F.ws + WS_WD); bf16_t* Wgu = (bf16_t*)(F.ws + WS_WGU);
    constexpr int I_IN = 16 * 40, I_PW = 8 * 8, I_OUT = 16 * 16, I_E = 16 * 16;
    constexpr int NITEMS = I_IN + I_PW + I_OUT + NEXP * 3 * I_E;
    for (int it = gw; it < NITEMS; it += NGW) {
        int r = it;
        if (r < I_IN) { tr_item((const float*)a.in[2], NPROJ, DM, Win, MapInProj{}, scr, 64 * (r / 40), 64 * (r % 40), F.lane); continue; } r -= I_IN;
        if (r < I_PW) { tr_item((const float*)a.in[7], DCONV, DCONV, Wpw, MapIdent{0}, scr, 64 * (r / 8), 64 * (r % 8), F.lane); continue; } r -= I_PW;
        if (r < I_OUT) { tr_item((const float*)a.in[9], DM, DM, Wout, MapIdent{0}, scr, 64 * (r / 16), 64 * (r % 16), F.lane); continue; } r -= I_OUT;
        const int e = r / (3 * I_E), q = r % (3 * I_E), which = q / I_E, t = q % I_E, k0 = 64 * (t / 16), n0 = 64 * (t % 16);
        if (which == 0) tr_item((const float*)a.in[14] + (size_t)e * DM * DFF, DFF, DM, Wgu + (size_t)e * 2048 * DM, MapGateUp{0}, scr, k0, n0, F.lane);
        else if (which == 1) tr_item((const float*)a.in[16] + (size_t)e * DM * DFF, DFF, DM, Wgu + (size_t)e * 2048 * DM, MapGateUp{128}, scr, k0, n0, F.lane);
        else tr_item((const float*)a.in[18] + (size_t)e * DFF * DM, DM, DFF, Wd + (size_t)e * DM * DFF, MapIdent{0}, scr, k0, n0, F.lane);
    }
    const float* x = (const float*)a.in[0]; bf16_t* XB = (bf16_t*)(F.ws + WS_XB);
    for (int m = gw; m < NTOK; m += NGW) {
        const GAS f32x4* xr = (const GAS f32x4*)(x + (size_t)m * DM) + F.lane; GAS u32x2* o = (GAS u32x2*)(XB + (size_t)m * DM) + F.lane;
        f32x4 v[4];
#pragma unroll
        for (int j = 0; j < 4; ++j) v[j] = xr[64 * j];
#pragma unroll
        for (int j = 0; j < 4; ++j) { u32x2 w; w.x = cvtpk(v[j][0], v[j][1]); w.y = cvtpk(v[j][2], v[j][3]); o[64 * j] = w; }
    }
    const int* pos = (const int*)a.in[1]; float* rope = (float*)(F.ws + WS_ROPE);
    for (int idx = (F.vcu * 512 + F.tid); idx < NTOK * 32; idx += F.G * 512) {
        const int tok = idx >> 5, i = idx & 31;
        double inv_freq = 1.0;
        for (int q = 0; q < i; ++q) inv_freq *= 0.7498942093324558;
        float c, s; sincos_d((double)pos[tok] * inv_freq, c, s);
        rope[idx] = c; rope[NTOK * 32 + idx] = s;
    }
}

namespace att {
constexpr int L_K = 0, L_V = 49152, L_WS = 98304, L_OST = L_WS + 8 * 256, L_END = L_OST + 8 * 4096;
__device__ __forceinline__ int crow(int r, int hi) { return (r & 3) + 8 * (r >> 2) + 4 * hi; }
__device__ __forceinline__ s16x4 vtr(const LAS char* p) { typedef short v4i16_t __attribute__((ext_vector_type(4))); return __builtin_bit_cast(s16x4, __builtin_amdgcn_ds_read_tr16_b64_v4i16((LAS v4i16_t*)p)); }
__device__ __forceinline__ void attn_unit(int b, int h, int br, int blk, const bf16_t* Q, const bf16_t* K, const bf16_t* V, bf16_t* OB, float* LSE, LAS unsigned char* lds) {
    const int tid = threadIdx.x, lane = tid & 63, r32 = lane & 31, hi = lane >> 5; const int wid = __builtin_amdgcn_readfirstlane(tid >> 6);
    const int d = 1 << (2 * br), per = 32 >> (2 * br), res = blk / per, i0 = 256 * (blk % per), kbase = i0 - 128;
    const int rowbase = b * SEQ + res;
#pragma unroll
    for (int T = 0; T < 6; ++T) {
        int sp = kbase + 64 * T + lane; sp = sp < 0 ? 0 : sp;
        const bf16_t* ks = K + (size_t)(rowbase + d * sp) * DATT + h * 64 + wid * 8;
        __builtin_amdgcn_global_load_lds((const unsigned*)ks, (LAS unsigned*)(lds + L_K + T * 8192 + wid * 1024), 16, 0, 0);
        int sv = kbase + 64 * T + 16 * (wid & 3) + (lane >> 2); sv = sv < 0 ? 0 : sv;
        const bf16_t* vs = V + (size_t)(rowbase + d * sv) * DATT + h * 64 + (wid >> 2) * 32 + (lane & 3) * 8;
        __builtin_amdgcn_global_load_lds((const unsigned*)vs, (LAS unsigned*)(lds + L_V + T * 8192 + wid * 1024), 16, 0, 0);
    }
    const int qsub = i0 + 32 * wid;
    const size_t qtok = (size_t)(rowbase + d * (qsub + r32));
    bf16x8 qr[4];
#pragma unroll
    for (int d0 = 0; d0 < 4; ++d0) qr[d0] = *(const bf16x8*)(Q + qtok * DATT + h * 64 + d0 * 16 + hi * 8);
    asm volatile("s_waitcnt vmcnt(0)" ::: "memory");
    __syncthreads();
    const int jmin = (i0 == 0) ? ((4 - wid) > 0 ? (4 - wid) : 0) : 0;
    f32x16 s[5];
    const float NEG = -INFINITY;
#pragma unroll
    for (int j = 0; j < 5; ++j) {
        if (j >= jmin) {
            const int tt = wid + j, T = tt >> 1, sub = tt & 1;
            const LAS unsigned char* kb = lds + L_K + T * 8192 + hi * 1024 + (32 * sub + r32) * 16;
            f32x16 acc = {};
#pragma unroll
            for (int d0 = 0; d0 < 4; ++d0) { const bf16x8 kf = *(const LAS bf16x8*)(kb + d0 * 2048); acc = __builtin_amdgcn_mfma_f32_32x32x16_bf16(kf, qr[d0], acc, 0, 0, 0); }
            if (j == 0) {
#pragma unroll
                for (int r = 0; r < 16; ++r) if (crow(r, hi) < r32) acc[r] = NEG;
            }
            if (j == 4) {
#pragma unroll
                for (int r = 0; r < 16; ++r) if (crow(r, hi) > r32) acc[r] = NEG;
            }
            s[j] = acc;
        } else {
#pragma unroll
            for (int r = 0; r < 16; ++r) s[j][r] = NEG;
        }
    }
    float m = NEG;
#pragma unroll
    for (int j = 0; j < 5; ++j)
#pragma unroll
        for (int r = 0; r < 16; ++r) m = fmaxf(m, s[j][r]);
    m = fmaxf(m, __shfl_xor(m, 32));
    float l = 0.f;
#pragma unroll
    for (int j = 0; j < 5; ++j)
#pragma unroll
        for (int r = 0; r < 16; ++r) { const float p = __builtin_amdgcn_exp2f(s[j][r] - m); s[j][r] = p; l += p; }
    l += __shfl_xor(l, 32);
    f32x16 o[2]; o[0] = f32x16{}; o[1] = f32x16{};
#pragma unroll
    for (int j = 0; j < 5; ++j) {
        if (j >= jmin) {
            const int tt = wid + j, T = tt >> 1, sub = tt & 1;
            const LAS char* vb = (const LAS char*)lds + L_V + T * 8192 + ((lane >> 4) & 1) * 32 + (lane & 3) * 8 + (32 * sub + 4 * hi + ((lane & 15) >> 2)) * 64;
#pragma unroll
            for (int ks = 0; ks < 2; ++ks) {
                u32x4 pw; pw.x = cvtpk(s[j][8 * ks + 0], s[j][8 * ks + 1]); pw.y = cvtpk(s[j][8 * ks + 2], s[j][8 * ks + 3]); pw.z = cvtpk(s[j][8 * ks + 4], s[j][8 * ks + 5]); pw.w = cvtpk(s[j][8 * ks + 6], s[j][8 * ks + 7]);
                const bf16x8 pa = __builtin_bit_cast(bf16x8, pw);
#pragma unroll
                for (int dh = 0; dh < 2; ++dh) {
                    const s16x4 lo = vtr(vb + dh * 4096 + ks * 1024), hi4 = vtr(vb + dh * 4096 + ks * 1024 + 512);
                    const bf16x8 vf = (bf16x8){lo[0], lo[1], lo[2], lo[3], hi4[0], hi4[1], hi4[2], hi4[3]};
                    o[dh] = __builtin_amdgcn_mfma_f32_32x32x16_bf16(pa, vf, o[dh], 0, 0, 0);
                }
            }
        }
    }
    LAS float* wsf = (LAS float*)(lds + L_WS) + wid * 64;
    if (hi == 0) wsf[r32] = __builtin_amdgcn_rcpf(l);
    LDS_WAIT(); asm volatile("" ::: "memory");
    LAS bf16_t* stg = (LAS bf16_t*)(lds + L_OST) + wid * 2048;
#pragma unroll
    for (int r = 0; r < 16; ++r) { const int orow = crow(r, hi); const float rl = wsf[orow];
#pragma unroll
        for (int dh = 0; dh < 2; ++dh) stg[orow * 64 + dh * 32 + r32] = (bf16_t)(cvtpk(o[dh][r] * rl, 0.f) & 0xffffu); }
    LDS_WAIT(); asm volatile("" ::: "memory");
    bf16_t* Ob = OB + (size_t)br * NTOK * DATT;
#pragma unroll
    for (int i = 0; i < 4; ++i) { const int row = i * 8 + (lane >> 3), ch = lane & 7; const u32x4 v = *(const LAS u32x4*)(stg + row * 64 + ch * 8);
        *(u32x4*)(Ob + (size_t)(rowbase + d * (qsub + row)) * DATT + h * 64 + ch * 8) = v; }
    if (hi == 0) LSE[((size_t)br * NTOK + qtok) * 8 + h] = m + __builtin_amdgcn_logf(l);
    __syncthreads();
}
}

__device__ __forceinline__ void conv_item(int item, const bf16_t* U, const float* cw, const float* cb, const float* lng, const float* lnb, bf16_t* S, LAS unsigned char* lds, int wave, int lane) {
    const int c = threadIdx.x, t0 = item * 64;
    float w[31], x[62];
#pragma unroll
    for (int j = 0; j < 31; ++j) w[j] = cw[j * DCONV + c];
    const float bias = cb[c];
    const bool hist = (t0 % SEQ) != 0;
#pragma unroll
    for (int j = 0; j < 30; ++j) x[j] = hist ? bf2f(U[(size_t)(t0 - 30 + j) * DCONV + c]) : 0.f;
    LAS float* CT = (LAS float*)lds;
    f32x4 g0 = *(const f32x4*)(lng + 8 * lane), g1 = *(const f32x4*)(lng + 8 * lane + 4), b0 = *(const f32x4*)(lnb + 8 * lane), b1 = *(const f32x4*)(lnb + 8 * lane + 4);
    for (int ch = 0; ch < 2; ++ch) {
#pragma unroll
        for (int j = 0; j < 32; ++j) x[30 + j] = bf2f(U[(size_t)(t0 + 32 * ch + j) * DCONV + c]);
#pragma unroll
        for (int tt = 0; tt < 32; ++tt) { float y = bias;
#pragma unroll
            for (int j = 0; j < 31; ++j) y = __builtin_fmaf(w[j], x[tt + j], y);
            CT[tt * DCONV + c] = y; }
#pragma unroll
        for (int j = 0; j < 30; ++j) x[j] = x[32 + j];
        __syncthreads();
#pragma unroll
        for (int q = 0; q < 4; ++q) { const int tt = wave + 8 * q;
            const f32x4 v0 = *(const LAS f32x4*)(CT + tt * DCONV + 8 * lane), v1 = *(const LAS f32x4*)(CT + tt * DCONV + 8 * lane + 4);
            const float mean = wave_sum((v0[0] + v0[1]) + (v0[2] + v0[3]) + (v1[0] + v1[1]) + (v1[2] + v1[3])) * (1.f / DCONV);
            const f32x4 d0 = v0 - mean, d1 = v1 - mean;
            const float var = wave_sum((d0[0] * d0[0] + d0[1] * d0[1]) + (d0[2] * d0[2] + d0[3] * d0[3]) + (d1[0] * d1[0] + d1[1] * d1[1]) + (d1[2] * d1[2] + d1[3] * d1[3])) * (1.f / DCONV);
            const float rstd = 1.0f / sqrtf(var + LN_EPS);
            f32x4 y0 = d0 * rstd * g0 + b0, y1 = d1 * rstd * g1 + b1;
#pragma unroll
            for (int i = 0; i < 4; ++i) { y0[i] = y0[i] * fsigmoid(y0[i]); y1[i] = y1[i] * fsigmoid(y1[i]); }
            *(u32x4*)(S + (size_t)(t0 + 32 * ch + tt) * DCONV + 8 * lane) = pg8::pack8(y0, y1); }
        __syncthreads();
    }
}

__device__ __forceinline__ void combine_tokens(Frame& F, const bf16_t* OB, const float* LSE, bf16_t* AO) {
    const int gw = F.vcu * 8 + F.wave, NGW = F.G * 8, h = F.lane >> 3;
    for (int tok = gw; tok < NTOK; tok += NGW) {
        float ls[3]; u32x4 v[3];
#pragma unroll
        for (int br = 0; br < 3; ++br) { ls[br] = LSE[((size_t)br * NTOK + tok) * 8 + h]; v[br] = *(const u32x4*)(OB + ((size_t)br * NTOK + tok) * DATT + 8 * F.lane); }
        const float mx = fmaxf(ls[0], fmaxf(ls[1], ls[2]));
        float wt[3]; float sum = 0.f;
#pragma unroll
        for (int br = 0; br < 3; ++br) { wt[br] = __builtin_amdgcn_exp2f(ls[br] - mx); sum += wt[br]; }
        const float rs = 1.0f / sum;
        f32x4 a0 = {0.f, 0.f, 0.f, 0.f}, a1 = {0.f, 0.f, 0.f, 0.f};
#pragma unroll
        for (int br = 0; br < 3; ++br) { const float wv = wt[br] * rs;
            a0[0] += wv * bflo(v[br].x); a0[1] += wv * bfhi(v[br].x); a0[2] += wv * bflo(v[br].y); a0[3] += wv * bfhi(v[br].y);
            a1[0] += wv * bflo(v[br].z); a1[1] += wv * bfhi(v[br].z); a1[2] += wv * bflo(v[br].w); a1[3] += wv * bfhi(v[br].w); }
        *(u32x4*)(AO + (size_t)tok * DM + DCONV + 8 * F.lane) = pg8::pack8(a0, a1);
    }
}

constexpr int RT_RW = 0;
constexpr int RT_LCNT = 147456, RT_BASE = RT_LCNT + 128, RT_TE = RT_BASE + 128, RT_TG = RT_TE + 1024, RT_END = RT_TG + 1024;
__device__ __forceinline__ void route_phase(Frame& F, const Args& a) {
    LAS float* RW = (LAS float*)(F.lds + RT_RW);
    volatile LAS int* lcnt = (volatile LAS int*)(F.lds + RT_LCNT); volatile LAS int* lbase = (volatile LAS int*)(F.lds + RT_BASE);
    volatile LAS int* te = (volatile LAS int*)(F.lds + RT_TE); volatile LAS float* tg = (volatile LAS float*)(F.lds + RT_TG);
    const float* rw = (const float*)a.in[12]; const float* rb = (const float*)a.in[13]; const float* g1 = (const float*)a.in[10]; const float* b1 = (const float*)a.in[11];
    float* Z = (float*)(F.ws + WS_Z); bf16_t* X1B = (bf16_t*)(F.ws + WS_X1B);
    int* TOKE = (int*)(F.ws + WS_TOKE); float* TOKG = (float*)(F.ws + WS_TOKG); int* LIST = (int*)(F.ws + WS_LIST);
    for (int idx = F.tid; idx < DM * 8; idx += 512) { const int c = idx >> 3, q = idx & 7; const int rowp = (((c >> 8) * 4 + (c & 3)) * 64) + ((c >> 2) & 63);
        *(LAS f32x4*)(RW + rowp * 36 + 4 * q) = *(const f32x4*)(rw + c * 32 + 4 * q); }
    f32x4 gv[4], bv[4];
#pragma unroll
    for (int j = 0; j < 4; ++j) { gv[j] = *(const f32x4*)(g1 + 4 * F.lane + 256 * j); bv[j] = *(const f32x4*)(b1 + 4 * F.lane + 256 * j); }
    const float rbias = rb[(F.lane >> 1) & 31];
    for (int tb = F.vcu; tb < NTOK / 64; tb += F.G) {
        if (F.tid < 32) lcnt[F.tid] = 0;
        __syncthreads();
        for (int it = 0; it < 8; ++it) {
            const int tl = F.wave * 8 + it, tok = tb * 64 + tl;
            float* zrow = Z + (size_t)tok * DM;
            f32x4 xv[4]; float sum = 0.f;
#pragma unroll
            for (int j = 0; j < 4; ++j) { xv[j] = *(const f32x4*)(zrow + 4 * F.lane + 256 * j); sum += (xv[j][0] + xv[j][1]) + (xv[j][2] + xv[j][3]); }
            const float mean = wave_sum(sum) * (1.f / DM); float sq = 0.f;
#pragma unroll
            for (int j = 0; j < 4; ++j) { xv[j] = xv[j] - mean; sq += (xv[j][0] * xv[j][0] + xv[j][1] * xv[j][1]) + (xv[j][2] * xv[j][2] + xv[j][3] * xv[j][3]); }
            const float rstd = 1.0f / sqrtf(wave_sum(sq) * (1.f / DM) + LN_EPS);
#pragma unroll
            for (int j = 0; j < 4; ++j) { xv[j] = xv[j] * rstd * gv[j] + bv[j]; *(f32x4*)(zrow + 4 * F.lane + 256 * j) = xv[j];
                u32x2 w; w.x = cvtpk(xv[j][0], xv[j][1]); w.y = cvtpk(xv[j][2], xv[j][3]); *(u32x2*)(X1B + (size_t)tok * DM + 4 * F.lane + 256 * j) = w; }
            float acc[32];
#pragma unroll
            for (int e = 0; e < 32; ++e) acc[e] = 0.f;
#pragma unroll
            for (int j = 0; j < 4; ++j)
#pragma unroll
                for (int jj = 0; jj < 4; ++jj) { const float xs = xv[j][jj]; const LAS float* wr_ = RW + ((j * 4 + jj) * 64 + F.lane) * 36;
#pragma unroll
                    for (int q = 0; q < 8; ++q) { const f32x4 w4 = *(const LAS f32x4*)(wr_ + 4 * q);
                        acc[4 * q + 0] = __builtin_fmaf(xs, w4[0], acc[4 * q + 0]); acc[4 * q + 1] = __builtin_fmaf(xs, w4[1], acc[4 * q + 1]);
                        acc[4 * q + 2] = __builtin_fmaf(xs, w4[2], acc[4 * q + 2]); acc[4 * q + 3] = __builtin_fmaf(xs, w4[3], acc[4 * q + 3]); } }
#define RT_STEP(NV, MASK) { const bool up = (F.lane & (MASK)) != 0; _Pragma("unroll") for (int i = 0; i < (NV) / 2; ++i) { const float keep = up ? acc[i + (NV) / 2] : acc[i]; const float send = up ? acc[i] : acc[i + (NV) / 2]; acc[i] = keep + __shfl_xor(send, (MASK)); } }
            RT_STEP(32, 32) RT_STEP(16, 16) RT_STEP(8, 8) RT_STEP(4, 4) RT_STEP(2, 2)
#undef RT_STEP
            float logit = acc[0] + __shfl_xor(acc[0], 1) + rbias;
            const int myE = (F.lane >> 1) & 31;
            float tv[4]; int ti[4];
#pragma unroll
            for (int k = 0; k < 4; ++k) {
                float bvv = logit; int bi = myE;
#pragma unroll
                for (int o = 1; o < 64; o <<= 1) { const float ov = __shfl_xor(bvv, o); const int oi = __shfl_xor(bi, o); if (ov > bvv || (ov == bvv && oi < bi)) { bvv = ov; bi = oi; } }
                tv[k] = bvv; ti[k] = bi; if (myE == bi) logit = -INFINITY;
            }
            float ex[4], es = 0.f;
#pragma unroll
            for (int k = 0; k < 4; ++k) { ex[k] = __builtin_amdgcn_exp2f((tv[k] - tv[0]) * 1.4426950408889634f); es += ex[k]; }
            const float ies = 1.0f / es;
            if (F.lane < 4) {
                const int ek = F.lane == 0 ? ti[0] : F.lane == 1 ? ti[1] : F.lane == 2 ? ti[2] : ti[3];
                const float gk = (F.lane == 0 ? ex[0] : F.lane == 1 ? ex[1] : F.lane == 2 ? ex[2] : ex[3]) * ies;
                const int lr = __hip_atomic_fetch_add((LAS int*)(F.lds + RT_LCNT) + ek, 1, __ATOMIC_RELAXED, __HIP_MEMORY_SCOPE_WORKGROUP);
                te[tl * 4 + F.lane] = ek | (lr << 5); tg[tl * 4 + F.lane] = gk;
            }
        }
        __syncthreads();
        if (F.tid < 32) lbase[F.tid] = (int)__hip_atomic_fetch_add((unsigned*)(F.ctl + CW_GCNT + F.tid), (unsigned)lcnt[F.tid], RLX_AGENT);
        __syncthreads();
        if (F.tid < 256) { const int tl = F.tid >> 2, k = F.tid & 3, tok = tb * 64 + tl; const int w = te[tl * 4 + k], e = w & 31, rank = lbase[e] + (w >> 5);
            LIST[e * NTOK + rank] = tok; TOKE[tok * 4 + k] = e | (rank << 5); TOKG[tok * 4 + k] = tg[tl * 4 + k]; }
        __syncthreads();
    }
}
__device__ __forceinline__ void moe_prefix(Frame& F) {
    if (F.tid == 0) { int p = 0; for (int e = 0; e < 32; ++e) { const int c = (int)__hip_atomic_load(F.ctl + CW_GCNT + e, RLX_AGENT); F.MISC[80 + e] = (unsigned)c; F.MISC[32 + e] = (unsigned)p; p += (c + 255) >> 8; } F.MISC[64] = (unsigned)p; }
    __syncthreads();
}

__device__ __forceinline__ void final_phase(Frame& F, const Args& a) {
    const int gw = F.vcu * 8 + F.wave, NGW = F.G * 8;
    const float* X1 = (const float*)(F.ws + WS_Z); const bf16_t* Y = (const bf16_t*)(F.ws + WS_Y);
    const int* TOKE = (const int*)(F.ws + WS_TOKE); const float* TOKG = (const float*)(F.ws + WS_TOKG);
    const float* g2 = (const float*)a.in[20]; const float* b2 = (const float*)a.in[21];
    f32x4 gv[4], bv[4];
#pragma unroll
    for (int j = 0; j < 4; ++j) { gv[j] = *(const f32x4*)(g2 + 4 * F.lane + 256 * j); bv[j] = *(const f32x4*)(b2 + 4 * F.lane + 256 * j); }
    for (int tok = gw; tok < NTOK; tok += NGW) {
        f32x4 v[4];
#pragma unroll
        for (int j = 0; j < 4; ++j) v[j] = *(const f32x4*)(X1 + (size_t)tok * DM + 4 * F.lane + 256 * j) * DN_ALPHA;
#pragma unroll
        for (int k = 0; k < 4; ++k) { const int w = TOKE[tok * 4 + k], e = w & 31, rank = w >> 5; const float g = TOKG[tok * 4 + k];
            const size_t slot = (size_t)F.MISC[32 + e] * 256 + rank;
#pragma unroll
            for (int j = 0; j < 4; ++j) { const u32x2 y = *(const u32x2*)(Y + slot * DM + 4 * F.lane + 256 * j);
                v[j][0] += g * bflo(y.x); v[j][1] += g * bfhi(y.x); v[j][2] += g * bflo(y.y); v[j][3] += g * bfhi(y.y); } }
        float sum = 0.f;
#pragma unroll
        for (int j = 0; j < 4; ++j) sum += (v[j][0] + v[j][1]) + (v[j][2] + v[j][3]);
        const float mean = wave_sum(sum) * (1.f / DM); float sq = 0.f;
#pragma unroll
        for (int j = 0; j < 4; ++j) { v[j] = v[j] - mean; sq += (v[j][0] * v[j][0] + v[j][1] * v[j][1]) + (v[j][2] * v[j][2] + v[j][3] * v[j][3]); }
        const float rstd = 1.0f / sqrtf(wave_sum(sq) * (1.f / DM) + LN_EPS);
#pragma unroll
        for (int j = 0; j < 4; ++j) *(f32x4*)(a.out + (size_t)tok * DM + 4 * F.lane + 256 * j) = v[j] * rstd * gv[j] + bv[j];
    }
}

__global__ void __launch_bounds__(512, 2) mega_fwd(Args args) {
    extern __shared__ __attribute__((aligned(16))) unsigned char lds[];
    Frame F;
    F.lds = (LAS unsigned char*)lds;
    F.MISC = (volatile LAS unsigned*)(F.lds + MISC_OFF);
    F.tid = threadIdx.x; F.lane = F.tid & 63; F.wave = __builtin_amdgcn_readfirstlane(F.tid >> 6);
    F.G = gridDim.x; { const int bx = blockIdx.x; F.vcu = (F.G % 8 == 0) ? (bx % 8) * (F.G / 8) + bx / 8 : bx; }
    F.ws = args.ws; F.ctl = (gu32*)(args.ws + WS_CTL);
    for (int u = F.tid; u < 256; u += 512) F.MISC[u] = 0u;
    __syncthreads();
    XcdBarrier bar; bar.bar = (unsigned*)(F.ctl + CW_BAR); bar.x = 0; bar.st = nullptr;
    if (N_LAUNCHES != PER_PHASE) bar = xcd_barrier_post((unsigned*)(F.ctl + CW_BAR), F.MISC + 8);
#define GRID_BAR(seam) do { if (N_LAUNCHES == PER_PHASE) { if (F.tid == 0) __hip_atomic_store(F.ctl + CW_TMO, 0xBADBA0u | (unsigned)(seam), RLX_AGENT); } else { xcd_barrier(bar); } } while (0)
    const int lo = args.ph_lo, hi = args.ph_hi;
#define IN(k) (lo <= (k) && (k) < hi)
#define BOTH(k) (IN(k) && IN((k) + 1))
    unsigned char* ws = args.ws;
    bf16_t* XB = (bf16_t*)(ws + WS_XB); bf16_t* Ub = (bf16_t*)(ws + WS_U); bf16_t* Qb = (bf16_t*)(ws + WS_Q); bf16_t* Kb = (bf16_t*)(ws + WS_K); bf16_t* Vb = (bf16_t*)(ws + WS_V);
    bf16_t* Sb = (bf16_t*)(ws + WS_S); bf16_t* OB = (bf16_t*)(ws + WS_OB); float* LSE = (float*)(ws + WS_LSE); bf16_t* AO = (bf16_t*)(ws + WS_AO);
    float* Z = (float*)(ws + WS_Z); bf16_t* X1B = (bf16_t*)(ws + WS_X1B); bf16_t* Hb = (bf16_t*)(ws + WS_H); bf16_t* Yb = (bf16_t*)(ws + WS_Y);

    if (IN(0)) { p0_prologue(F, args); if (BOTH(0)) GRID_BAR(0); }
    if (IN(1)) {
        pg8::DenseOrder S; S.init(NTOK, NPROJ, DM, F.G, (int)blockIdx.x, ws + WS_WIN);
        pg8::EpiInProj E{Ub, Qb, Kb, Vb, (const float*)(ws + WS_ROPE)};
        pg8::gemm_phase<pg8::EpiInProj, pg8::DenseOrder, true>(F.lds, XB, DM, S, E);
        if (BOTH(1)) GRID_BAR(1);
    }
    if (IN(2)) {
        const int per = F.G / 8, xcd = F.vcu / per, loc = F.vcu % per;
        if (F.G % 8 == 0 && per >= 1) {
            for (int j = loc; j < 192; j += per) { const int bh = 2 * xcd + j / 96, jj = j % 96; att::attn_unit(bh >> 3, bh & 7, jj >> 5, jj & 31, Qb, Kb, Vb, OB, LSE, F.lds); }
        } else {
            for (int j = F.vcu; j < 1536; j += F.G) { const int bh = j / 96, jj = j % 96; att::attn_unit(bh >> 3, bh & 7, jj >> 5, jj & 31, Qb, Kb, Vb, OB, LSE, F.lds); }
        }
        for (int it = F.vcu; it < NTOK / 64; it += F.G)
            conv_item(it, Ub, (const float*)args.in[3], (const float*)args.in[4], (const float*)args.in[5], (const float*)args.in[6], Sb, F.lds, F.wave, F.lane);
        if (BOTH(2)) GRID_BAR(2);
    }
    if (IN(3)) {
        combine_tokens(F, OB, LSE, AO);
        pg8::DenseOrder S; S.init(NTOK, DCONV, DCONV, F.G, (int)blockIdx.x, ws + WS_WPW);
        pg8::EpiBiasBf16 E{AO, DM, (const float*)args.in[8]};
        pg8::gemm_phase<pg8::EpiBiasBf16, pg8::DenseOrder, true>(F.lds, Sb, DCONV, S, E);
        if (BOTH(3)) GRID_BAR(3);
    }
    if (IN(4)) {
        pg8::DenseOrder S; S.init(NTOK, DM, DM, F.G, (int)blockIdx.x, ws + WS_WOUT);
        pg8::EpiResF32 E{(const float*)args.in[0], Z};
        pg8::gemm_phase<pg8::EpiResF32, pg8::DenseOrder, true>(F.lds, AO, DM, S, E);
        if (BOTH(4)) GRID_BAR(4);
    }
    if (IN(5)) { route_phase(F, args); if (BOTH(5)) GRID_BAR(5); }
    if (IN(6)) {
        moe_prefix(F);
        pg8::MoeOrder S{(const volatile LAS int*)(F.MISC + 32), (const volatile LAS int*)(F.MISC + 80), (const int*)(ws + WS_LIST), (const char*)(ws + WS_WGU), 8, 2048, F.vcu, F.G};
        pg8::EpiSwiglu E{Hb, (const float*)args.in[15], (const float*)args.in[17], (const volatile LAS int*)(F.MISC + 32)};
        pg8::gemm_phase<pg8::EpiSwiglu, pg8::MoeOrder, true>(F.lds, X1B, DM, S, E);
        if (BOTH(6)) GRID_BAR(6);
    }
    if (IN(7)) {
        moe_prefix(F);
        pg8::MoeOrder S{(const volatile LAS int*)(F.MISC + 32), (const volatile LAS int*)(F.MISC + 80), nullptr, (const char*)(ws + WS_WD), 4, 1024, F.vcu, F.G};
        pg8::EpiDown E{Yb, (const float*)args.in[19], (const volatile LAS int*)(F.MISC + 32)};
        pg8::gemm_phase<pg8::EpiDown, pg8::MoeOrder, true>(F.lds, Hb, DM, S, E);
        if (BOTH(7)) GRID_BAR(7);
    }
    if (IN(8)) { moe_prefix(F); final_phase(F, args); }
#undef IN
#undef BOTH
}

extern "C" void kernel_launch(void* const* d_in, const int* in_sizes, int n_in, void* d_out, int out_size, void* d_ws, size_t ws_size, hipStream_t stream) {
    static int grid = 0;
    if (grid == 0) {
        if (n_in != 22 || out_size != NTOK * DM || ws_size < WS_END) { fprintf(stderr, "kernel_launch: unexpected problem (n_in %d out %d ws %zu need %zu)\n", n_in, out_size, ws_size, (size_t)WS_END); grid = -1; return; }
        int dev = 0, cus = 0;
        if (hipGetDevice(&dev) != hipSuccess || hipDeviceGetAttribute(&cus, hipDeviceAttributeMultiprocessorCount, dev) != hipSuccess) { grid = -1; return; }
        if (hipFuncSetAttribute((const void*)mega_fwd, hipFuncAttributeMaxDynamicSharedMemorySize, LDS_BYTES) != hipSuccess) { fprintf(stderr, "kernel_launch: hipFuncSetAttribute failed\n"); grid = -1; return; }
        (void)hipGetLastError();
        grid = cus;
    }
    if (grid < 0) return;
    if (hipMemsetAsync((char*)d_ws + WS_CTL, 0, CTL_ZERO_BYTES, stream) != hipSuccess) return;
    Args a{};
    for (int i = 0; i < 22; ++i) a.in[i] = d_in[i];
    a.out = (float*)d_out; a.ws = (unsigned char*)d_ws;
    for (int li = 0; li < N_LAUNCHES; ++li) {
        a.ph_lo = (N_LAUNCHES == PER_PHASE) ? li : 0; a.ph_hi = (N_LAUNCHES == PER_PHASE) ? li + 1 : PER_PHASE; a.li = li;
        hipLaunchKernelGGL(mega_fwd, dim3(grid), dim3(512), LDS_BYTES, stream, a);
    }
}
```

```cpp
#include <hip/hip_runtime.h>
#include <cstdio>
#include <cstdint>

#define GAS __attribute__((address_space(1)))
#define LAS __attribute__((address_space(3)))
typedef unsigned short bf16_t;
typedef short bf16x8 __attribute__((ext_vector_type(8)));
typedef short s16x4 __attribute__((ext_vector_type(4)));
typedef float f32x4 __attribute__((ext_vector_type(4)));
typedef float f32x2 __attribute__((ext_vector_type(2)));
typedef float f32x16 __attribute__((ext_vector_type(16)));
typedef unsigned u32x4 __attribute__((ext_vector_type(4)));
typedef unsigned u32x2 __attribute__((ext_vector_type(2)));
typedef __bf16 bf16x2_t __attribute__((ext_vector_type(2)));

#ifndef MK_N_LAUNCHES
#define MK_N_LAUNCHES 1
#endif
#ifndef TS_A
#define TS_A -1
#endif
#ifndef TS_B
#define TS_B -1
#endif
constexpr int N_LAUNCHES = MK_N_LAUNCHES;
constexpr int PER_PHASE = 9;

constexpr int BATCH = 2, SEQ = 8192, DM = 1024, NTOK = BATCH * SEQ;
constexpr int DCONV = 512, DATT = 512, NHEAD = 8, HD = 64, NPROJ = 2560, CONVK = 31;
constexpr int NEXP = 32, TOPK = 4, DFF = 1024;
constexpr float LN_EPS = 1e-5f;
constexpr float DN_ALPHA = 1.189207115002721f;
constexpr float SWI_LIMIT = 7.0f, SWI_ALPHA = 1.702f;
constexpr float WSCALE8 = 32.0f, WINV8 = 1.0f / 32.0f;
constexpr float QSCALE = 0.125f * 1.4426950408889634f;
constexpr int MAXSLOT = NTOK * TOPK + NEXP * 256;

constexpr size_t MiB = 1u << 20;
constexpr size_t WS_CTL = 0, CTL_ZERO_BYTES = 1 * MiB;
constexpr size_t WS_TOKE = 1 * MiB;
constexpr size_t WS_TOKG = WS_TOKE + 256 * 1024;
constexpr size_t WS_LIST = 2 * MiB;
constexpr size_t WS_ROPE = 4 * MiB;
constexpr size_t WS_WIN = 8 * MiB;
constexpr size_t WS_WPW = 13 * MiB;
constexpr size_t WS_WRT = 13 * MiB + 512 * 1024;
constexpr size_t WS_WOUT = 14 * MiB;
constexpr size_t WS_WD = 16 * MiB;
constexpr size_t WS_WGU = 48 * MiB;
constexpr size_t WS_AO = 112 * MiB;
constexpr size_t WS_Z = 144 * MiB;
constexpr size_t WS_Y = 48 * MiB;
constexpr size_t WS_X1B = 208 * MiB;
constexpr size_t WS_X1F8 = 240 * MiB;
constexpr size_t WS_XB = 256 * MiB;
constexpr size_t WS_U = 288 * MiB;
constexpr size_t WS_Q = 304 * MiB, WS_K = 320 * MiB, WS_V = 336 * MiB;
constexpr size_t WS_S = 352 * MiB;
constexpr size_t WS_OB = 368 * MiB;
constexpr size_t WS_LSE = 416 * MiB;
constexpr size_t WS_H = 256 * MiB;
constexpr size_t WS_END = 418 * MiB;
static_assert(WS_Y + (size_t)MAXSLOT * DM <= WS_Z && WS_H + (size_t)MAXSLOT * DM <= WS_OB && WS_WGU + (size_t)NEXP * 2048 * DM <= WS_AO, "ws overlays");
constexpr int CW_TMO = 0, CW_CODE = 1;
constexpr int CW_GCNT = 64;
constexpr int CW_BAR = 4096;

constexpr int LDS_BYTES = 163840;
constexpr int MISC_OFF = LDS_BYTES - 1024;
constexpr int RING_BYTES = 131072;

#define RLX_AGENT __ATOMIC_RELAXED, __HIP_MEMORY_SCOPE_AGENT
#define LDS_WAIT() asm volatile("s_waitcnt lgkmcnt(0)" ::: "memory")
#define VM_WAIT() asm volatile("s_waitcnt vmcnt(0)" ::: "memory")
typedef GAS unsigned gu32;

__device__ __forceinline__ unsigned cvtpk(float lo, float hi) { f32x2 v = {lo, hi}; bf16x2_t b = __builtin_convertvector(v, bf16x2_t); return __builtin_bit_cast(unsigned, b); }
__device__ __forceinline__ unsigned pk4_fp8(float a, float b, float c, float d) { int w = 0; w = __builtin_amdgcn_cvt_pk_fp8_f32(a, b, w, false); w = __builtin_amdgcn_cvt_pk_fp8_f32(c, d, w, true); return (unsigned)w; }
__device__ __forceinline__ void st16_wt(void* p, u32x4 v) { asm volatile("global_store_dwordx4 %0, %1, off sc1\n\ts_nop 1" :: "v"(p), "v"(v) : "memory"); }
__device__ __forceinline__ float bf2f(bf16_t h) { return __uint_as_float((unsigned)h << 16); }
__device__ __forceinline__ float bflo(unsigned w) { return __uint_as_float(w << 16); }
__device__ __forceinline__ float bfhi(unsigned w) { return __uint_as_float(w & 0xffff0000u); }
__device__ __forceinline__ float wave_sum(float v) {
#pragma unroll
    for (int o = 1; o < 64; o <<= 1) v += __shfl_xor(v, o);
    return v;
}
__device__ __forceinline__ float fsigmoid(float x) { return __builtin_amdgcn_rcpf(1.0f + __builtin_amdgcn_exp2f(-1.4426950408889634f * x)); }

namespace pg8 {
constexpr int BM = 256, BK = 64, HALF = 128, HTB = HALF * BK * 2, STAGE_BYTES = 8 * HTB, NXCD = 8, WGM = 8;
__host__ __device__ __forceinline__ int lds_byte(int r, int c) { const int st = (r >> 4) * 2 + (c >> 5), rr = r & 15, cc = c & 31, ob = rr * 64 + cc * 2; return st * 1024 + (ob ^ (((ob >> 9) & 1) << 5)); }
__host__ __device__ __forceinline__ void stage_rc(int b, int& R, int& C) { const int st = b / 1024, sb = b % 1024, swz = sb ^ (((sb >> 9) & 1) << 5); R = (st >> 1) * 16 + swz / 64; C = (st & 1) * 32 + (swz % 64) / 2; }
__host__ __device__ __forceinline__ int perm32(int rho) { const int n = rho >> 4, i = rho & 15; return 8 * (i >> 2) + 4 * n + (i & 3); }

struct Unit { int pm, pn, e, idx; };

struct DenseOrder {
    int nM, nN, nwg, G, c, K; const char* Bt;
    __device__ void init(int M, int N, int K_, int G_, int c_, const void* Bt_) { nM = M / BM; nN = N / BM; nwg = nM * nN; G = G_; c = c_; K = K_; Bt = (const char*)Bt_; }
    __device__ __forceinline__ bool next(int i, Unit& u) const {
        const long L = (long)i * G + c; if (L >= nwg) return false;
        int wgid = (int)L; { const int q = nwg / NXCD, r = nwg % NXCD, xcd = wgid % NXCD, off = wgid / NXCD; wgid = (xcd < r ? xcd * (q + 1) : r * (q + 1) + (xcd - r) * q) + off; }
        const int nig = WGM * nN, gid = wgid / nig, fm = gid * WGM, gsz = (nM - fm) < WGM ? (nM - fm) : WGM;
        u.pm = fm + ((wgid % nig) % gsz); u.pn = (wgid % nig) / gsz; u.e = 0; u.idx = i; return true;
    }
    __device__ __forceinline__ const char* b_base(const Unit& u) const { return Bt + (size_t)u.pn * BM * K * 2; }
    __device__ __forceinline__ void a_off(const Unit& u, unsigned (&v)[2][2]) const {
#pragma unroll
        for (int i = 0; i < 2; ++i) { int R, C; stage_rc((int)threadIdx.x * 16 + i * 8192, R, C);
#pragma unroll
            for (int h = 0; h < 2; ++h) v[h][i] = (unsigned)((u.pm * BM + h * HALF + R) * K + C) * 2u; }
    }
};
constexpr int PLAN_OFF = 131072, PLAN_UNITS = 12, PLAN_STRIDE = 2048, PLAN_DESC = PLAN_OFF + PLAN_UNITS * PLAN_STRIDE;
struct MoeOrder {
    const volatile LAS int* tp;
    const volatile LAS int* cnt;
    const int* list;
    const char* Bt; int NT, nrowB;
    int pitch;
    int vcu, G;
    LAS unsigned char* lds;
    __device__ __forceinline__ int tpu(int j) const { return __builtin_amdgcn_readfirstlane(tp[j]); }
    __device__ __forceinline__ bool calc(int i, Unit& u) const {
        const int Ltot = tpu(32) * NT, CH = (Ltot + 7) >> 3, per = G >> 3, x = vcu / per, c = vcu % per;
        const int loc = i * per + c; if (loc >= CH) return false;
        const int L = x * CH + loc; if (L >= Ltot) return false;
        int e = 0, hi_ = 32;
#pragma unroll
        for (int st = 0; st < 5; ++st) { const int mid = (e + hi_) >> 1; if (tpu(mid) * NT <= L) e = mid; else hi_ = mid; }
        const int t0 = tpu(e), te = tpu(e + 1) - t0, q = L - t0 * NT;
        u.e = e; u.pn = q / te; u.pm = q % te; u.idx = i; return true;
    }
    template <class BiasFn> __device__ __forceinline__ void plan(const BiasFn& biasfn) const {
        const int tid = threadIdx.x;
        for (int i = 0; i < PLAN_UNITS; ++i) {
            Unit u; const bool ok = calc(i, u);
            if (tid == 0) { volatile LAS int* d = (volatile LAS int*)(lds + PLAN_DESC) + 4 * i; d[0] = ok ? u.e : 0; d[1] = ok ? u.pn : 0; d[2] = ok ? u.pm : 0; d[3] = ok ? 1 : 0; }
            if (!ok) continue;
            if (tid < 256) {
                const int ce = __builtin_amdgcn_readfirstlane(cnt[u.e]), p0 = tpu(u.e) * BM, r = u.pm * BM + tid;
                int row; if (list) { row = 0; if (r < ce) row = list[u.e * NTOK + r]; } else row = p0 + r;
                ((LAS int*)(lds + PLAN_OFF + i * PLAN_STRIDE))[tid] = row;
            } else ((LAS float*)(lds + PLAN_OFF + i * PLAN_STRIDE + 1024))[tid - 256] = biasfn(u, tid - 256);
        }
        __syncthreads();
    }
    __device__ __forceinline__ bool next(int i, Unit& u) const {
        if (i >= PLAN_UNITS) return false;
        const volatile LAS int* d = (const volatile LAS int*)(lds + PLAN_DESC) + 4 * i;
        if (__builtin_amdgcn_readfirstlane(d[3]) == 0) return false;
        u.e = __builtin_amdgcn_readfirstlane(d[0]); u.pn = __builtin_amdgcn_readfirstlane(d[1]); u.pm = __builtin_amdgcn_readfirstlane(d[2]); u.idx = i; return true;
    }
    __device__ __forceinline__ const char* b_base(const Unit& u) const { return Bt + ((size_t)u.e * nrowB + (size_t)u.pn * BM) * pitch * 2; }
    __device__ __forceinline__ void a_off(const Unit& u, unsigned (&v)[2][2]) const {
        const LAS int* rows = (const LAS int*)(lds + PLAN_OFF + u.idx * PLAN_STRIDE);
#pragma unroll
        for (int i = 0; i < 2; ++i) { int R, C; stage_rc((int)threadIdx.x * 16 + i * 8192, R, C);
#pragma unroll
            for (int h = 0; h < 2; ++h) v[h][i] = (unsigned)(rows[h * HALF + R] * pitch + C) * 2u; }
    }
    __device__ __forceinline__ void plan_bias(const Unit& u, int wc, int fq, f32x4 (&bv)[2][2]) const {
        const LAS float* pb = (const LAS float*)(lds + PLAN_OFF + u.idx * PLAN_STRIDE + 1024);
#pragma unroll
        for (int bj = 0; bj < 2; ++bj)
#pragma unroll
            for (int n = 0; n < 2; ++n) bv[bj][n] = *(const LAS f32x4*)(pb + bj * HALF + wc * 32 + 8 * fq + 4 * n);
    }
};

template <class Epi, class Sched, bool ALIGN_EPI, bool FP8 = false>
__device__ __forceinline__ void gemm_phase(LAS unsigned char* lds, const void* Abase_, int K, const Sched& S, const Epi& E) {
    const char* Abase = (const char*)Abase_;
    const int tid = threadIdx.x, wid = __builtin_amdgcn_readfirstlane(tid >> 6), lane = tid & 63, wr = wid >> 2, wc = wid & 3, fr = lane & 15, fq = lane >> 4;
    const int nt = K / BK;
    unsigned voffB[2];
#pragma unroll
    for (int i = 0; i < 2; ++i) { int R, C; stage_rc(tid * 16 + i * 8192, R, C); const int Rb = Epi::PERM ? ((R & ~31) + perm32(R & 31)) : R; voffB[i] = (unsigned)(Rb * K + C) * 2u; }
    const size_t kstep = (size_t)(BK * 2);
    const size_t hstep = (size_t)HALF * K * 2;
    const unsigned ldsw = (unsigned)wid * 1024u;
    const int aoff = lds_byte(wr * 64 + fr, fq * 8), boff = lds_byte(wc * 32 + fr, fq * 8);
#define PG8_SA(b, h) (((b) * 2 + (h)) * HTB)
#define PG8_SB(b, h) ((4 + (b) * 2 + (h)) * HTB)
#define PG8_UPTR(p) ((const char*)(((unsigned long long)(unsigned)__builtin_amdgcn_readfirstlane((int)((unsigned long long)(p) >> 32)) << 32) | (unsigned long long)(unsigned)__builtin_amdgcn_readfirstlane((int)(unsigned)(unsigned long long)(p))))
#define PG8_STAGEB(bufoff, gbase) do { const char* gb_ = PG8_UPTR(gbase); _Pragma("unroll") for (int _i = 0; _i < 2; ++_i) \
        __builtin_amdgcn_global_load_lds((const unsigned*)(gb_ + voffB[_i]), (LAS unsigned*)(lds + (bufoff) + ldsw + _i * 8192), 16, 0, 0); } while (0)
#define PG8_STAGEA(bufoff, vo, h, kb) do { const char* ga_ = PG8_UPTR(Abase + (kb)); _Pragma("unroll") for (int _i = 0; _i < 2; ++_i) \
        __builtin_amdgcn_global_load_lds((const unsigned*)(ga_ + (vo)[h][_i]), (LAS unsigned*)(lds + (bufoff) + ldsw + _i * 8192), 16, 0, 0); } while (0)
#define PG8_STAGEA2(bufoff, h, kb) do { const char* ga_ = PG8_UPTR(Abase + (kb)); _Pragma("unroll") for (int _i = 0; _i < 2; ++_i) \
        __builtin_amdgcn_global_load_lds((const unsigned*)(ga_ + (last ? vN[h][_i] : vA[h][_i])), (LAS unsigned*)(lds + (bufoff) + ldsw + _i * 8192), 16, 0, 0); } while (0)
#define PG8_LD8(addr_) __builtin_shufflevector(*(const LAS v4i_*)(addr_), *(const LAS v4i_*)((addr_) + 1024), 0, 1, 2, 3, 4, 5, 6, 7)
#define PG8_LDA(dst, b, h) do { _Pragma("unroll") for (int m = 0; m < 4; ++m) dst[m] = PG8_LD8(lds + PG8_SA(b, h) + aoff + m * 2048); } while (0)
#define PG8_LDB(dst, b, h) do { _Pragma("unroll") for (int n = 0; n < 2; ++n) dst[n] = PG8_LD8(lds + PG8_SB(b, h) + boff + n * 2048); } while (0)
#define PG8_LO(x) __builtin_bit_cast(bf16x8, __builtin_shufflevector(x, x, 0, 1, 2, 3))
#define PG8_HI(x) __builtin_bit_cast(bf16x8, __builtin_shufflevector(x, x, 4, 5, 6, 7))
#define PG8_MMA(ai, bj, At, Bt) do { if constexpr (FP8) __builtin_amdgcn_sched_barrier(0); __builtin_amdgcn_s_setprio(1); _Pragma("unroll") for (int m = 0; m < 4; ++m) _Pragma("unroll") for (int n = 0; n < 2; ++n) { \
        if constexpr (FP8) asm volatile("v_mfma_scale_f32_16x16x128_f8f6f4 %0, %1, %2, %0, %3, %3 op_sel_hi:[0,0,0]" : "+v"(acc[ai][bj][m][n]) : "v"(Bt[n]), "v"(At[m]), "v"(sc8));   \
        else { acc[ai][bj][m][n] = __builtin_amdgcn_mfma_f32_16x16x32_bf16(PG8_LO(Bt[n]), PG8_LO(At[m]), acc[ai][bj][m][n], 0, 0, 0); \
               acc[ai][bj][m][n] = __builtin_amdgcn_mfma_f32_16x16x32_bf16(PG8_HI(Bt[n]), PG8_HI(At[m]), acc[ai][bj][m][n], 0, 0, 0); } } \
        __builtin_amdgcn_s_setprio(0); if constexpr (FP8) __builtin_amdgcn_sched_barrier(0); } while (0)
#define PG8_WAIT_V(n) asm volatile("s_waitcnt vmcnt(" #n ")" ::: "memory")
#define PG8_WAIT_L(n) asm volatile("s_waitcnt lgkmcnt(" #n ")" ::: "memory")
#define PG8_BAR __builtin_amdgcn_s_barrier()
#define PG8_SCHED __builtin_amdgcn_sched_barrier(0)
    Unit cur, nxt; int ui = 0;
    if (!S.next(0, cur)) return;
    f32x4 acc[2][2][4][2], bvn[2][2];
    E.bias(cur, wc, fq, bvn);
#pragma unroll
    for (int a = 0; a < 2; ++a)
#pragma unroll
        for (int b = 0; b < 2; ++b)
#pragma unroll
            for (int m = 0; m < 4; ++m)
#pragma unroll
                for (int n = 0; n < 2; ++n) acc[a][b][m][n] = bvn[b][n];
    typedef int v4i_ __attribute__((ext_vector_type(4))); typedef int v8i_ __attribute__((ext_vector_type(8)));
    v8i_ At[4], B0[2], B1[2];
    int sc8 = 0x7f7f7f7f; asm volatile("" : "+v"(sc8));
    unsigned vA[2][2], vN[2][2];
    S.a_off(cur, vA);
    const char* cB = S.b_base(cur);
    PG8_STAGEB(PG8_SB(0, 0), cB); PG8_STAGEB(PG8_SB(0, 1), cB + hstep); PG8_STAGEA(PG8_SA(0, 0), vA, 0, 0); PG8_STAGEA(PG8_SA(0, 1), vA, 1, 0);
    if (wr == 1) PG8_BAR;
    PG8_WAIT_V(2); PG8_BAR;
    PG8_STAGEB(PG8_SB(1, 0), cB + kstep); PG8_STAGEA(PG8_SA(1, 0), vA, 0, kstep); PG8_STAGEB(PG8_SB(1, 1), cB + hstep + kstep);
    PG8_WAIT_V(6); PG8_BAR;
    for (;;) {
        const bool has_next = S.next(ui + 1, nxt);
        const char* nB = cB;
#pragma unroll
        for (int h = 0; h < 2; ++h)
#pragma unroll
            for (int i = 0; i < 2; ++i) vN[h][i] = vA[h][i];
        if (has_next) { S.a_off(nxt, vN); nB = S.b_base(nxt); }
#pragma unroll 1
        for (int t = 0; t < nt; t += 2) {
            const bool last = (t == nt - 2);
            const size_t k1 = (size_t)(t + 1) * kstep;
            const size_t k2 = last ? 0 : (size_t)(t + 2) * kstep, k3 = k2 + kstep;
            const char* b2 = last ? nB : cB + (size_t)(t + 2) * kstep; const char* b3 = b2 + kstep;
            PG8_LDB(B0, 0, 0); PG8_LDB(B1, 0, 1); PG8_SCHED; PG8_LDA(At, 0, 0); PG8_STAGEA(PG8_SA(1, 1), vA, 1, k1);
            PG8_WAIT_V(8); PG8_WAIT_L(0); PG8_BAR; PG8_MMA(0, 0, At, B0); PG8_MMA(0, 1, At, B1); PG8_BAR; PG8_SCHED;
            PG8_LDA(At, 0, 1); PG8_STAGEB(PG8_SB(0, 0), b2); PG8_STAGEB(PG8_SB(0, 1), b2 + hstep); PG8_STAGEA2(PG8_SA(0, 0), 0, k2);
            PG8_WAIT_V(8); PG8_WAIT_L(0); PG8_BAR; PG8_MMA(1, 0, At, B0); PG8_MMA(1, 1, At, B1); PG8_BAR; PG8_SCHED;
            PG8_LDB(B0, 1, 0); PG8_LDB(B1, 1, 1); PG8_SCHED; PG8_LDA(At, 1, 0); PG8_STAGEA2(PG8_SA(0, 1), 1, k2);
            PG8_WAIT_V(8); PG8_WAIT_L(0); PG8_BAR; PG8_MMA(0, 0, At, B0); PG8_MMA(0, 1, At, B1); PG8_BAR; PG8_SCHED;
            PG8_LDA(At, 1, 1); PG8_STAGEB(PG8_SB(1, 0), b3); PG8_STAGEB(PG8_SB(1, 1), b3 + hstep); PG8_STAGEA2(PG8_SA(1, 0), 0, k3);
            PG8_WAIT_V(8); PG8_WAIT_L(0); PG8_BAR; PG8_MMA(1, 0, At, B0); PG8_MMA(1, 1, At, B1); PG8_BAR; PG8_SCHED;
        }
        if constexpr (ALIGN_EPI) { if (wr == 0) PG8_BAR; }
        if constexpr (FP8) asm volatile("s_nop 15\n\ts_nop 7" ::: "memory");
        if (has_next) E.bias(nxt, wc, fq, bvn);
        if (!Epi::AFTER_DRAIN || has_next) E(acc, cur, wr, wc, fr, fq);
        if (!has_next) break;
#pragma unroll
        for (int a = 0; a < 2; ++a)
#pragma unroll
            for (int b = 0; b < 2; ++b)
#pragma unroll
                for (int m = 0; m < 4; ++m)
#pragma unroll
                    for (int n = 0; n < 2; ++n) acc[a][b][m][n] = bvn[b][n];
        cur = nxt; cB = nB; ++ui;
#pragma unroll
        for (int h = 0; h < 2; ++h)
#pragma unroll
            for (int i = 0; i < 2; ++i) vA[h][i] = vN[h][i];
        if constexpr (ALIGN_EPI) { if (wr == 1) PG8_BAR; }
    }
    PG8_WAIT_V(0);
    if constexpr (!ALIGN_EPI) { if (wr == 0) PG8_BAR; }
    PG8_BAR;
    if constexpr (Epi::AFTER_DRAIN) E(acc, cur, wr, wc, fr, fq);
#undef PG8_SA
#undef PG8_SB
#undef PG8_STAGEA
#undef PG8_UPTR
#undef PG8_STAGEA2
#undef PG8_STAGEB
#undef PG8_LDA
#undef PG8_LD8
#undef PG8_LO
#undef PG8_HI
#undef PG8_LDB
#undef PG8_MMA
#undef PG8_WAIT_V
#undef PG8_WAIT_L
#undef PG8_BAR
#undef PG8_SCHED
}

typedef const f32x4 (&AccRef)[2][2][4][2];
__device__ __forceinline__ u32x4 pack8(f32x4 a, f32x4 b) { u32x4 w; w.x = cvtpk(a[0], a[1]); w.y = cvtpk(a[2], a[3]); w.z = cvtpk(b[0], b[1]); w.w = cvtpk(b[2], b[3]); return w; }

struct EpiInProj {
    static constexpr bool PERM = true, AFTER_DRAIN = false;
    bf16_t *U, *Q, *Kb, *V; const float* rope;
    __device__ __forceinline__ void bias(const Unit&, int, int, f32x4 (&bv)[2][2]) const { bv[0][0] = bv[0][1] = bv[1][0] = bv[1][1] = (f32x4){0.f, 0.f, 0.f, 0.f}; }
    __device__ __forceinline__ void operator()(AccRef acc, const Unit& u, int wr, int wc, int fr, int fq) const {
        const int row0 = u.pm * BM + wr * 64 + fr;
        if (u.pn < 4) {
#pragma unroll
            for (int ai = 0; ai < 2; ++ai)
#pragma unroll
                for (int m = 0; m < 4; ++m) { const int row = row0 + ai * HALF + m * 16; f32x4 o[2];
#pragma unroll
                    for (int n = 0; n < 2; ++n)
#pragma unroll
                        for (int i = 0; i < 4; ++i) o[n][i] = acc[ai][0][m][n][i] * fsigmoid(acc[ai][1][m][n][i]);
                    st16_wt(U + (size_t)row * DCONV + u.pn * 128 + wc * 32 + 8 * fq, pack8(o[0], o[1])); }
        } else if (u.pn < 8) {
            const bool isq = u.pn < 6; bf16_t* dst = isq ? Q : Kb; const float sc = isq ? QSCALE : 1.0f;
            const int head = 4 * (u.pn & 1) + wc;
#pragma unroll
            for (int ai = 0; ai < 2; ++ai) { f32x4 cs[4][2], sn[4][2];
#pragma unroll
                for (int m = 0; m < 4; ++m) { const int row = row0 + ai * HALF + m * 16;
#pragma unroll
                    for (int n = 0; n < 2; ++n) { cs[m][n] = *(const f32x4*)(rope + (size_t)row * 32 + 8 * fq + 4 * n); sn[m][n] = *(const f32x4*)(rope + (size_t)NTOK * 32 + (size_t)row * 32 + 8 * fq + 4 * n); } }
#pragma unroll
                for (int m = 0; m < 4; ++m) { const int row = row0 + ai * HALF + m * 16; f32x4 lo[2], hi[2];
#pragma unroll
                    for (int n = 0; n < 2; ++n) { const f32x4 a = acc[ai][0][m][n], b = acc[ai][1][m][n];
                        lo[n] = (a * cs[m][n] - b * sn[m][n]) * sc; hi[n] = (b * cs[m][n] + a * sn[m][n]) * sc; }
                    bf16_t* p = dst + (size_t)row * DATT + head * 64 + 8 * fq;
                    st16_wt(p, pack8(lo[0], lo[1])); st16_wt(p + 32, pack8(hi[0], hi[1])); } }
        } else {
#pragma unroll
            for (int ai = 0; ai < 2; ++ai)
#pragma unroll
                for (int m = 0; m < 4; ++m) { const int row = row0 + ai * HALF + m * 16;
#pragma unroll
                    for (int bj = 0; bj < 2; ++bj) st16_wt(V + (size_t)row * DATT + (u.pn - 8) * 256 + bj * 128 + wc * 32 + 8 * fq, pack8(acc[ai][bj][m][0], acc[ai][bj][m][1])); }
        }
    }
};
struct EpiBiasBf16 {
    static constexpr bool PERM = true, AFTER_DRAIN = false;
    bf16_t* O; int ldc; const float* bvec;
    __device__ __forceinline__ void bias(const Unit& u, int wc, int fq, f32x4 (&bv)[2][2]) const {
        const int col0 = u.pn * BM + wc * 32 + 8 * fq;
#pragma unroll
        for (int bj = 0; bj < 2; ++bj)
#pragma unroll
            for (int n = 0; n < 2; ++n) bv[bj][n] = *(const f32x4*)(bvec + col0 + bj * HALF + 4 * n);
    }
    __device__ __forceinline__ void operator()(AccRef acc, const Unit& u, int wr, int wc, int fr, int fq) const {
        const int row0 = u.pm * BM + wr * 64 + fr, col0 = u.pn * BM + wc * 32 + 8 * fq;
#pragma unroll
        for (int ai = 0; ai < 2; ++ai)
#pragma unroll
            for (int m = 0; m < 4; ++m) { bf16_t* rowp = O + (size_t)(row0 + ai * HALF + m * 16) * ldc + col0;
#pragma unroll
                for (int bj = 0; bj < 2; ++bj) st16_wt(rowp + bj * HALF, pack8(acc[ai][bj][m][0], acc[ai][bj][m][1])); }
    }
};
struct EpiPlainBf16 {
    static constexpr bool PERM = true, AFTER_DRAIN = false;
    bf16_t* O; int ldc;
    __device__ __forceinline__ void bias(const Unit&, int, int, f32x4 (&bv)[2][2]) const { bv[0][0] = bv[0][1] = bv[1][0] = bv[1][1] = (f32x4){0.f, 0.f, 0.f, 0.f}; }
    __device__ __forceinline__ void operator()(AccRef acc, const Unit& u, int wr, int wc, int fr, int fq) const {
        const int row0 = u.pm * BM + wr * 64 + fr, col0 = u.pn * BM + wc * 32 + 8 * fq;
#pragma unroll
        for (int ai = 0; ai < 2; ++ai)
#pragma unroll
            for (int m = 0; m < 4; ++m) { bf16_t* rowp = O + (size_t)(row0 + ai * HALF + m * 16) * ldc + col0;
#pragma unroll
                for (int bj = 0; bj < 2; ++bj) st16_wt(rowp + bj * HALF, pack8(acc[ai][bj][m][0], acc[ai][bj][m][1])); }
    }
};
__device__ __forceinline__ u32x4 widen16(u32x2 a, u32x2 b) {
    const auto r0 = __builtin_amdgcn_permlane16_swap(a.x, b.x, false, false); const auto r1 = __builtin_amdgcn_permlane16_swap(a.y, b.y, false, false);
    u32x4 o; o.x = r0[0]; o.y = r1[0]; o.z = r0[1]; o.w = r1[1]; return o;
}
struct EpiSwiglu {
    static constexpr bool PERM = true, AFTER_DRAIN = false;
    unsigned char* H; const float *bg, *bu; const volatile LAS int* tp;
    const MoeOrder* S;
    __device__ __forceinline__ float bias_at(const Unit& u, int tc) const { return (tc < 128 ? bg[(size_t)u.e * DFF + u.pn * 128 + tc] : bu[(size_t)u.e * DFF + u.pn * 128 + tc - 128]) * WSCALE8; }
    __device__ __forceinline__ void bias(const Unit& u, int wc, int fq, f32x4 (&bv)[2][2]) const { S->plan_bias(u, wc, fq, bv); }
    __device__ __forceinline__ void operator()(AccRef acc, const Unit& u, int wr, int wc, int fr, int fq) const {
        const int row0 = __builtin_amdgcn_readfirstlane(tp[u.e]) * BM + u.pm * BM + wr * 64 + fr, col0 = u.pn * 128 + wc * 32 + 8 * fq;
#pragma unroll
        for (int ai = 0; ai < 2; ++ai) { u32x2 w8[4];
#pragma unroll
            for (int m = 0; m < 4; ++m) { f32x4 o[2];
#pragma unroll
                for (int n = 0; n < 2; ++n)
#pragma unroll
                    for (int i = 0; i < 4; i += 2) { const f32x2 ga = {acc[ai][0][m][n][i], acc[ai][0][m][n][i + 1]}, ua = {acc[ai][1][m][n][i], acc[ai][1][m][n][i + 1]};
                        const f32x2 gm = __builtin_elementwise_min(ga, (f32x2){SWI_LIMIT * WSCALE8, SWI_LIMIT * WSCALE8});
                        const f32x2 g = gm * WINV8, ea = gm * (-SWI_ALPHA * 1.4426950408889634f * WINV8);
                        f32x2 ex; ex.x = __builtin_amdgcn_exp2f(ea.x); ex.y = __builtin_amdgcn_exp2f(ea.y);
                        const f32x2 dn = ex + 1.0f; f32x2 rc; rc.x = __builtin_amdgcn_rcpf(dn.x); rc.y = __builtin_amdgcn_rcpf(dn.y);
                        f32x2 u1 = __builtin_elementwise_fma(ua, (f32x2){WINV8, WINV8}, (f32x2){1.0f, 1.0f});
                        u1 = __builtin_elementwise_min(__builtin_elementwise_max(u1, (f32x2){1.0f - SWI_LIMIT, 1.0f - SWI_LIMIT}), (f32x2){1.0f + SWI_LIMIT, 1.0f + SWI_LIMIT});
                        const f32x2 r = (u1 * g) * rc; o[n][i] = r.x; o[n][i + 1] = r.y; }
                w8[m].x = pk4_fp8(o[0][0], o[0][1], o[0][2], o[0][3]); w8[m].y = pk4_fp8(o[1][0], o[1][1], o[1][2], o[1][3]); }
#pragma unroll
            for (int mp = 0; mp < 2; ++mp) { const u32x4 v16 = widen16(w8[2 * mp], w8[2 * mp + 1]);
                *(u32x4*)(H + (size_t)(row0 + ai * HALF + (2 * mp + (fq & 1)) * 16) * DFF + (col0 - 8 * fq + 16 * (fq >> 1))) = v16; } }
    }
};
struct EpiDown {
    static constexpr bool PERM = true, AFTER_DRAIN = false;
    unsigned char* Y; const float* bd; const volatile LAS int* tp;
    const MoeOrder* S;
    __device__ __forceinline__ float bias_at(const Unit& u, int tc) const { return bd[(size_t)u.e * DM + u.pn * BM + tc] * WSCALE8; }
    __device__ __forceinline__ void bias(const Unit& u, int wc, int fq, f32x4 (&bv)[2][2]) const { S->plan_bias(u, wc, fq, bv); }
    __device__ __forceinline__ void operator()(AccRef acc, const Unit& u, int wr, int wc, int fr, int fq) const {
        const int row0 = __builtin_amdgcn_readfirstlane(tp[u.e]) * BM + u.pm * BM + wr * 64 + fr, col0 = u.pn * BM + wc * 32 + 8 * fq;
#pragma unroll
        for (int ai = 0; ai < 2; ++ai)
#pragma unroll
            for (int mp = 0; mp < 2; ++mp)
#pragma unroll
                for (int bj = 0; bj < 2; ++bj) { u32x2 w8[2];
#pragma unroll
                    for (int q = 0; q < 2; ++q) { const f32x4 y0 = acc[ai][bj][2 * mp + q][0] * WINV8, y1 = acc[ai][bj][2 * mp + q][1] * WINV8; w8[q].x = pk4_fp8(y0[0], y0[1], y0[2], y0[3]); w8[q].y = pk4_fp8(y1[0], y1[1], y1[2], y1[3]); }
                    *(u32x4*)(Y + (size_t)(row0 + ai * HALF + (2 * mp + (fq & 1)) * 16) * DM + (col0 - 8 * fq + 16 * (fq >> 1)) + bj * HALF) = widen16(w8[0], w8[1]); }
    }
};
}

#define XB_TMO      128
#define XB_XCNT(j)  (256  + 64 * (j))
#define XB_XSUB(j)  (1280 + 64 * (j))
#define XB_XGEN(j)  (2304 + 64 * (j))
#define XB_TOP      3328
#define XB_TOPGEN   3392
#define XCD_BAR_WORDS 3456
#define XB_SPIN_CAP (1u << 18)
__device__ __forceinline__ unsigned xb_ld(unsigned* p)              { return __hip_atomic_load(p, __ATOMIC_RELAXED, __HIP_MEMORY_SCOPE_AGENT); }
__device__ __forceinline__ unsigned xb_add(unsigned* p, unsigned v) { return __hip_atomic_fetch_add(p, v, __ATOMIC_RELAXED, __HIP_MEMORY_SCOPE_AGENT); }
__device__ __forceinline__ unsigned xb_xcc_id() { return (unsigned)__builtin_amdgcn_s_getreg((3 << 11) | 20) & 0xFu; }
#define XB_SPIN(cond, bar) do { unsigned _sp = 0; while (cond) { __builtin_amdgcn_s_sleep(1); \
    if ((++_sp & 255u) == 0u) { if (xb_ld(&(bar)[XB_TMO])) break; if (_sp > XB_SPIN_CAP) { atomicAdd(&(bar)[XB_TMO], 1u); break; } } } } while (0)
struct XcdBarrier { unsigned* bar; unsigned x; volatile LAS unsigned* st; };
__device__ __forceinline__ XcdBarrier xcd_barrier_post(unsigned* bar, volatile LAS unsigned* st) {
    XcdBarrier b; b.bar = bar; b.x = xb_xcc_id(); b.st = st;
    if (threadIdx.x == 0) (void)xb_add(&bar[XB_XCNT(b.x)], 1u);
    return b;
}
__device__ __forceinline__ void xcd_barrier_complete(unsigned* bar, unsigned x, unsigned& nloc, unsigned& nx) {
    const unsigned G = gridDim.x * gridDim.y * gridDim.z;
    unsigned sum, cnt, mine, sp = 0u;
    for (;;) {
        sum = 0u; cnt = 0u; mine = 0u;
#pragma unroll
        for (unsigned j = 0; j < 16; ++j) { const unsigned c = xb_ld(&bar[XB_XCNT(j)]); sum += c; cnt += (c > 0u) ? 1u : 0u; mine = (j == x) ? c : mine; }
        if (sum == G) break;
        __builtin_amdgcn_s_sleep(1);
        if ((++sp & 255u) == 0u) { if (xb_ld(&bar[XB_TMO])) break; if (sp > XB_SPIN_CAP) { atomicAdd(&bar[XB_TMO], 1u); break; } }
    }
    nloc = mine > 0u ? mine : 1u; nx = cnt > 0u ? cnt : 1u;
}
__device__ __forceinline__ void xcd_barrier(const XcdBarrier& b) {
    asm volatile("s_waitcnt vmcnt(0)" ::: "memory");
    __syncthreads();
    if (threadIdx.x == 0) {
        unsigned* bar = b.bar;
        __builtin_amdgcn_s_waitcnt(0);
        unsigned nloc = b.st[0], nx = b.st[1];
        if (nloc == 0u) { xcd_barrier_complete(bar, b.x, nloc, nx); b.st[0] = nloc; b.st[1] = nx; }
        const unsigned old = xb_add(&bar[XB_XSUB(b.x)], 1u);
        const unsigned gen = old / nloc;
        if (old + 1u == (gen + 1u) * nloc) {
            __builtin_amdgcn_fence(__ATOMIC_RELEASE, "agent");
            asm volatile("s_waitcnt vmcnt(0)" ::: "memory");
            const unsigned og = xb_add(&bar[XB_TOP], 1u);
            const unsigned tg = og / nx;
            if (og + 1u == (tg + 1u) * nx) xb_add(&bar[XB_TOPGEN], 1u);
            else XB_SPIN(xb_ld(&bar[XB_TOPGEN]) == tg, bar);
            __builtin_amdgcn_fence(__ATOMIC_ACQUIRE, "agent");
            xb_add(&bar[XB_XGEN(b.x)], 1u);
            asm volatile("s_waitcnt vmcnt(0)" ::: "memory");
        } else {
            XB_SPIN(xb_ld(&bar[XB_XGEN(b.x)]) == gen, bar);
            __builtin_amdgcn_fence(__ATOMIC_ACQUIRE, "agent");
            asm volatile("s_waitcnt vmcnt(0)" ::: "memory");
        }
    }
    __syncthreads();
}

struct Args { const void* in[22]; float* out; unsigned char* ws; int ph_lo, ph_hi, li, pad; };
struct Frame {
    LAS unsigned char* lds; volatile LAS unsigned* MISC; gu32* ctl;
    int tid, lane, wave, vcu, G;
    bool bg, conv; int wc8, cidx;
    unsigned char* ws;
};

template <class RowMap>
__device__ __forceinline__ void tr_item(const float* W, int N, int K, bf16_t* WT, const RowMap& rm, LAS float* scr, int k0, int n0, int lane) {
    const int n4 = lane & 15, kr = lane >> 4;
    f32x4 v[16];
#pragma unroll
    for (int i = 0; i < 16; ++i) v[i] = *(const GAS f32x4*)(W + (size_t)(k0 + kr + 4 * i) * N + n0 + 4 * n4);
#pragma unroll
    for (int i = 0; i < 16; ++i) { LAS float* p = scr + (kr + 4 * i) * 65 + 4 * n4; p[0] = v[i][0]; p[1] = v[i][1]; p[2] = v[i][2]; p[3] = v[i][3]; }
    LDS_WAIT(); asm volatile("" ::: "memory");
    const int c = (lane & 3) + 4 * (lane >> 5), nn = (lane >> 2) & 7;
#pragma unroll
    for (int it = 0; it < 8; ++it) { const int n = nn + 8 * it; const LAS float* s = scr + (8 * c) * 65 + n;
        u32x4 o; o.x = cvtpk(s[0], s[65]); o.y = cvtpk(s[2 * 65], s[3 * 65]); o.z = cvtpk(s[4 * 65], s[5 * 65]); o.w = cvtpk(s[6 * 65], s[7 * 65]);
        *(GAS u32x4*)(WT + (size_t)rm(n0 + n) * K + k0 + 8 * c) = o; }
    LDS_WAIT(); asm volatile("" ::: "memory");
}
template <class RowMap>
__device__ __forceinline__ void tr_item8(const float* W, int N, int K, unsigned char* WT, const RowMap& rm, LAS float* scr, int k0, int n0, int lane, float scale) {
    const int n4 = lane & 15, kr = lane >> 4;
    f32x4 v[16];
#pragma unroll
    for (int i = 0; i < 16; ++i) v[i] = *(const GAS f32x4*)(W + (size_t)(k0 + kr + 4 * i) * N + n0 + 4 * n4);
#pragma unroll
    for (int i = 0; i < 16; ++i) { LAS float* p = scr + (kr + 4 * i) * 65 + 4 * n4; p[0] = v[i][0] * scale; p[1] = v[i][1] * scale; p[2] = v[i][2] * scale; p[3] = v[i][3] * scale; }
    LDS_WAIT(); asm volatile("" ::: "memory");
    const int c = (lane & 1) + 2 * (lane >> 5), nn = (lane >> 1) & 15;
#pragma unroll
    for (int it = 0; it < 4; ++it) { const int n = nn + 16 * it; const LAS float* s = scr + (16 * c) * 65 + n;
        u32x4 o; o.x = pk4_fp8(s[0], s[65], s[2 * 65], s[3 * 65]); o.y = pk4_fp8(s[4 * 65], s[5 * 65], s[6 * 65], s[7 * 65]);
        o.z = pk4_fp8(s[8 * 65], s[9 * 65], s[10 * 65], s[11 * 65]); o.w = pk4_fp8(s[12 * 65], s[13 * 65], s[14 * 65], s[15 * 65]);
        *(GAS u32x4*)(WT + (size_t)rm(n0 + n) * K + k0 + 16 * c) = o; }
    LDS_WAIT(); asm volatile("" ::: "memory");
}
struct MapIdent { int off; __device__ __forceinline__ int operator()(int n) const { return off + n; } };
struct MapGateUp { int off; __device__ __forceinline__ int operator()(int n) const { return off + 256 * (n >> 7) + (n & 127); } };
struct MapInProj { __device__ __forceinline__ int operator()(int n) const {
    if (n < 512) return 256 * (n >> 7) + (n & 127);
    if (n < 1024) { const int c = n - 512; return 256 * (c >> 7) + 128 + (c & 127); }
    if (n < 2048) { const int c = (n - 1024) & 511, h = c >> 6, d = c & 63; return 256 * ((n < 1536 ? 4 : 6) + (h >> 2)) + 128 * (d >> 5) + (h & 3) * 32 + (d & 31); }
    return n; } };

__device__ __forceinline__ void sincos_d(double a, float& c, float& s) {
    const double TWO_PI = 6.283185307179586476925286766559, INV = 0.15915494309189533576888376337251;
    const double n = __builtin_rint(a * INV); double r = __builtin_fma(-n, TWO_PI, a); r = __builtin_fma(-n, 2.4492935982947064e-16, r) ;
    const double r2 = r * r; double sp = 0.0, cp = 0.0;
#pragma unroll
    for (int k = 13; k >= 1; --k) { sp = (sp + 1.0) * (r2 * (-1.0 / (double)((2 * k) * (2 * k + 1)))); cp = (cp + 1.0) * (r2 * (-1.0 / (double)((2 * k - 1) * (2 * k)))); }
    s = (float)(r * (1.0 + sp)); c = (float)(1.0 + cp);
}

constexpr int CV_I_IN = 16 * 40, CV_I_PW = 8 * 8, CV_I_OUT = 16 * 16, CV_I_E = 16 * 16;
constexpr int CV_NEXP = NEXP * 3 * CV_I_E, CV_NITEMS = CV_NEXP + CV_I_IN + CV_I_PW + CV_I_OUT;
constexpr int NCONVX = 4, NCONV = 8 * NCONVX, NWORK = 256 - NCONV;
#ifndef WD_P3_
#define WD_P3_ 2048
#endif
constexpr int WD_P3 = WD_P3_;
#ifndef P1_GT_
#define P1_GT_ 1280
#endif
constexpr int P1_GT = P1_GT_;
constexpr int P1_NG = 20;
#ifndef CV_NTAIL_
#define CV_NTAIL_ 6144
#endif
constexpr int CV_NTAIL = CV_NTAIL_;
#ifndef CV_S1_
#define CV_S1_ 5600
#define CV_S2_ 9400
#define CV_S3_ 11300
#endif
constexpr int CV_S1 = CV_S1_, CV_S2 = CV_S2_, CV_S3 = CV_S3_;
struct CvItem { const float* W; unsigned char* dst; int N, K, k0, n0, mode; };
__device__ __forceinline__ CvItem cv_decode(const Args& a, unsigned char* ws, int r) {
    CvItem c;
    if (r < CV_NEXP) {
        const int e = r / (3 * CV_I_E), q = r % (3 * CV_I_E), which = q / CV_I_E, t = q % CV_I_E; c.k0 = 64 * (t / 16); c.n0 = 64 * (t % 16); c.mode = which; c.N = DM; c.K = DM;
        if (which == 0) { c.W = (const float*)a.in[14] + (size_t)e * DM * DFF; c.dst = ws + WS_WGU + (size_t)e * 2048 * DM; }
        else if (which == 1) { c.W = (const float*)a.in[16] + (size_t)e * DM * DFF; c.dst = ws + WS_WGU + (size_t)e * 2048 * DM; }
        else { c.W = (const float*)a.in[18] + (size_t)e * DFF * DM; c.dst = ws + WS_WD + (size_t)e * DM * DFF; }
        return c; }
    r -= CV_NEXP;
    if (r < CV_I_IN) { c.W = (const float*)a.in[2]; c.dst = ws + WS_WIN; c.N = NPROJ; c.K = DM; c.k0 = 64 * (r / 40); c.n0 = 64 * (r % 40); c.mode = 3; return c; } r -= CV_I_IN;
    if (r < CV_I_PW) { c.W = (const float*)a.in[7]; c.dst = ws + WS_WPW; c.N = DCONV; c.K = DCONV; c.k0 = 64 * (r / 8); c.n0 = 64 * (r % 8); c.mode = 4; return c; } r -= CV_I_PW;
    c.W = (const float*)a.in[9]; c.dst = ws + WS_WOUT; c.N = DM; c.K = DM; c.k0 = 64 * (r / 16); c.n0 = 64 * (r % 16); c.mode = 5; return c;
}
__device__ __forceinline__ void cv_load(const CvItem& c, int lane, f32x4 (&v)[16]) {
    const int n4 = lane & 15, kr = lane >> 4;
#pragma unroll
    for (int i = 0; i < 16; ++i) v[i] = *(const GAS f32x4*)(c.W + (size_t)(c.k0 + kr + 4 * i) * c.N + c.n0 + 4 * n4);
}
__device__ __forceinline__ int cv_row(int mode, int n) {
    if (mode == 0) return 256 * (n >> 7) + (n & 127);
    if (mode == 1) return 128 + 256 * (n >> 7) + (n & 127);
    if (mode == 3) return MapInProj{}(n);
    return n;
}
template <int REMAP>
__device__ __forceinline__ int cv_remap(int j) { return REMAP == 1 ? (j >> 9) * 768 + (j & 511) : REMAP == 2 ? (j >> 8) * 768 + 512 + (j & 255) : j; }
template <int REMAP = 0>
__device__ __forceinline__ void convert_items(Frame& F, const Args& a, int first, int last, int wg, int NWG) {
    const int lane = F.lane, p = F.wave & 3; const bool loader = F.wave < 4;
    const int stride = NWG * 4, base = first + wg * 4 + p;
    const int span = last - first - wg * 4; const int nsteps = span <= 0 ? 0 : (span + stride - 1) / stride;
    if (nsteps == 0) return;
    LAS float* slot0 = (LAS float*)(F.lds + (p * 2 + 0) * 16640); LAS float* slot1 = (LAS float*)(F.lds + (p * 2 + 1) * 16640);
    const int n4 = lane & 15, kr = lane >> 4;
    f32x4 vA[16], vB[16], vC[16]; CvItem cA, cB, cC; cA = cv_decode(a, F.ws, cv_remap<REMAP>(base < last ? base : first)); cB = cA; cC = cA;
    if (loader) { if (base < last) cv_load(cA, lane, vA); if (base + stride < last) { cB = cv_decode(a, F.ws, cv_remap<REMAP>(base + stride)); cv_load(cB, lane, vB); }
                  if (base + 2 * stride < last) { cC = cv_decode(a, F.ws, cv_remap<REMAP>(base + 2 * stride)); cv_load(cC, lane, vC); } }
#define CV_LOADER_STEP(vX, cX, slotX, s_) do { const int it_ = base + (s_) * stride; if (it_ < last) { const float sc = cX.mode < 3 ? WSCALE8 : 1.0f; \
        _Pragma("unroll") for (int i = 0; i < 16; ++i) { LAS float* q_ = slotX + (kr + 4 * i) * 65 + 4 * n4; q_[0] = vX[i][0] * sc; q_[1] = vX[i][1] * sc; q_[2] = vX[i][2] * sc; q_[3] = vX[i][3] * sc; } \
        LDS_WAIT(); if (it_ + 3 * stride < last) { cX = cv_decode(a, F.ws, cv_remap<REMAP>(it_ + 3 * stride)); cv_load(cX, lane, vX); } } } while (0)
#define CV_STORER_STEP(slotX, s_) do { const int it_ = base + (s_) * stride; if (it_ < last) { const CvItem cur = cv_decode(a, F.ws, cv_remap<REMAP>(it_)); \
        if (cur.mode < 3) { const int c = (lane & 1) + 2 * (lane >> 5), nn = (lane >> 1) & 15; \
            _Pragma("unroll") for (int q = 0; q < 4; ++q) { const int n = nn + 16 * q; const LAS float* s2 = slotX + (16 * c) * 65 + n; \
                u32x4 o; o.x = pk4_fp8(s2[0], s2[65], s2[2 * 65], s2[3 * 65]); o.y = pk4_fp8(s2[4 * 65], s2[5 * 65], s2[6 * 65], s2[7 * 65]); \
                o.z = pk4_fp8(s2[8 * 65], s2[9 * 65], s2[10 * 65], s2[11 * 65]); o.w = pk4_fp8(s2[12 * 65], s2[13 * 65], s2[14 * 65], s2[15 * 65]); \
                *(GAS u32x4*)(cur.dst + (size_t)cv_row(cur.mode, cur.n0 + n) * cur.K + cur.k0 + 16 * c) = o; } \
        } else { const int c = (lane & 3) + 4 * (lane >> 5), nn = (lane >> 2) & 7; \
            _Pragma("unroll") for (int q = 0; q < 8; ++q) { const int n = nn + 8 * q; const LAS float* s2 = slotX + (8 * c) * 65 + n; \
                u32x4 o; o.x = cvtpk(s2[0], s2[65]); o.y = cvtpk(s2[2 * 65], s2[3 * 65]); o.z = cvtpk(s2[4 * 65], s2[5 * 65]); o.w = cvtpk(s2[6 * 65], s2[7 * 65]); \
                *(GAS u32x4*)((bf16_t*)cur.dst + (size_t)cv_row(cur.mode, cur.n0 + n) * cur.K + cur.k0 + 8 * c) = o; } } \
        LDS_WAIT(); } } while (0)
#define CV_BAR() do { asm volatile("s_waitcnt lgkmcnt(0)" ::: "memory"); __builtin_amdgcn_s_barrier(); asm volatile("" ::: "memory"); } while (0)
    if (loader) {
        for (int s_ = 0; s_ < nsteps; s_ += 6) {
            CV_LOADER_STEP(vA, cA, slot0, s_); CV_BAR();
            if (s_ + 1 < nsteps) { CV_LOADER_STEP(vB, cB, slot1, s_ + 1); CV_BAR(); }
            if (s_ + 2 < nsteps) { CV_LOADER_STEP(vC, cC, slot0, s_ + 2); CV_BAR(); }
            if (s_ + 3 < nsteps) { CV_LOADER_STEP(vA, cA, slot1, s_ + 3); CV_BAR(); }
            if (s_ + 4 < nsteps) { CV_LOADER_STEP(vB, cB, slot0, s_ + 4); CV_BAR(); }
            if (s_ + 5 < nsteps) { CV_LOADER_STEP(vC, cC, slot1, s_ + 5); CV_BAR(); }
        }
    } else {
        for (int s_ = 0; s_ < nsteps; s_ += 2) {
            CV_BAR(); CV_STORER_STEP(slot0, s_);
            if (s_ + 1 < nsteps) { CV_BAR(); CV_STORER_STEP(slot1, s_ + 1); }
        }
    }
    CV_BAR();
#undef CV_LOADER_STEP
#undef CV_STORER_STEP
#undef CV_BAR
}
__device__ __forceinline__ void p0_prologue(Frame& F, const Args& a) {
    const int gw = F.vcu * 8 + F.wave, NGW = F.G * 8;
    const float* x = (const float*)a.in[0]; bf16_t* XB = (bf16_t*)(F.ws + WS_XB);
    const int* pos = (const int*)a.in[1]; float* rope = (float*)(F.ws + WS_ROPE);
    for (int m0 = gw; m0 < NTOK; m0 += 8 * NGW) {
        f32x4 v[8][4];
#pragma unroll
        for (int k = 0; k < 8; ++k) { const int m = m0 + k * NGW; if (m < NTOK) {
#pragma unroll
            for (int j = 0; j < 4; ++j) v[k][j] = ((const GAS f32x4*)(x + (size_t)m * DM) + F.lane)[64 * j]; } }
        if (m0 == gw) {
            const int i = F.tid & 31;
            double inv_freq = 1.0;
            for (int q = 0; q < i; ++q) inv_freq *= 0.7498942093324558;
            for (int idx = (F.vcu * 512 + F.tid); idx < NTOK * 32; idx += F.G * 512) {
                float c, s_; sincos_d((double)pos[idx >> 5] * inv_freq, c, s_);
                rope[idx] = c; rope[NTOK * 32 + idx] = s_;
            }
            const float* rw = (const float*)a.in[12]; bf16_t* WrT = (bf16_t*)(F.ws + WS_WRT);
            for (int idx = F.vcu * 512 + F.tid; idx < NEXP * DM; idx += F.G * 512) { const int e = idx >> 10, k = idx & 1023; const float wv = rw[k * NEXP + e]; const unsigned hb = cvtpk(wv, 0.f) & 0xffffu;
                WrT[idx] = (bf16_t)hb; WrT[NEXP * DM + idx] = (bf16_t)(cvtpk(wv - bf2f((bf16_t)hb), 0.f) & 0xffffu); }
        }
#pragma unroll
        for (int k = 0; k < 8; ++k) { const int m = m0 + k * NGW; if (m < NTOK) { GAS u32x2* o = (GAS u32x2*)(XB + (size_t)m * DM) + F.lane;
#pragma unroll
            for (int j = 0; j < 4; ++j) { u32x2 w; w.x = cvtpk(v[k][j][0], v[k][j][1]); w.y = cvtpk(v[k][j][2], v[k][j][3]); o[64 * j] = w; } } }
    }
    convert_items(F, a, F.G == 256 ? CV_NEXP : 0, CV_NITEMS, F.vcu, F.G);
}

namespace att {
constexpr int L_K = 0, L_V = 49152, L_WS = 98304, L_OST = L_WS + 8 * 256, L_END = L_OST + 8 * 4096;
__device__ __forceinline__ int crow(int r, int hi) { return (r & 3) + 8 * (r >> 2) + 4 * hi; }
__device__ __forceinline__ s16x4 vtr(const LAS char* p) { typedef short v4i16_t __attribute__((ext_vector_type(4))); return __builtin_bit_cast(s16x4, __builtin_amdgcn_ds_read_tr16_b64_v4i16((LAS v4i16_t*)p)); }
__device__ __forceinline__ void attn_unit(int b, int h, int br, int blk, const bf16_t* Q, const bf16_t* K, const bf16_t* V, bf16_t* OB, float* LSE, LAS unsigned char* lds) {
    const int tid = threadIdx.x, lane = tid & 63, r32 = lane & 31, hi = lane >> 5; const int wid = __builtin_amdgcn_readfirstlane(tid >> 6);
    const int d = 1 << (2 * br), per = 32 >> (2 * br), res = blk / per, i0 = 256 * (blk % per), kbase = i0 - 128;
    const int rowbase = b * SEQ + res;
#pragma unroll
    for (int T = 0; T < 6; ++T) {
        int sp = kbase + 64 * T + lane; sp = sp < 0 ? 0 : sp;
        const bf16_t* ks = K + (size_t)(rowbase + d * sp) * DATT + h * 64 + wid * 8;
        __builtin_amdgcn_global_load_lds((const unsigned*)ks, (LAS unsigned*)(lds + L_K + T * 8192 + wid * 1024), 16, 0, 0);
        int sv = kbase + 64 * T + 16 * (wid & 3) + (lane >> 2); sv = sv < 0 ? 0 : sv;
        const bf16_t* vs = V + (size_t)(rowbase + d * sv) * DATT + h * 64 + (wid >> 2) * 32 + (lane & 3) * 8;
        __builtin_amdgcn_global_load_lds((const unsigned*)vs, (LAS unsigned*)(lds + L_V + T * 8192 + wid * 1024), 16, 0, 0);
    }
    const int qsub = i0 + 32 * wid;
    const size_t qtok = (size_t)(rowbase + d * (qsub + r32));
    bf16x8 qr[4];
#pragma unroll
    for (int d0 = 0; d0 < 4; ++d0) qr[d0] = *(const bf16x8*)(Q + qtok * DATT + h * 64 + d0 * 16 + hi * 8);
    asm volatile("s_waitcnt vmcnt(0)" ::: "memory");
    __syncthreads();
    const int jmin = (i0 == 0) ? ((4 - wid) > 0 ? (4 - wid) : 0) : 0;
    f32x16 s[5];
    const float NEG = -INFINITY;
#pragma unroll
    for (int j = 0; j < 5; ++j) {
        if (j >= jmin) {
            const int tt = wid + j, T = tt >> 1, sub = tt & 1;
            const LAS unsigned char* kb = lds + L_K + T * 8192 + hi * 1024 + (32 * sub + r32) * 16;
            f32x16 acc = {};
#pragma unroll
            for (int d0 = 0; d0 < 4; ++d0) { const bf16x8 kf = *(const LAS bf16x8*)(kb + d0 * 2048); acc = __builtin_amdgcn_mfma_f32_32x32x16_bf16(kf, qr[d0], acc, 0, 0, 0); }
            if (j == 0) {
#pragma unroll
                for (int r = 0; r < 16; ++r) if (crow(r, hi) < r32) acc[r] = NEG;
            }
            if (j == 4) {
#pragma unroll
                for (int r = 0; r < 16; ++r) if (crow(r, hi) > r32) acc[r] = NEG;
            }
            s[j] = acc;
        } else {
#pragma unroll
            for (int r = 0; r < 16; ++r) s[j][r] = NEG;
        }
    }
    float m = NEG;
#pragma unroll
    for (int j = 0; j < 5; ++j)
#pragma unroll
        for (int r = 0; r < 16; ++r) m = fmaxf(m, s[j][r]);
    m = fmaxf(m, __shfl_xor(m, 32));
    float l = 0.f;
#pragma unroll
    for (int j = 0; j < 5; ++j)
#pragma unroll
        for (int r = 0; r < 16; ++r) { const float p = __builtin_amdgcn_exp2f(s[j][r] - m); s[j][r] = p; l += p; }
    l += __shfl_xor(l, 32);
    f32x16 o[2]; o[0] = f32x16{}; o[1] = f32x16{};
#pragma unroll
    for (int j = 0; j < 5; ++j) {
        if (j >= jmin) {
            const int tt = wid + j, T = tt >> 1, sub = tt & 1;
            const LAS char* vb = (const LAS char*)lds + L_V + T * 8192 + ((lane >> 4) & 1) * 32 + (lane & 3) * 8 + (32 * sub + 4 * hi + ((lane & 15) >> 2)) * 64;
#pragma unroll
            for (int ks = 0; ks < 2; ++ks) {
                u32x4 pw; pw.x = cvtpk(s[j][8 * ks + 0], s[j][8 * ks + 1]); pw.y = cvtpk(s[j][8 * ks + 2], s[j][8 * ks + 3]); pw.z = cvtpk(s[j][8 * ks + 4], s[j][8 * ks + 5]); pw.w = cvtpk(s[j][8 * ks + 6], s[j][8 * ks + 7]);
                const bf16x8 pa = __builtin_bit_cast(bf16x8, pw);
#pragma unroll
                for (int dh = 0; dh < 2; ++dh) {
                    const s16x4 lo = vtr(vb + dh * 4096 + ks * 1024), hi4 = vtr(vb + dh * 4096 + ks * 1024 + 512);
                    const bf16x8 vf = (bf16x8){lo[0], lo[1], lo[2], lo[3], hi4[0], hi4[1], hi4[2], hi4[3]};
                    o[dh] = __builtin_amdgcn_mfma_f32_32x32x16_bf16(pa, vf, o[dh], 0, 0, 0);
                }
            }
        }
    }
    LAS float* wsf = (LAS float*)(lds + L_WS) + wid * 64;
    if (hi == 0) wsf[r32] = __builtin_amdgcn_rcpf(l);
    LDS_WAIT(); asm volatile("" ::: "memory");
    LAS bf16_t* stg = (LAS bf16_t*)(lds + L_OST) + wid * 2048;
#pragma unroll
    for (int r = 0; r < 16; ++r) { const int orow = crow(r, hi); const float rl = wsf[orow];
#pragma unroll
        for (int dh = 0; dh < 2; ++dh) stg[orow * 64 + dh * 32 + r32] = (bf16_t)(cvtpk(o[dh][r] * rl, 0.f) & 0xffffu); }
    LDS_WAIT(); asm volatile("" ::: "memory");
    bf16_t* Ob = OB + (size_t)br * NTOK * DATT;
#pragma unroll
    for (int i = 0; i < 4; ++i) { const int row = i * 8 + (lane >> 3), ch = lane & 7; const u32x4 v = *(const LAS u32x4*)(stg + row * 64 + ch * 8);
        st16_wt(Ob + (size_t)(rowbase + d * (qsub + row)) * DATT + h * 64 + ch * 8, v); }
    if (hi == 0) LSE[((size_t)br * NTOK + qtok) * 8 + h] = m + __builtin_amdgcn_logf(l);
    __syncthreads();
}
struct UnitGeo { int rowbase, d, i0, h, br; };
__device__ __forceinline__ UnitGeo unit_geo(int j_in_xcd, int xcd) {
    const int bh = 2 * xcd + j_in_xcd / 96, jj = j_in_xcd % 96, br = jj >> 5, blk = jj & 31;
    UnitGeo g; g.br = br; g.h = bh & 7; g.d = 1 << (2 * br); const int per = 32 >> (2 * br); g.rowbase = (bh >> 3) * SEQ + blk / per; g.i0 = 256 * (blk % per); return g;
}
__device__ __forceinline__ void glds16(const void* gsrc, unsigned lds_dst) { unsigned keep;
    asm volatile("s_mov_b32 %0, m0\n\ts_mov_b32 m0, %2\n\ts_nop 0\n\tglobal_load_lds_dwordx4 %1, off\n\ts_mov_b32 m0, %0" : "=&s"(keep) : "v"(gsrc), "s"(lds_dst) : "memory"); }
__device__ __forceinline__ void dma_k(const UnitGeo& g, const bf16_t* K, unsigned ldsb, int wid, int lane) {
#pragma unroll
    for (int T = 0; T < 6; ++T) { int sp = g.i0 - 128 + 64 * T + lane; sp = sp < 0 ? 0 : sp;
        glds16(K + (size_t)(g.rowbase + g.d * sp) * DATT + g.h * 64 + wid * 8, (unsigned)__builtin_amdgcn_readfirstlane((int)(ldsb + L_K + T * 8192 + wid * 1024))); }
}
__device__ __forceinline__ void dma_v(const UnitGeo& g, const bf16_t* V, unsigned ldsb, int wid, int lane) {
#pragma unroll
    for (int T = 0; T < 6; ++T) { int sv = g.i0 - 128 + 64 * T + 16 * (wid & 3) + (lane >> 2); sv = sv < 0 ? 0 : sv;
        glds16(V + (size_t)(g.rowbase + g.d * sv) * DATT + g.h * 64 + (wid >> 2) * 32 + (lane & 3) * 8, (unsigned)__builtin_amdgcn_readfirstlane((int)(ldsb + L_V + T * 8192 + wid * 1024))); }
}
__device__ __forceinline__ void load_q(const UnitGeo& g, const bf16_t* Q, int wid, int r32, int hi, bf16x8 (&qr)[4]) {
    const bf16_t* qp = Q + (size_t)(g.rowbase + g.d * (g.i0 + 32 * wid + r32)) * DATT + g.h * 64 + hi * 8;
#pragma unroll
    for (int d0 = 0; d0 < 4; ++d0) asm volatile("global_load_dwordx4 %0, %1, off offset:%c2" : "=v"(qr[d0]) : "v"(qp), "i"(d0 * 32) : "memory");
}
__device__ __forceinline__ void attn_units(int j0, int jstep, int xcd, const bf16_t* Q, const bf16_t* K, const bf16_t* V, bf16_t* OB, float* LSE, LAS unsigned char* lds) {
    const int tid = threadIdx.x, lane = tid & 63, r32 = lane & 31, hi = lane >> 5; const int wid = __builtin_amdgcn_readfirstlane(tid >> 6);
    const unsigned ldsb = (unsigned)(size_t)lds;
    if (j0 >= 192) return;
    UnitGeo g = unit_geo(j0, xcd);
    bf16x8 qr[4];
    asm volatile("s_waitcnt vmcnt(0) lgkmcnt(0)" ::: "memory");
    dma_k(g, K, ldsb, wid, lane); load_q(g, Q, wid, r32, hi, qr);
    for (int j = j0; j < 192; j += jstep) {
        const int d = g.d, i0 = g.i0, h = g.h, br = g.br, rowbase = g.rowbase;
        dma_v(g, V, ldsb, wid, lane);
        asm volatile("s_waitcnt vmcnt(6)" : "+v"(qr[0]), "+v"(qr[1]), "+v"(qr[2]), "+v"(qr[3]) :: "memory");
        __builtin_amdgcn_s_barrier(); asm volatile("" ::: "memory");
        const int qsub = i0 + 32 * wid; const size_t qtok = (size_t)(rowbase + d * (qsub + r32));
        const int jmin = (i0 == 0) ? ((4 - wid) > 0 ? (4 - wid) : 0) : 0;
        f32x16 s[5]; const float NEG = -INFINITY;
#pragma unroll
        for (int t5 = 0; t5 < 5; ++t5) {
            const int tt = wid + t5, T = tt >> 1, sub = tt & 1;
            const LAS unsigned char* kb = lds + L_K + T * 8192 + hi * 1024 + (32 * sub + r32) * 16;
            bf16x8 kf[4];
#pragma unroll
            for (int d0 = 0; d0 < 4; ++d0) kf[d0] = *(const LAS bf16x8*)(kb + d0 * 2048);
            const float tbias = (t5 >= jmin) ? 0.f : NEG;
            f32x16 acc;
#pragma unroll
            for (int r = 0; r < 16; ++r) acc[r] = tbias;
#pragma unroll
            for (int d0 = 0; d0 < 4; ++d0) acc = __builtin_amdgcn_mfma_f32_32x32x16_bf16(kf[d0], qr[d0], acc, 0, 0, 0);
            if (t5 == 0) {
#pragma unroll
                for (int r = 0; r < 16; ++r) acc[r] = (crow(r, hi) < r32) ? NEG : acc[r];
            }
            if (t5 == 4) {
#pragma unroll
                for (int r = 0; r < 16; ++r) acc[r] = (crow(r, hi) > r32) ? NEG : acc[r];
            }
            s[t5] = acc;
        }
        float m = NEG;
#pragma unroll
        for (int t5 = 0; t5 < 5; ++t5)
#pragma unroll
            for (int r = 0; r < 16; ++r) m = fmaxf(m, s[t5][r]);
        m = fmaxf(m, __shfl_xor(m, 32));
        float l = 0.f;
#pragma unroll
        for (int t5 = 0; t5 < 5; ++t5)
#pragma unroll
            for (int r = 0; r < 16; ++r) { const float p = __builtin_amdgcn_exp2f(s[t5][r] - m); s[t5][r] = p; l += p; }
        l += __shfl_xor(l, 32);
        asm volatile("s_waitcnt vmcnt(0) lgkmcnt(0)" ::: "memory");
        __builtin_amdgcn_s_barrier(); asm volatile("" ::: "memory");
        const bool more = (j + jstep) < 192;
        UnitGeo gn = g;
        if (more) { gn = unit_geo(j + jstep, xcd); dma_k(gn, K, ldsb, wid, lane); load_q(gn, Q, wid, r32, hi, qr); }
        f32x16 o[2]; o[0] = f32x16{}; o[1] = f32x16{};
#pragma unroll
        for (int t5 = 0; t5 < 5; ++t5) {
            const int tt = wid + t5, T = tt >> 1, sub = tt & 1;
            const LAS char* vb = (const LAS char*)lds + L_V + T * 8192 + ((lane >> 4) & 1) * 32 + (lane & 3) * 8 + (32 * sub + 4 * hi + ((lane & 15) >> 2)) * 64;
            s16x4 lo[2][2], hi4[2][2];
#pragma unroll
            for (int ks = 0; ks < 2; ++ks)
#pragma unroll
                for (int dh = 0; dh < 2; ++dh) { lo[ks][dh] = vtr(vb + dh * 4096 + ks * 1024); hi4[ks][dh] = vtr(vb + dh * 4096 + ks * 1024 + 512); }
#pragma unroll
            for (int ks = 0; ks < 2; ++ks) {
                u32x4 pw; pw.x = cvtpk(s[t5][8 * ks + 0], s[t5][8 * ks + 1]); pw.y = cvtpk(s[t5][8 * ks + 2], s[t5][8 * ks + 3]); pw.z = cvtpk(s[t5][8 * ks + 4], s[t5][8 * ks + 5]); pw.w = cvtpk(s[t5][8 * ks + 6], s[t5][8 * ks + 7]);
                const bf16x8 pa = __builtin_bit_cast(bf16x8, pw);
#pragma unroll
                for (int dh = 0; dh < 2; ++dh) {
                    const bf16x8 vf = (bf16x8){lo[ks][dh][0], lo[ks][dh][1], lo[ks][dh][2], lo[ks][dh][3], hi4[ks][dh][0], hi4[ks][dh][1], hi4[ks][dh][2], hi4[ks][dh][3]};
                    o[dh] = __builtin_amdgcn_mfma_f32_32x32x16_bf16(pa, vf, o[dh], 0, 0, 0);
                }
            }
        }
        LAS float* wsf = (LAS float*)(lds + L_WS) + wid * 64;
        if (hi == 0) wsf[r32] = __builtin_amdgcn_rcpf(l);
        LDS_WAIT(); asm volatile("" ::: "memory");
        LAS bf16_t* stg = (LAS bf16_t*)(lds + L_OST) + wid * 2048;
#pragma unroll
        for (int r = 0; r < 16; ++r) { const int orow = crow(r, hi); const float rl = wsf[orow];
#pragma unroll
            for (int dh = 0; dh < 2; ++dh) stg[orow * 64 + dh * 32 + r32] = (bf16_t)(cvtpk(o[dh][r] * rl, 0.f) & 0xffffu); }
        LDS_WAIT(); asm volatile("" ::: "memory");
        bf16_t* Ob = OB + (size_t)br * NTOK * DATT;
#pragma unroll
        for (int i = 0; i < 4; ++i) { const int row = i * 8 + (lane >> 3), ch = lane & 7; const u32x4 v = *(const LAS u32x4*)(stg + row * 64 + ch * 8);
            st16_wt(Ob + (size_t)(rowbase + d * (qsub + row)) * DATT + h * 64 + ch * 8, v); }
        if (hi == 0) LSE[((size_t)br * NTOK + qtok) * 8 + h] = m + __builtin_amdgcn_logf(l);
        asm volatile("s_waitcnt lgkmcnt(0)" ::: "memory");
        __builtin_amdgcn_s_barrier(); asm volatile("" ::: "memory");
        g = gn;
    }
    asm volatile("s_waitcnt vmcnt(0)" ::: "memory");
}
}

__device__ __forceinline__ void conv_item(int item, const bf16_t* U, const float* cw, const float* cb, const float* lng, const float* lnb, bf16_t* S, LAS unsigned char* lds, int wave, int lane) {
    const int c = threadIdx.x, t0 = item * 64;
    LAS bf16_t* UT = (LAS bf16_t*)lds;
    LAS float* CT = (LAS float*)(lds + 32768);
    float w[31], x[62];
#pragma unroll
    for (int j = 0; j < 31; ++j) w[j] = cw[j * DCONV + c];
    const float bias = cb[c];
    const bool hist = (t0 % SEQ) != 0;
    const f32x4 g0 = *(const f32x4*)(lng + 8 * lane), g1 = *(const f32x4*)(lng + 8 * lane + 4), b0 = *(const f32x4*)(lnb + 8 * lane), b1 = *(const f32x4*)(lnb + 8 * lane + 4);
    u32x4 pre[4];
#define CV_ISSUE(tb) do { const int tb_ = (tb) < 0 ? 0 : (tb); _Pragma("unroll") for (int q = 0; q < 4; ++q) { const int idx = c + 512 * q; pre[q] = *(const u32x4*)(U + (size_t)(tb_ + (idx >> 6)) * DCONV + (idx & 63) * 8); } } while (0)
#define CV_WRITE() do { _Pragma("unroll") for (int q = 0; q < 4; ++q) { const int idx = c + 512 * q; *(LAS u32x4*)(UT + (idx >> 6) * DCONV + (idx & 63) * 8) = pre[q]; } } while (0)
    CV_ISSUE(t0 - 32);
    CV_WRITE();
    CV_ISSUE(t0);
    __syncthreads();
#pragma unroll
    for (int j = 0; j < 30; ++j) { const float v = bf2f(UT[(2 + j) * DCONV + c]); x[j] = hist ? v : 0.f; }
    for (int ch = 0; ch < 2; ++ch) {
        __syncthreads();
        CV_WRITE();
        if (ch == 0) CV_ISSUE(t0 + 32);
        __syncthreads();
#pragma unroll
        for (int j = 0; j < 32; ++j) x[30 + j] = bf2f(UT[j * DCONV + c]);
#pragma unroll
        for (int tt = 0; tt < 32; ++tt) { float y = bias;
#pragma unroll
            for (int j = 0; j < 31; ++j) y = __builtin_fmaf(w[j], x[tt + j], y);
            CT[tt * DCONV + c] = y; }
#pragma unroll
        for (int j = 0; j < 30; ++j) x[j] = x[32 + j];
        __syncthreads();
#pragma unroll
        for (int q = 0; q < 4; ++q) { const int tt = wave + 8 * q;
            const f32x4 v0 = *(const LAS f32x4*)(CT + tt * DCONV + 8 * lane), v1 = *(const LAS f32x4*)(CT + tt * DCONV + 8 * lane + 4);
            const float mean = wave_sum((v0[0] + v0[1]) + (v0[2] + v0[3]) + (v1[0] + v1[1]) + (v1[2] + v1[3])) * (1.f / DCONV);
            const f32x4 d0 = v0 - mean, d1 = v1 - mean;
            const float var = wave_sum((d0[0] * d0[0] + d0[1] * d0[1]) + (d0[2] * d0[2] + d0[3] * d0[3]) + (d1[0] * d1[0] + d1[1] * d1[1]) + (d1[2] * d1[2] + d1[3] * d1[3])) * (1.f / DCONV);
            const float rstd = 1.0f / sqrtf(var + LN_EPS);
            f32x4 y0 = d0 * rstd * g0 + b0, y1 = d1 * rstd * g1 + b1;
#pragma unroll
            for (int i = 0; i < 4; ++i) { y0[i] = y0[i] * fsigmoid(y0[i]); y1[i] = y1[i] * fsigmoid(y1[i]); }
            st16_wt(S + (size_t)(t0 + 32 * ch + tt) * DCONV + 8 * lane, pg8::pack8(y0, y1)); }
    }
    __syncthreads();
#undef CV_ISSUE
#undef CV_WRITE
}

__device__ __forceinline__ void combine_tokens(Frame& F, const bf16_t* OB, const float* LSE, bf16_t* AO, int gw, int NGW) {
    const int h = F.lane >> 3;
    for (int tok0 = gw * 4; tok0 < NTOK; tok0 += NGW * 4) {
        float ls[4][3]; u32x4 v[4][3];
#pragma unroll
        for (int t = 0; t < 4; ++t)
#pragma unroll
            for (int br = 0; br < 3; ++br) { ls[t][br] = LSE[((size_t)br * NTOK + tok0 + t) * 8 + h]; v[t][br] = *(const u32x4*)(OB + ((size_t)br * NTOK + tok0 + t) * DATT + 8 * F.lane); }
#pragma unroll
        for (int t = 0; t < 4; ++t) {
            const float mx = fmaxf(ls[t][0], fmaxf(ls[t][1], ls[t][2]));
            float wt[3]; float sum = 0.f;
#pragma unroll
            for (int br = 0; br < 3; ++br) { wt[br] = __builtin_amdgcn_exp2f(ls[t][br] - mx); sum += wt[br]; }
            const float rs = 1.0f / sum;
            f32x4 a0 = {0.f, 0.f, 0.f, 0.f}, a1 = {0.f, 0.f, 0.f, 0.f};
#pragma unroll
            for (int br = 0; br < 3; ++br) { const float wv = wt[br] * rs; const u32x4 q = v[t][br];
                a0[0] += wv * bflo(q.x); a0[1] += wv * bfhi(q.x); a0[2] += wv * bflo(q.y); a0[3] += wv * bfhi(q.y);
                a1[0] += wv * bflo(q.z); a1[1] += wv * bfhi(q.z); a1[2] += wv * bflo(q.w); a1[3] += wv * bfhi(q.w); }
            st16_wt(AO + (size_t)(tok0 + t) * DM + DCONV + 8 * F.lane, pg8::pack8(a0, a1));
        }
    }
}

constexpr int RT_X = 0, RT_XP = 2064;
constexpr int RT_LCNT = 147456, RT_BASE = RT_LCNT + 128, RT_TE = RT_BASE + 128, RT_TG = RT_TE + 1024, RT_END = RT_TG + 1024;
static_assert(64 * RT_XP <= RT_LCNT && 8 * 32 * 33 * 4 <= 64 * RT_XP, "route LDS map");
__device__ __forceinline__ void route_phase(Frame& F, const Args& a) {
    volatile LAS int* lcnt = (volatile LAS int*)(F.lds + RT_LCNT); volatile LAS int* lbase = (volatile LAS int*)(F.lds + RT_BASE);
    volatile LAS int* te = (volatile LAS int*)(F.lds + RT_TE); volatile LAS float* tg = (volatile LAS float*)(F.lds + RT_TG);
    const float* rb = (const float*)a.in[13]; const float* g1 = (const float*)a.in[10]; const float* b1 = (const float*)a.in[11];
    const bf16_t* MIXb = (const bf16_t*)(F.ws + WS_Z); const float* Xin = (const float*)a.in[0]; bf16_t* X1B = (bf16_t*)(F.ws + WS_X1B); unsigned char* X18 = F.ws + WS_X1F8;
    const bf16_t* WrT = (const bf16_t*)(F.ws + WS_WRT);
    int* TOKE = (int*)(F.ws + WS_TOKE); float* TOKG = (float*)(F.ws + WS_TOKG); int* LIST = (int*)(F.ws + WS_LIST);
    const int r32 = F.lane & 31, hi = F.lane >> 5;
    f32x4 gv[4], bv[4];
#pragma unroll
    for (int j = 0; j < 4; ++j) { gv[j] = *(const f32x4*)(g1 + 4 * F.lane + 256 * j); bv[j] = *(const f32x4*)(b1 + 4 * F.lane + 256 * j); }
    for (int tb = F.vcu; tb < NTOK / 64; tb += F.G) {
        if (F.tid < 32) lcnt[F.tid] = 0;
        for (int it = 0; it < 8; ++it) {
            const int tl = F.wave * 8 + it, tok = tb * 64 + tl;
            f32x4 xv[4]; float sum = 0.f;
#pragma unroll
            for (int j = 0; j < 4; ++j) { const u32x2 mx = *(const u32x2*)(MIXb + (size_t)tok * DM + 4 * F.lane + 256 * j);
                xv[j] = *(const f32x4*)(Xin + (size_t)tok * DM + 4 * F.lane + 256 * j) * DN_ALPHA + (f32x4){bflo(mx.x), bfhi(mx.x), bflo(mx.y), bfhi(mx.y)}; sum += (xv[j][0] + xv[j][1]) + (xv[j][2] + xv[j][3]); }
            const float mean = wave_sum(sum) * (1.f / DM); float sq = 0.f;
#pragma unroll
            for (int j = 0; j < 4; ++j) { xv[j] = xv[j] - mean; sq += (xv[j][0] * xv[j][0] + xv[j][1] * xv[j][1]) + (xv[j][2] * xv[j][2] + xv[j][3] * xv[j][3]); }
            const float rstd = 1.0f / sqrtf(wave_sum(sq) * (1.f / DM) + LN_EPS);
#pragma unroll
            for (int j = 0; j < 4; ++j) { xv[j] = xv[j] * rstd * gv[j] + bv[j];
                u32x2 w; w.x = cvtpk(xv[j][0], xv[j][1]); w.y = cvtpk(xv[j][2], xv[j][3]); *(u32x2*)(X1B + (size_t)tok * DM + 4 * F.lane + 256 * j) = w;
                *(LAS u32x2*)(F.lds + RT_X + tl * RT_XP + (4 * F.lane + 256 * j) * 2) = w;
                *(unsigned*)(X18 + (size_t)tok * DM + 4 * F.lane + 256 * j) = pk4_fp8(xv[j][0], xv[j][1], xv[j][2], xv[j][3]); }
        }
        __syncthreads();
        const int mb = F.wave & 1, kq = F.wave >> 1;
        f32x16 acc = {};
        {
            bf16x8 bfr[16], bfl[16];
#pragma unroll
            for (int s_ = 0; s_ < 16; ++s_) { bfr[s_] = *(const bf16x8*)(WrT + (size_t)r32 * DM + 16 * (kq * 16 + s_) + 8 * hi); bfl[s_] = *(const bf16x8*)(WrT + (size_t)NEXP * DM + (size_t)r32 * DM + 16 * (kq * 16 + s_) + 8 * hi); }
#pragma unroll
            for (int s_ = 0; s_ < 16; ++s_) { const bf16x8 af = *(const LAS bf16x8*)(F.lds + RT_X + (32 * mb + r32) * RT_XP + (16 * (kq * 16 + s_) + 8 * hi) * 2);
                acc = __builtin_amdgcn_mfma_f32_32x32x16_bf16(af, bfr[s_], acc, 0, 0, 0); acc = __builtin_amdgcn_mfma_f32_32x32x16_bf16(af, bfl[s_], acc, 0, 0, 0); }
        }
        __syncthreads();
        {
            LAS float* P = (LAS float*)(F.lds + RT_X) + (size_t)(mb * 4 + kq) * 32 * 33;
#pragma unroll
            for (int r = 0; r < 16; ++r) P[((r & 3) + 8 * (r >> 2) + 4 * hi) * 33 + r32] = acc[r];
        }
        __syncthreads();
        if (F.wave == 0) {
            const LAS float* P = (const LAS float*)(F.lds + RT_X) + (size_t)((F.lane >> 5) * 4) * 32 * 33 + (F.lane & 31) * 33;
            float l[32];
#pragma unroll
            for (int e = 0; e < 32; ++e) l[e] = ((P[e] + P[32 * 33 + e]) + (P[2 * 32 * 33 + e] + P[3 * 32 * 33 + e])) + rb[e];
            float tv[4]; int ti[4];
#pragma unroll
            for (int k = 0; k < 4; ++k) { float best = l[0]; int bi = 0;
#pragma unroll
                for (int e = 1; e < 32; ++e) { const bool gt = l[e] > best; best = gt ? l[e] : best; bi = gt ? e : bi; }
                tv[k] = best; ti[k] = bi;
#pragma unroll
                for (int e = 0; e < 32; ++e) l[e] = (e == bi) ? -INFINITY : l[e]; }
            float ex[4], es = 0.f;
#pragma unroll
            for (int k = 0; k < 4; ++k) { ex[k] = __builtin_amdgcn_exp2f((tv[k] - tv[0]) * 1.4426950408889634f); es += ex[k]; }
            const float ies = 1.0f / es;
#pragma unroll
            for (int k = 0; k < 4; ++k) { const int lr = __hip_atomic_fetch_add((LAS int*)(F.lds + RT_LCNT) + ti[k], 1, __ATOMIC_RELAXED, __HIP_MEMORY_SCOPE_WORKGROUP);
                te[F.lane * 4 + k] = ti[k] | (lr << 5); tg[F.lane * 4 + k] = ex[k] * ies; }
        }
        __syncthreads();
        if (F.tid < 32) lbase[F.tid] = (int)__hip_atomic_fetch_add((unsigned*)(F.ctl + CW_GCNT + 64 * F.tid), (unsigned)lcnt[F.tid], RLX_AGENT);
        __syncthreads();
        if (F.tid < 256) { const int tl = F.tid >> 2, k = F.tid & 3, tok = tb * 64 + tl; const int w = te[tl * 4 + k], e = w & 31, rank = lbase[e] + (w >> 5);
            LIST[e * NTOK + rank] = tok; TOKE[tok * 4 + k] = e | (rank << 5); TOKG[tok * 4 + k] = tg[tl * 4 + k]; }
        __syncthreads();
    }
}
__device__ __forceinline__ void moe_prefix(Frame& F) {
    if (F.tid < 64) {
        const int c = (F.lane < 32) ? (int)__hip_atomic_load(F.ctl + CW_GCNT + 64 * (F.lane & 31), RLX_AGENT) : 0;
        const int t = (c + 255) >> 8; int incl = t;
#pragma unroll
        for (int o = 1; o < 32; o <<= 1) { const int y = __shfl_up(incl, o); if (F.lane >= o) incl += y; }
        if (F.lane < 32) { F.MISC[80 + F.lane] = (unsigned)c; F.MISC[32 + F.lane] = (unsigned)(incl - t); }
        if (F.lane == 31) F.MISC[64] = (unsigned)incl;
    }
    __syncthreads();
}

__device__ __forceinline__ void final_phase(Frame& F, const Args& a) {
    const int gw = F.vcu * 8 + F.wave, NGW = F.G * 8;
    const bf16_t* X1B = (const bf16_t*)(F.ws + WS_X1B); const unsigned char* Y = F.ws + WS_Y;
    const int* TOKE = (const int*)(F.ws + WS_TOKE); const float* TOKG = (const float*)(F.ws + WS_TOKG);
    const float* g2 = (const float*)a.in[20]; const float* b2 = (const float*)a.in[21];
    f32x4 gv[4], bv[4];
#pragma unroll
    for (int j = 0; j < 4; ++j) { gv[j] = *(const f32x4*)(g2 + 4 * F.lane + 256 * j); bv[j] = *(const f32x4*)(b2 + 4 * F.lane + 256 * j); }
    typedef int i32x4 __attribute__((ext_vector_type(4)));
    unsigned yn[4][4]; u32x2 xn[4]; f32x4 gn = {0.f, 0.f, 0.f, 0.f}; i32x4 inn = {0, 0, 0, 0}; f32x4 gnn = {0.f, 0.f, 0.f, 0.f};
#define FP_ROWS(tok_, iw_) do { _Pragma("unroll") for (int k = 0; k < 4; ++k) { const int w_ = (iw_)[k]; const size_t slot = (size_t)F.MISC[32 + (w_ & 31)] * 256 + (w_ >> 5); \
        _Pragma("unroll") for (int j = 0; j < 4; ++j) yn[k][j] = *(const unsigned*)(Y + slot * DM + 4 * F.lane + 256 * j); } \
        _Pragma("unroll") for (int j = 0; j < 4; ++j) xn[j] = *(const u32x2*)(X1B + (size_t)(tok_) * DM + 4 * F.lane + 256 * j); } while (0)
    if (gw < NTOK) { const i32x4 i0 = *(const i32x4*)(TOKE + (size_t)gw * 4); gn = *(const f32x4*)(TOKG + (size_t)gw * 4); FP_ROWS(gw, i0); }
    if (gw + NGW < NTOK) { inn = *(const i32x4*)(TOKE + (size_t)(gw + NGW) * 4); gnn = *(const f32x4*)(TOKG + (size_t)(gw + NGW) * 4); }
    for (int tok = gw; tok < NTOK; tok += NGW) {
        f32x4 v[4];
#pragma unroll
        for (int j = 0; j < 4; ++j) { v[j][0] = DN_ALPHA * bflo(xn[j].x); v[j][1] = DN_ALPHA * bfhi(xn[j].x); v[j][2] = DN_ALPHA * bflo(xn[j].y); v[j][3] = DN_ALPHA * bfhi(xn[j].y); }
#pragma unroll
        for (int k = 0; k < 4; ++k) { const float g = gn[k];
#pragma unroll
            for (int j = 0; j < 4; ++j) { const f32x2 ylo = __builtin_amdgcn_cvt_pk_f32_fp8((int)yn[k][j], false), yhi = __builtin_amdgcn_cvt_pk_f32_fp8((int)yn[k][j], true);
                v[j][0] += g * ylo[0]; v[j][1] += g * ylo[1]; v[j][2] += g * yhi[0]; v[j][3] += g * yhi[1]; } }
        if (tok + NGW < NTOK) { gn = gnn; FP_ROWS(tok + NGW, inn); }
        if (tok + 2 * NGW < NTOK) { inn = *(const i32x4*)(TOKE + (size_t)(tok + 2 * NGW) * 4); gnn = *(const f32x4*)(TOKG + (size_t)(tok + 2 * NGW) * 4); }
        float sum = 0.f;
#pragma unroll
        for (int j = 0; j < 4; ++j) sum += (v[j][0] + v[j][1]) + (v[j][2] + v[j][3]);
        const float mean = wave_sum(sum) * (1.f / DM); float sq = 0.f;
#pragma unroll
        for (int j = 0; j < 4; ++j) { v[j] = v[j] - mean; sq += (v[j][0] * v[j][0] + v[j][1] * v[j][1]) + (v[j][2] * v[j][2] + v[j][3] * v[j][3]); }
        const float rstd = 1.0f / sqrtf(wave_sum(sq) * (1.f / DM) + LN_EPS);
#pragma unroll
        for (int j = 0; j < 4; ++j) { f32x4 o = v[j] * rstd * gv[j] + bv[j];
            if (TS_A >= 0 && blockIdx.x == 0) { const float tus = 0.01f * (float)(F.MISC[121 + (TS_A >= 0 ? TS_A : 0)] - F.MISC[120 + (TS_A >= 0 ? TS_A : 0)]); o = o + sqrtf(256e-6f * tus); }
            if (TS_B >= 0 && blockIdx.x == 0 && tok == gw && F.wave == 0 && F.lane == 0 && j == 0) { const float tus = 0.01f * (float)(F.MISC[121 + (TS_B >= 0 ? TS_B : 0)] - F.MISC[120 + (TS_B >= 0 ? TS_B : 0)]); o[0] += 1.0f + 0.1f * tus; }
            *(f32x4*)(a.out + (size_t)tok * DM + 4 * F.lane + 256 * j) = o; }
    }
#undef FP_ROWS
}

__global__ void __launch_bounds__(512, 2) mega_fwd(Args args) {
    extern __shared__ __attribute__((aligned(16))) unsigned char lds[];
    Frame F;
    F.lds = (LAS unsigned char*)lds;
    F.MISC = (volatile LAS unsigned*)(F.lds + MISC_OFF);
    F.tid = threadIdx.x; F.lane = F.tid & 63; F.wave = __builtin_amdgcn_readfirstlane(F.tid >> 6);
    F.G = gridDim.x; { const int bx = blockIdx.x; F.vcu = (F.G % 8 == 0) ? (bx % 8) * (F.G / 8) + bx / 8 : bx; }
    { GAS unsigned char* wsg = (GAS unsigned char*)args.ws; asm volatile("" : "+s"(wsg)); F.ws = (unsigned char*)wsg; }
    F.ctl = (gu32*)(F.ws + WS_CTL);
    F.bg = false; { const int xg = F.vcu >> 5, lc = F.vcu & 31; F.conv = F.bg && lc >= 32 - NCONVX; F.wc8 = lc * 8 + xg; F.cidx = xg * NCONVX + (lc - (32 - NCONVX)); }
    for (int u = F.tid; u < 256; u += 512) F.MISC[u] = 0u;
    __syncthreads();
    XcdBarrier bar; bar.bar = (unsigned*)(F.ctl + CW_BAR); bar.x = 0; bar.st = nullptr;
    if (N_LAUNCHES != PER_PHASE) bar = xcd_barrier_post((unsigned*)(F.ctl + CW_BAR), F.MISC + 8);
#define GRID_BAR(seam) do { if (N_LAUNCHES == PER_PHASE) { if (F.tid == 0) __hip_atomic_store(F.ctl + CW_TMO, 0xBADBA0u | (unsigned)(seam), RLX_AGENT); } else { xcd_barrier(bar); } } while (0)
#define STAMP(k) do { if (TS_A >= 0 || TS_B >= 0) { if (blockIdx.x == 0 && F.tid == 0) F.MISC[120 + (k)] = (unsigned)__builtin_amdgcn_s_memrealtime(); } } while (0)
    STAMP(0);
    const int lo = args.ph_lo, hi = args.ph_hi;
#define IN(k) (lo <= (k) && (k) < hi)
#define BOTH(k) (IN(k) && IN((k) + 1))
    unsigned char* ws = F.ws;
    bf16_t* XB = (bf16_t*)(ws + WS_XB); bf16_t* Ub = (bf16_t*)(ws + WS_U); bf16_t* Qb = (bf16_t*)(ws + WS_Q); bf16_t* Kb = (bf16_t*)(ws + WS_K); bf16_t* Vb = (bf16_t*)(ws + WS_V);
    bf16_t* Sb = (bf16_t*)(ws + WS_S); bf16_t* OB = (bf16_t*)(ws + WS_OB); float* LSE = (float*)(ws + WS_LSE); bf16_t* AO = (bf16_t*)(ws + WS_AO);
    bf16_t* MIXb = (bf16_t*)(ws + WS_Z); unsigned char* X18 = ws + WS_X1F8; unsigned char* H8 = ws + WS_H; unsigned char* Yb = ws + WS_Y;

    if (IN(0)) { p0_prologue(F, args); if (BOTH(0)) GRID_BAR(0); STAMP(1); }
    if (IN(1)) {
        if (F.G == 256) {
            const int xg = F.vcu >> 5, lc = F.vcu & 31;
            if (lc >= P1_NG) convert_items<1>(F, args, P1_GT, NEXP * 2 * CV_I_E, xg * (32 - P1_NG) + (lc - P1_NG), 8 * (32 - P1_NG));
            else {
                pg8::DenseOrder S; S.init(NTOK, NPROJ, DM, 8 * P1_NG, lc * 8 + xg, ws + WS_WIN);
                pg8::EpiInProj E{Ub, Qb, Kb, Vb, (const float*)(ws + WS_ROPE)};
                pg8::gemm_phase<pg8::EpiInProj, pg8::DenseOrder, true>(F.lds, XB, DM, S, E);
                convert_items<1>(F, args, 0, P1_GT, lc * 8 + xg, 8 * P1_NG);
            }
        } else {
            pg8::DenseOrder S; S.init(NTOK, NPROJ, DM, F.G, (int)blockIdx.x, ws + WS_WIN);
            pg8::EpiInProj E{Ub, Qb, Kb, Vb, (const float*)(ws + WS_ROPE)};
            pg8::gemm_phase<pg8::EpiInProj, pg8::DenseOrder, true>(F.lds, XB, DM, S, E);
        }
        if (BOTH(1)) GRID_BAR(1); STAMP(2);
    }
    if (IN(2)) {
        const int per = F.G / 8, xcd = F.vcu / per, loc = F.vcu % per;
        if (F.bg) {
            if (!F.conv) for (int j = loc; j < 192; j += 32 - NCONVX) { const int bh = 2 * xcd + j / 96, jj = j % 96; att::attn_unit(bh >> 3, bh & 7, jj >> 5, jj & 31, Qb, Kb, Vb, OB, LSE, F.lds); }
        } else if (F.G == 256) {
            att::attn_units(loc, per, xcd, Qb, Kb, Vb, OB, LSE, F.lds);
            __syncthreads();
        } else if (F.G % 8 == 0 && per >= 1) {
            for (int j = loc; j < 192; j += per) { const int bh = 2 * xcd + j / 96, jj = j % 96; att::attn_unit(bh >> 3, bh & 7, jj >> 5, jj & 31, Qb, Kb, Vb, OB, LSE, F.lds); }
        } else {
            for (int j = F.vcu; j < 1536; j += F.G) { const int bh = j / 96, jj = j % 96; att::attn_unit(bh >> 3, bh & 7, jj >> 5, jj & 31, Qb, Kb, Vb, OB, LSE, F.lds); }
        }
        for (int it = F.vcu; it < NTOK / 64; it += F.G)
            conv_item(it, Ub, (const float*)args.in[3], (const float*)args.in[4], (const float*)args.in[5], (const float*)args.in[6], Sb, F.lds, F.wave, F.lane);
        if (F.conv) convert_items(F, args, CV_S1, CV_S2, F.cidx, NCONV);
        if (BOTH(2)) GRID_BAR(2); STAMP(3);
    }
    if (IN(3)) {
        constexpr int NPW = (NTOK / 256) * (DCONV / 256);
        const int wid_ = F.bg ? F.wc8 : (int)blockIdx.x, nw_ = F.bg ? NWORK : (int)F.G;
        if (F.conv) convert_items(F, args, CV_S2, CV_S3, F.cidx, NCONV);
        else {
            if (nw_ > NPW) { if (wid_ >= NPW) { combine_tokens(F, OB, LSE, AO, (wid_ - NPW) * 8 + F.wave, (nw_ - NPW) * 8);
                if (F.G == 256) { __syncthreads(); convert_items<2>(F, args, 0, WD_P3, wid_ - NPW, 128); } } }
            else combine_tokens(F, OB, LSE, AO, wid_ * 8 + F.wave, nw_ * 8);
            pg8::DenseOrder S; S.init(NTOK, DCONV, DCONV, nw_, wid_, ws + WS_WPW);
            pg8::EpiBiasBf16 E{AO, DM, (const float*)args.in[8]};
            pg8::gemm_phase<pg8::EpiBiasBf16, pg8::DenseOrder, true>(F.lds, Sb, DCONV, S, E);
        }
        if (BOTH(3)) GRID_BAR(3); STAMP(4);
    }
    if (IN(4)) {
        pg8::DenseOrder S; S.init(NTOK, DM, DM, F.G, (int)blockIdx.x, ws + WS_WOUT);
        pg8::EpiPlainBf16 E{MIXb, DM};
        pg8::gemm_phase<pg8::EpiPlainBf16, pg8::DenseOrder, true>(F.lds, AO, DM, S, E);
        if (BOTH(4)) GRID_BAR(4); STAMP(5);
    }
    if (IN(5)) { route_phase(F, args); if (BOTH(5)) GRID_BAR(5); STAMP(6); }
    if (IN(6)) {
        const bool dsplit = (F.G == 256);
        moe_prefix(F);
        {
            pg8::MoeOrder S{(const volatile LAS int*)(F.MISC + 32), (const volatile LAS int*)(F.MISC + 80), (const int*)(ws + WS_LIST), (const char*)(ws + WS_WGU), 8, 2048, DM / 2, F.vcu, F.G, F.lds};
            pg8::EpiSwiglu E{H8, (const float*)args.in[15], (const float*)args.in[17], (const volatile LAS int*)(F.MISC + 32), &S};
            S.plan([&](const pg8::Unit& u, int tc) { return E.bias_at(u, tc); });
            pg8::gemm_phase<pg8::EpiSwiglu, pg8::MoeOrder, true, true>(F.lds, X18, DM / 2, S, E);
        }
        if (dsplit && (F.vcu & 31) >= 16) convert_items<2>(F, args, WD_P3, NEXP * CV_I_E, (F.vcu >> 5) * 16 + ((F.vcu & 31) - 16), 128);
        if (BOTH(6)) GRID_BAR(6); STAMP(7);
    }
    if (IN(7)) {
        moe_prefix(F);
        pg8::MoeOrder S{(const volatile LAS int*)(F.MISC + 32), (const volatile LAS int*)(F.MISC + 80), nullptr, (const char*)(ws + WS_WD), 4, 1024, DFF / 2, F.vcu, F.G, F.lds};
        pg8::EpiDown E{Yb, (const float*)args.in[19], (const volatile LAS int*)(F.MISC + 32), &S};
        S.plan([&](const pg8::Unit& u, int tc) { return E.bias_at(u, tc); });
        pg8::gemm_phase<pg8::EpiDown, pg8::MoeOrder, true, true>(F.lds, H8, DFF / 2, S, E);
        if (BOTH(7)) GRID_BAR(7); STAMP(8);
    }
    if (IN(8)) { moe_prefix(F); final_phase(F, args); }
#undef IN
#undef BOTH
}

extern "C" void kernel_launch(void* const* d_in, const int* in_sizes, int n_in, void* d_out, int out_size, void* d_ws, size_t ws_size, hipStream_t stream) {
    static int grid = 0;
    if (grid == 0) {
        if (n_in != 22 || out_size != NTOK * DM || ws_size < WS_END) { fprintf(stderr, "kernel_launch: unexpected problem (n_in %d out %d ws %zu need %zu)\n", n_in, out_size, ws_size, (size_t)WS_END); grid = -1; return; }
        int dev = 0, cus = 0;
        if (hipGetDevice(&dev) != hipSuccess || hipDeviceGetAttribute(&cus, hipDeviceAttributeMultiprocessorCount, dev) != hipSuccess) { grid = -1; return; }
        if (hipFuncSetAttribute((const void*)mega_fwd, hipFuncAttributeMaxDynamicSharedMemorySize, LDS_BYTES) != hipSuccess) { fprintf(stderr, "kernel_launch: hipFuncSetAttribute failed\n"); grid = -1; return; }
        (void)hipGetLastError();
        grid = cus;
    }
    if (grid < 0) return;
    if (hipMemsetAsync((char*)d_ws + WS_CTL, 0, CTL_ZERO_BYTES, stream) != hipSuccess) return;
    Args a{};
    for (int i = 0; i < 22; ++i) a.in[i] = d_in[i];
    a.out = (float*)d_out; a.ws = (unsigned char*)d_ws;
    for (int li = 0; li < N_LAUNCHES; ++li) {
        a.ph_lo = (N_LAUNCHES == PER_PHASE) ? li : 0; a.ph_hi = (N_LAUNCHES == PER_PHASE) ? li + 1 : PER_PHASE; a.li = li;
        hipLaunchKernelGGL(mega_fwd, dim3(grid), dim3(512), LDS_BYTES, stream, a);
    }
}
```

```cpp
#include <hip/hip_runtime.h>
#include <cstdio>
#include <cstdint>

#define GAS __attribute__((address_space(1)))
#define LAS __attribute__((address_space(3)))
typedef unsigned short bf16_t;
typedef short bf16x8 __attribute__((ext_vector_type(8)));
typedef short s16x4 __attribute__((ext_vector_type(4)));
typedef float f32x4 __attribute__((ext_vector_type(4)));
typedef float f32x2 __attribute__((ext_vector_type(2)));
typedef float f32x16 __attribute__((ext_vector_type(16)));
typedef unsigned u32x4 __attribute__((ext_vector_type(4)));
typedef unsigned u32x2 __attribute__((ext_vector_type(2)));
typedef __bf16 bf16x2_t __attribute__((ext_vector_type(2)));

#ifndef MK_N_LAUNCHES
#define MK_N_LAUNCHES 1
#endif
#ifndef TS_A
#define TS_A -1
#endif
#ifndef TS_B
#define TS_B -1
#endif
constexpr int N_LAUNCHES = MK_N_LAUNCHES;
constexpr int PER_PHASE = 9;

constexpr int BATCH = 2, SEQ = 8192, DM = 1024, NTOK = BATCH * SEQ;
constexpr int DCONV = 512, DATT = 512, NHEAD = 8, HD = 64, NPROJ = 2560, CONVK = 31;
constexpr int NEXP = 32, TOPK = 4, DFF = 1024;
constexpr float LN_EPS = 1e-5f;
constexpr float DN_ALPHA = 1.189207115002721f;
constexpr float SWI_LIMIT = 7.0f, SWI_ALPHA = 1.702f;
constexpr float WSCALE8 = 32.0f, WINV8 = 1.0f / 32.0f;
constexpr float QSCALE = 0.125f * 1.4426950408889634f;
constexpr int MAXSLOT = NTOK * TOPK + NEXP * 256;

constexpr size_t MiB = 1u << 20;
constexpr size_t WS_CTL = 0, CTL_ZERO_BYTES = 1 * MiB;
constexpr size_t WS_TOKE = 1 * MiB;
constexpr size_t WS_TOKG = WS_TOKE + 256 * 1024;
constexpr size_t WS_LIST = 2 * MiB;
constexpr size_t WS_ROPE = 4 * MiB;
constexpr size_t WS_WIN = 8 * MiB;
constexpr size_t WS_WPW = 13 * MiB;
constexpr size_t WS_WRT = 13 * MiB + 512 * 1024;
constexpr size_t WS_WOUT = 14 * MiB;
constexpr size_t WS_WD = 16 * MiB;
constexpr size_t WS_WGU = 48 * MiB;
constexpr size_t WS_AO = 112 * MiB;
constexpr size_t WS_Z = 144 * MiB;
constexpr size_t WS_Y = 48 * MiB;
constexpr size_t WS_X1B = 208 * MiB;
constexpr size_t WS_X1F8 = 240 * MiB;
constexpr size_t WS_XB = 256 * MiB;
constexpr size_t WS_U = 288 * MiB;
constexpr size_t WS_Q = 304 * MiB, WS_K = 320 * MiB, WS_V = 336 * MiB;
constexpr size_t WS_S = 352 * MiB;
constexpr size_t WS_OB = 368 * MiB;
constexpr size_t WS_LSE = 416 * MiB;
constexpr size_t WS_H = 256 * MiB;
constexpr size_t WS_END = 418 * MiB;
static_assert(WS_Y + (size_t)MAXSLOT * DM <= WS_Z && WS_H + (size_t)MAXSLOT * DM <= WS_OB && WS_WGU + (size_t)NEXP * 2048 * DM <= WS_AO, "ws overlays");
constexpr int CW_TMO = 0, CW_CODE = 1;
constexpr int CW_GCNT = 64;
constexpr int CW_BAR = 4096;

constexpr int LDS_BYTES = 163840;
constexpr int MISC_OFF = LDS_BYTES - 1024;
constexpr int RING_BYTES = 131072;

#define RLX_AGENT __ATOMIC_RELAXED, __HIP_MEMORY_SCOPE_AGENT
#define LDS_WAIT() asm volatile("s_waitcnt lgkmcnt(0)" ::: "memory")
#define VM_WAIT() asm volatile("s_waitcnt vmcnt(0)" ::: "memory")
typedef GAS unsigned gu32;

__device__ __forceinline__ unsigned cvtpk(float lo, float hi) { f32x2 v = {lo, hi}; bf16x2_t b = __builtin_convertvector(v, bf16x2_t); return __builtin_bit_cast(unsigned, b); }
__device__ __forceinline__ unsigned pk4_fp8(float a, float b, float c, float d) { int w = 0; w = __builtin_amdgcn_cvt_pk_fp8_f32(a, b, w, false); w = __builtin_amdgcn_cvt_pk_fp8_f32(c, d, w, true); return (unsigned)w; }
__device__ __forceinline__ void st16_wt(void* p, u32x4 v) { asm volatile("global_store_dwordx4 %0, %1, off sc1\n\ts_nop 1" :: "v"(p), "v"(v) : "memory"); }
__device__ __forceinline__ float bf2f(bf16_t h) { return __uint_as_float((unsigned)h << 16); }
__device__ __forceinline__ float bflo(unsigned w) { return __uint_as_float(w << 16); }
__device__ __forceinline__ float bfhi(unsigned w) { return __uint_as_float(w & 0xffff0000u); }
__device__ __forceinline__ float wave_sum(float v) {
#pragma unroll
    for (int o = 1; o < 64; o <<= 1) v += __shfl_xor(v, o);
    return v;
}
__device__ __forceinline__ float fsigmoid(float x) { return __builtin_amdgcn_rcpf(1.0f + __builtin_amdgcn_exp2f(-1.4426950408889634f * x)); }

namespace pg8 {
constexpr int BM = 256, BK = 64, HALF = 128, HTB = HALF * BK * 2, STAGE_BYTES = 8 * HTB, NXCD = 8, WGM = 8;
__host__ __device__ __forceinline__ int lds_byte(int r, int c) { const int st = (r >> 4) * 2 + (c >> 5), rr = r & 15, cc = c & 31, ob = rr * 64 + cc * 2; return st * 1024 + (ob ^ (((ob >> 9) & 1) << 5)); }
__host__ __device__ __forceinline__ void stage_rc(int b, int& R, int& C) { const int st = b / 1024, sb = b % 1024, swz = sb ^ (((sb >> 9) & 1) << 5); R = (st >> 1) * 16 + swz / 64; C = (st & 1) * 32 + (swz % 64) / 2; }
__host__ __device__ __forceinline__ int perm32(int rho) { const int n = rho >> 4, i = rho & 15; return 8 * (i >> 2) + 4 * n + (i & 3); }

struct Unit { int pm, pn, e, idx; };

struct DenseOrder {
    int nM, nN, nwg, G, c, K; const char* Bt;
    __device__ void init(int M, int N, int K_, int G_, int c_, const void* Bt_) { nM = M / BM; nN = N / BM; nwg = nM * nN; G = G_; c = c_; K = K_; Bt = (const char*)Bt_; }
    __device__ __forceinline__ bool next(int i, Unit& u) const {
        const long L = (long)i * G + c; if (L >= nwg) return false;
        int wgid = (int)L; { const int q = nwg / NXCD, r = nwg % NXCD, xcd = wgid % NXCD, off = wgid / NXCD; wgid = (xcd < r ? xcd * (q + 1) : r * (q + 1) + (xcd - r) * q) + off; }
        const int nig = WGM * nN, gid = wgid / nig, fm = gid * WGM, gsz = (nM - fm) < WGM ? (nM - fm) : WGM;
        u.pm = fm + ((wgid % nig) % gsz); u.pn = (wgid % nig) / gsz; u.e = 0; u.idx = i; return true;
    }
    __device__ __forceinline__ const char* b_base(const Unit& u) const { return Bt + (size_t)u.pn * BM * K * 2; }
    __device__ __forceinline__ void a_off(const Unit& u, unsigned (&v)[2][2]) const {
#pragma unroll
        for (int i = 0; i < 2; ++i) { int R, C; stage_rc((int)threadIdx.x * 16 + i * 8192, R, C);
#pragma unroll
            for (int h = 0; h < 2; ++h) v[h][i] = (unsigned)((u.pm * BM + h * HALF + R) * K + C) * 2u; }
    }
};
constexpr int PLAN_OFF = 131072, PLAN_UNITS = 12, PLAN_STRIDE = 2048, PLAN_DESC = PLAN_OFF + PLAN_UNITS * PLAN_STRIDE;
struct MoeOrder {
    const volatile LAS int* tp;
    const volatile LAS int* cnt;
    const int* list;
    const char* Bt; int NT, nrowB;
    int pitch;
    int vcu, G;
    LAS unsigned char* lds;
    __device__ __forceinline__ int tpu(int j) const { return __builtin_amdgcn_readfirstlane(tp[j]); }
    template <class BiasPtr> __device__ __forceinline__ void plan(const BiasPtr& biasptr, float bscale) const {
        const int tid = threadIdx.x, lane = tid & 63, li = lane < 32 ? lane : 32;
        const int vt = tp[li], vc = cnt[lane & 31];
        auto T = [&](int j) { return __builtin_amdgcn_readlane(vt, j); };
        const int per = G >> 3, x = vcu / per, c = vcu % per;
        const int Ltot = T(32) * NT, CH = (Ltot + 7) >> 3;
        int ce_ = 0, tl_ = 0, th_ = T(1);
        auto unit_of = [&](int i, Unit& u, int& t0) {
            const int loc = i * per + c, L = x * CH + loc; const bool ok = loc < CH && L < Ltot;
            u.e = 0; u.pn = 0; u.pm = 0; u.idx = i; t0 = 0;
            if (ok) {
                while (L >= th_ * NT && ce_ < NEXP - 1) { ++ce_; tl_ = th_; th_ = T(ce_ + 1); }
                const int q = L - tl_ * NT, te = th_ - tl_;
                const int pn = (int)(((float)q + 0.5f) * __builtin_amdgcn_rcpf((float)te));
                u.e = ce_; u.pn = pn; u.pm = q - pn * te; t0 = tl_; }
            return ok; };
        int val[PLAN_UNITS];
        if (tid < 256) {
#pragma unroll
            for (int i = 0; i < PLAN_UNITS; ++i) { Unit u; int t0; const bool ok = unit_of(i, u, t0);
                if (tid == 0) { volatile LAS int* d = (volatile LAS int*)(lds + PLAN_DESC) + 4 * i; d[0] = u.e; d[1] = u.pn; d[2] = u.pm; d[3] = ok ? 1 : 0; }
                const int ce = __builtin_amdgcn_readlane(vc, u.e), r = u.pm * BM + tid;
                val[i] = list ? 0 : t0 * BM + r;
                if (list && ok && r < ce) val[i] = list[u.e * NTOK + r]; }
#pragma unroll
            for (int i = 0; i < PLAN_UNITS; ++i) ((LAS int*)(lds + PLAN_OFF + i * PLAN_STRIDE))[tid] = val[i];
        } else {
#pragma unroll
            for (int i = 0; i < PLAN_UNITS; ++i) { Unit u; int t0; const bool ok = unit_of(i, u, t0);
                val[i] = 0; if (ok) val[i] = *(const int*)biasptr(u, tid - 256); }
#pragma unroll
            for (int i = 0; i < PLAN_UNITS; ++i) ((LAS float*)(lds + PLAN_OFF + i * PLAN_STRIDE))[tid] = __builtin_bit_cast(float, val[i]) * bscale;
        }
        __syncthreads();
    }
    __device__ __forceinline__ bool next(int i, Unit& u) const {
        if (i >= PLAN_UNITS) return false;
        const volatile LAS int* d = (const volatile LAS int*)(lds + PLAN_DESC) + 4 * i;
        if (__builtin_amdgcn_readfirstlane(d[3]) == 0) return false;
        u.e = __builtin_amdgcn_readfirstlane(d[0]); u.pn = __builtin_amdgcn_readfirstlane(d[1]); u.pm = __builtin_amdgcn_readfirstlane(d[2]); u.idx = i; return true;
    }
    __device__ __forceinline__ const char* b_base(const Unit& u) const { return Bt + ((size_t)u.e * nrowB + (size_t)u.pn * BM) * pitch * 2; }
    __device__ __forceinline__ void a_off(const Unit& u, unsigned (&v)[2][2]) const {
        const LAS int* rows = (const LAS int*)(lds + PLAN_OFF + u.idx * PLAN_STRIDE);
#pragma unroll
        for (int i = 0; i < 2; ++i) { int R, C; stage_rc((int)threadIdx.x * 16 + i * 8192, R, C);
#pragma unroll
            for (int h = 0; h < 2; ++h) v[h][i] = (unsigned)(rows[h * HALF + R] * pitch + C) * 2u; }
    }
    __device__ __forceinline__ void plan_bias(const Unit& u, int wc, int fq, f32x4 (&bv)[2][2]) const {
        const LAS float* pb = (const LAS float*)(lds + PLAN_OFF + u.idx * PLAN_STRIDE + 1024);
#pragma unroll
        for (int bj = 0; bj < 2; ++bj)
#pragma unroll
            for (int n = 0; n < 2; ++n) bv[bj][n] = *(const LAS f32x4*)(pb + bj * HALF + wc * 32 + 8 * fq + 4 * n);
    }
};

template <class Epi, class Sched, bool ALIGN_EPI, bool FP8 = false>
__device__ __forceinline__ void gemm_phase(LAS unsigned char* lds, const void* Abase_, int K, const Sched& S, const Epi& E) {
    const char* Abase = (const char*)Abase_;
    const int tid = threadIdx.x, wid = __builtin_amdgcn_readfirstlane(tid >> 6), lane = tid & 63, wr = wid >> 2, wc = wid & 3, fr = lane & 15, fq = lane >> 4;
    const int nt = K / BK;
    unsigned voffB[2];
#pragma unroll
    for (int i = 0; i < 2; ++i) { int R, C; stage_rc(tid * 16 + i * 8192, R, C); const int Rb = Epi::PERM ? ((R & ~31) + perm32(R & 31)) : R; voffB[i] = (unsigned)(Rb * K + C) * 2u; }
    const size_t kstep = (size_t)(BK * 2);
    const size_t hstep = (size_t)HALF * K * 2;
    const unsigned ldsw = (unsigned)wid * 1024u;
    const int aoff = lds_byte(wr * 64 + fr, fq * 8), boff = lds_byte(wc * 32 + fr, fq * 8);
#define PG8_SA(b, h) (((b) * 2 + (h)) * HTB)
#define PG8_SB(b, h) ((4 + (b) * 2 + (h)) * HTB)
#define PG8_UPTR(p) ((const char*)(((unsigned long long)(unsigned)__builtin_amdgcn_readfirstlane((int)((unsigned long long)(p) >> 32)) << 32) | (unsigned long long)(unsigned)__builtin_amdgcn_readfirstlane((int)(unsigned)(unsigned long long)(p))))
#define PG8_STAGEB(bufoff, gbase) do { const char* gb_ = PG8_UPTR(gbase); _Pragma("unroll") for (int _i = 0; _i < 2; ++_i) \
        __builtin_amdgcn_global_load_lds((const unsigned*)(gb_ + voffB[_i]), (LAS unsigned*)(lds + (bufoff) + ldsw + _i * 8192), 16, 0, 0); } while (0)
#define PG8_STAGEA(bufoff, vo, h, kb) do { const char* ga_ = PG8_UPTR(Abase + (kb)); _Pragma("unroll") for (int _i = 0; _i < 2; ++_i) \
        __builtin_amdgcn_global_load_lds((const unsigned*)(ga_ + (vo)[h][_i]), (LAS unsigned*)(lds + (bufoff) + ldsw + _i * 8192), 16, 0, 0); } while (0)
#define PG8_STAGEA2(bufoff, h, kb) do { const char* ga_ = PG8_UPTR(Abase + (kb)); _Pragma("unroll") for (int _i = 0; _i < 2; ++_i) \
        __builtin_amdgcn_global_load_lds((const unsigned*)(ga_ + (last ? vN[h][_i] : vA[h][_i])), (LAS unsigned*)(lds + (bufoff) + ldsw + _i * 8192), 16, 0, 0); } while (0)
#define PG8_LD8(addr_) __builtin_shufflevector(*(const LAS v4i_*)(addr_), *(const LAS v4i_*)((addr_) + 1024), 0, 1, 2, 3, 4, 5, 6, 7)
#define PG8_LDA(dst, b, h) do { _Pragma("unroll") for (int m = 0; m < 4; ++m) dst[m] = PG8_LD8(lds + PG8_SA(b, h) + aoff + m * 2048); } while (0)
#define PG8_LDB(dst, b, h) do { _Pragma("unroll") for (int n = 0; n < 2; ++n) dst[n] = PG8_LD8(lds + PG8_SB(b, h) + boff + n * 2048); } while (0)
#define PG8_LO(x) __builtin_bit_cast(bf16x8, __builtin_shufflevector(x, x, 0, 1, 2, 3))
#define PG8_HI(x) __builtin_bit_cast(bf16x8, __builtin_shufflevector(x, x, 4, 5, 6, 7))
#define PG8_MMA(ai, bj, At, Bt) do { if constexpr (FP8) __builtin_amdgcn_sched_barrier(0); __builtin_amdgcn_s_setprio(1); _Pragma("unroll") for (int m = 0; m < 4; ++m) _Pragma("unroll") for (int n = 0; n < 2; ++n) { \
        if constexpr (FP8) asm volatile("v_mfma_scale_f32_16x16x128_f8f6f4 %0, %1, %2, %0, %3, %3 op_sel_hi:[0,0,0]" : "+v"(acc[ai][bj][m][n]) : "v"(Bt[n]), "v"(At[m]), "v"(sc8));   \
        else { acc[ai][bj][m][n] = __builtin_amdgcn_mfma_f32_16x16x32_bf16(PG8_LO(Bt[n]), PG8_LO(At[m]), acc[ai][bj][m][n], 0, 0, 0); \
               acc[ai][bj][m][n] = __builtin_amdgcn_mfma_f32_16x16x32_bf16(PG8_HI(Bt[n]), PG8_HI(At[m]), acc[ai][bj][m][n], 0, 0, 0); } } \
        __builtin_amdgcn_s_setprio(0); if constexpr (FP8) __builtin_amdgcn_sched_barrier(0); } while (0)
#define PG8_WAIT_V(n) asm volatile("s_waitcnt vmcnt(" #n ")" ::: "memory")
#define PG8_WAIT_L(n) asm volatile("s_waitcnt lgkmcnt(" #n ")" ::: "memory")
#define PG8_BAR __builtin_amdgcn_s_barrier()
#define PG8_SCHED __builtin_amdgcn_sched_barrier(0)
    Unit cur, nxt; int ui = 0;
    if (!S.next(0, cur)) return;
    f32x4 acc[2][2][4][2], bvn[2][2];
    E.bias(cur, wc, fq, bvn);
#pragma unroll
    for (int a = 0; a < 2; ++a)
#pragma unroll
        for (int b = 0; b < 2; ++b)
#pragma unroll
            for (int m = 0; m < 4; ++m)
#pragma unroll
                for (int n = 0; n < 2; ++n) acc[a][b][m][n] = bvn[b][n];
    typedef int v4i_ __attribute__((ext_vector_type(4))); typedef int v8i_ __attribute__((ext_vector_type(8)));
    v8i_ At[4], B0[2], B1[2];
    int sc8 = 0x7f7f7f7f; asm volatile("" : "+v"(sc8));
    unsigned vA[2][2], vN[2][2];
    S.a_off(cur, vA);
    const char* cB = S.b_base(cur);
    PG8_STAGEB(PG8_SB(0, 0), cB); PG8_STAGEB(PG8_SB(0, 1), cB + hstep); PG8_STAGEA(PG8_SA(0, 0), vA, 0, 0); PG8_STAGEA(PG8_SA(0, 1), vA, 1, 0);
    if (wr == 1) PG8_BAR;
    PG8_WAIT_V(2); PG8_BAR;
    PG8_STAGEB(PG8_SB(1, 0), cB + kstep); PG8_STAGEA(PG8_SA(1, 0), vA, 0, kstep); PG8_STAGEB(PG8_SB(1, 1), cB + hstep + kstep);
    PG8_WAIT_V(6); PG8_BAR;
    for (;;) {
        const bool has_next = S.next(ui + 1, nxt);
        const char* nB = cB;
#pragma unroll
        for (int h = 0; h < 2; ++h)
#pragma unroll
            for (int i = 0; i < 2; ++i) vN[h][i] = vA[h][i];
        if (has_next) { S.a_off(nxt, vN); nB = S.b_base(nxt); }
#pragma unroll 1
        for (int t = 0; t < nt; t += 2) {
            const bool last = (t == nt - 2);
            const size_t k1 = (size_t)(t + 1) * kstep;
            const size_t k2 = last ? 0 : (size_t)(t + 2) * kstep, k3 = k2 + kstep;
            const char* b2 = last ? nB : cB + (size_t)(t + 2) * kstep; const char* b3 = b2 + kstep;
            PG8_LDB(B0, 0, 0); PG8_LDB(B1, 0, 1); PG8_SCHED; PG8_LDA(At, 0, 0); PG8_STAGEA(PG8_SA(1, 1), vA, 1, k1);
            PG8_WAIT_V(8); PG8_WAIT_L(0); PG8_BAR; PG8_MMA(0, 0, At, B0); PG8_MMA(0, 1, At, B1); PG8_BAR; PG8_SCHED;
            PG8_LDA(At, 0, 1); PG8_STAGEB(PG8_SB(0, 0), b2); PG8_STAGEB(PG8_SB(0, 1), b2 + hstep); PG8_STAGEA2(PG8_SA(0, 0), 0, k2);
            PG8_WAIT_V(8); PG8_WAIT_L(0); PG8_BAR; PG8_MMA(1, 0, At, B0); PG8_MMA(1, 1, At, B1); PG8_BAR; PG8_SCHED;
            PG8_LDB(B0, 1, 0); PG8_LDB(B1, 1, 1); PG8_SCHED; PG8_LDA(At, 1, 0); PG8_STAGEA2(PG8_SA(0, 1), 1, k2);
            PG8_WAIT_V(8); PG8_WAIT_L(0); PG8_BAR; PG8_MMA(0, 0, At, B0); PG8_MMA(0, 1, At, B1); PG8_BAR; PG8_SCHED;
            PG8_LDA(At, 1, 1); PG8_STAGEB(PG8_SB(1, 0), b3); PG8_STAGEB(PG8_SB(1, 1), b3 + hstep); PG8_STAGEA2(PG8_SA(1, 0), 0, k3);
            PG8_WAIT_V(8); PG8_WAIT_L(0); PG8_BAR; PG8_MMA(1, 0, At, B0); PG8_MMA(1, 1, At, B1); PG8_BAR; PG8_SCHED;
        }
        if constexpr (ALIGN_EPI) { if (wr == 0) PG8_BAR; }
        if constexpr (FP8) asm volatile("s_nop 15\n\ts_nop 7" ::: "memory");
        if (has_next) E.bias(nxt, wc, fq, bvn);
        if (!Epi::AFTER_DRAIN || has_next) E(acc, cur, wr, wc, fr, fq);
        if (!has_next) break;
#pragma unroll
        for (int a = 0; a < 2; ++a)
#pragma unroll
            for (int b = 0; b < 2; ++b)
#pragma unroll
                for (int m = 0; m < 4; ++m)
#pragma unroll
                    for (int n = 0; n < 2; ++n) acc[a][b][m][n] = bvn[b][n];
        cur = nxt; cB = nB; ++ui;
#pragma unroll
        for (int h = 0; h < 2; ++h)
#pragma unroll
            for (int i = 0; i < 2; ++i) vA[h][i] = vN[h][i];
        if constexpr (ALIGN_EPI) { if (wr == 1) PG8_BAR; }
    }
    PG8_WAIT_V(0);
    if constexpr (!ALIGN_EPI) { if (wr == 0) PG8_BAR; }
    PG8_BAR;
    if constexpr (Epi::AFTER_DRAIN) E(acc, cur, wr, wc, fr, fq);
#undef PG8_SA
#undef PG8_SB
#undef PG8_STAGEA
#undef PG8_UPTR
#undef PG8_STAGEA2
#undef PG8_STAGEB
#undef PG8_LDA
#undef PG8_LD8
#undef PG8_LO
#undef PG8_HI
#undef PG8_LDB
#undef PG8_MMA
#undef PG8_WAIT_V
#undef PG8_WAIT_L
#undef PG8_BAR
#undef PG8_SCHED
}

typedef const f32x4 (&AccRef)[2][2][4][2];
__device__ __forceinline__ u32x4 pack8(f32x4 a, f32x4 b) { u32x4 w; w.x = cvtpk(a[0], a[1]); w.y = cvtpk(a[2], a[3]); w.z = cvtpk(b[0], b[1]); w.w = cvtpk(b[2], b[3]); return w; }

struct EpiInProj {
    static constexpr bool PERM = true, AFTER_DRAIN = false;
    bf16_t *U, *Q, *Kb, *V; const float* rope;
    __device__ __forceinline__ void bias(const Unit&, int, int, f32x4 (&bv)[2][2]) const { bv[0][0] = bv[0][1] = bv[1][0] = bv[1][1] = (f32x4){0.f, 0.f, 0.f, 0.f}; }
    __device__ __forceinline__ void operator()(AccRef acc, const Unit& u, int wr, int wc, int fr, int fq) const {
        const int row0 = u.pm * BM + wr * 64 + fr;
        if (u.pn < 4) {
#pragma unroll
            for (int ai = 0; ai < 2; ++ai)
#pragma unroll
                for (int m = 0; m < 4; ++m) { const int row = row0 + ai * HALF + m * 16; f32x4 o[2];
#pragma unroll
                    for (int n = 0; n < 2; ++n)
#pragma unroll
                        for (int i = 0; i < 4; ++i) o[n][i] = acc[ai][0][m][n][i] * fsigmoid(acc[ai][1][m][n][i]);
                    st16_wt(U + (size_t)row * DCONV + u.pn * 128 + wc * 32 + 8 * fq, pack8(o[0], o[1])); }
        } else if (u.pn < 8) {
            const bool isq = u.pn < 6; bf16_t* dst = isq ? Q : Kb; const float sc = isq ? QSCALE : 1.0f;
            const int head = 4 * (u.pn & 1) + wc;
#pragma unroll
            for (int ai = 0; ai < 2; ++ai) { f32x4 cs[4][2], sn[4][2];
#pragma unroll
                for (int m = 0; m < 4; ++m) { const int row = row0 + ai * HALF + m * 16;
#pragma unroll
                    for (int n = 0; n < 2; ++n) { cs[m][n] = *(const f32x4*)(rope + (size_t)row * 32 + 8 * fq + 4 * n); sn[m][n] = *(const f32x4*)(rope + (size_t)NTOK * 32 + (size_t)row * 32 + 8 * fq + 4 * n); } }
#pragma unroll
                for (int m = 0; m < 4; ++m) { const int row = row0 + ai * HALF + m * 16; f32x4 lo[2], hi[2];
#pragma unroll
                    for (int n = 0; n < 2; ++n) { const f32x4 a = acc[ai][0][m][n], b = acc[ai][1][m][n];
                        lo[n] = (a * cs[m][n] - b * sn[m][n]) * sc; hi[n] = (b * cs[m][n] + a * sn[m][n]) * sc; }
                    bf16_t* p = dst + (size_t)row * DATT + head * 64 + 8 * fq;
                    st16_wt(p, pack8(lo[0], lo[1])); st16_wt(p + 32, pack8(hi[0], hi[1])); } }
        } else {
#pragma unroll
            for (int ai = 0; ai < 2; ++ai)
#pragma unroll
                for (int m = 0; m < 4; ++m) { const int row = row0 + ai * HALF + m * 16;
#pragma unroll
                    for (int bj = 0; bj < 2; ++bj) st16_wt(V + (size_t)row * DATT + (u.pn - 8) * 256 + bj * 128 + wc * 32 + 8 * fq, pack8(acc[ai][bj][m][0], acc[ai][bj][m][1])); }
        }
    }
};
struct EpiBiasBf16 {
    static constexpr bool PERM = true, AFTER_DRAIN = false;
    bf16_t* O; int ldc; const float* bvec;
    __device__ __forceinline__ void bias(const Unit& u, int wc, int fq, f32x4 (&bv)[2][2]) const {
        const int col0 = u.pn * BM + wc * 32 + 8 * fq;
#pragma unroll
        for (int bj = 0; bj < 2; ++bj)
#pragma unroll
            for (int n = 0; n < 2; ++n) bv[bj][n] = *(const f32x4*)(bvec + col0 + bj * HALF + 4 * n);
    }
    __device__ __forceinline__ void operator()(AccRef acc, const Unit& u, int wr, int wc, int fr, int fq) const {
        const int row0 = u.pm * BM + wr * 64 + fr, col0 = u.pn * BM + wc * 32 + 8 * fq;
#pragma unroll
        for (int ai = 0; ai < 2; ++ai)
#pragma unroll
            for (int m = 0; m < 4; ++m) { bf16_t* rowp = O + (size_t)(row0 + ai * HALF + m * 16) * ldc + col0;
#pragma unroll
                for (int bj = 0; bj < 2; ++bj) st16_wt(rowp + bj * HALF, pack8(acc[ai][bj][m][0], acc[ai][bj][m][1])); }
    }
};
struct EpiPlainBf16 {
    static constexpr bool PERM = true, AFTER_DRAIN = false;
    bf16_t* O; int ldc;
    __device__ __forceinline__ void bias(const Unit&, int, int, f32x4 (&bv)[2][2]) const { bv[0][0] = bv[0][1] = bv[1][0] = bv[1][1] = (f32x4){0.f, 0.f, 0.f, 0.f}; }
    __device__ __forceinline__ void operator()(AccRef acc, const Unit& u, int wr, int wc, int fr, int fq) const {
        const int row0 = u.pm * BM + wr * 64 + fr, col0 = u.pn * BM + wc * 32 + 8 * fq;
#pragma unroll
        for (int ai = 0; ai < 2; ++ai)
#pragma unroll
            for (int m = 0; m < 4; ++m) { bf16_t* rowp = O + (size_t)(row0 + ai * HALF + m * 16) * ldc + col0;
#pragma unroll
                for (int bj = 0; bj < 2; ++bj) st16_wt(rowp + bj * HALF, pack8(acc[ai][bj][m][0], acc[ai][bj][m][1])); }
    }
};
__device__ __forceinline__ u32x4 widen16(u32x2 a, u32x2 b) {
    const auto r0 = __builtin_amdgcn_permlane16_swap(a.x, b.x, false, false); const auto r1 = __builtin_amdgcn_permlane16_swap(a.y, b.y, false, false);
    u32x4 o; o.x = r0[0]; o.y = r1[0]; o.z = r0[1]; o.w = r1[1]; return o;
}
struct EpiSwiglu {
    static constexpr bool PERM = true, AFTER_DRAIN = false;
    unsigned char* H; const float *bg, *bu; const volatile LAS int* tp;
    const MoeOrder* S;
    __device__ __forceinline__ const float* bias_ptr(const Unit& u, int tc) const { return (tc < 128 ? bg + tc : bu + (tc - 128)) + (size_t)u.e * DFF + u.pn * 128; }
    __device__ __forceinline__ void bias(const Unit& u, int wc, int fq, f32x4 (&bv)[2][2]) const { S->plan_bias(u, wc, fq, bv); }
    __device__ __forceinline__ void operator()(AccRef acc, const Unit& u, int wr, int wc, int fr, int fq) const {
        const int row0 = __builtin_amdgcn_readfirstlane(tp[u.e]) * BM + u.pm * BM + wr * 64 + fr, col0 = u.pn * 128 + wc * 32 + 8 * fq;
#pragma unroll
        for (int ai = 0; ai < 2; ++ai) { u32x2 w8[4];
#pragma unroll
            for (int m = 0; m < 4; ++m) { f32x4 o[2];
#pragma unroll
                for (int n = 0; n < 2; ++n)
#pragma unroll
                    for (int i = 0; i < 4; i += 2) { const f32x2 ga = {acc[ai][0][m][n][i], acc[ai][0][m][n][i + 1]}, ua = {acc[ai][1][m][n][i], acc[ai][1][m][n][i + 1]};
                        const f32x2 gm = __builtin_elementwise_min(ga, (f32x2){SWI_LIMIT * WSCALE8, SWI_LIMIT * WSCALE8});
                        const f32x2 g = gm * WINV8, ea = gm * (-SWI_ALPHA * 1.4426950408889634f * WINV8);
                        f32x2 ex; ex.x = __builtin_amdgcn_exp2f(ea.x); ex.y = __builtin_amdgcn_exp2f(ea.y);
                        const f32x2 dn = ex + 1.0f; f32x2 rc; rc.x = __builtin_amdgcn_rcpf(dn.x); rc.y = __builtin_amdgcn_rcpf(dn.y);
                        f32x2 u1 = __builtin_elementwise_fma(ua, (f32x2){WINV8, WINV8}, (f32x2){1.0f, 1.0f});
                        u1 = __builtin_elementwise_min(__builtin_elementwise_max(u1, (f32x2){1.0f - SWI_LIMIT, 1.0f - SWI_LIMIT}), (f32x2){1.0f + SWI_LIMIT, 1.0f + SWI_LIMIT});
                        const f32x2 r = (u1 * g) * rc; o[n][i] = r.x; o[n][i + 1] = r.y; }
                w8[m].x = pk4_fp8(o[0][0], o[0][1], o[0][2], o[0][3]); w8[m].y = pk4_fp8(o[1][0], o[1][1], o[1][2], o[1][3]); }
#pragma unroll
            for (int mp = 0; mp < 2; ++mp) { const u32x4 v16 = widen16(w8[2 * mp], w8[2 * mp + 1]);
                *(u32x4*)(H + (size_t)(row0 + ai * HALF + (2 * mp + (fq & 1)) * 16) * DFF + (col0 - 8 * fq + 16 * (fq >> 1))) = v16; } }
    }
};
struct EpiDown {
    static constexpr bool PERM = true, AFTER_DRAIN = false;
    unsigned char* Y; const float* bd; const volatile LAS int* tp;
    const MoeOrder* S;
    __device__ __forceinline__ const float* bias_ptr(const Unit& u, int tc) const { return bd + (size_t)u.e * DM + u.pn * BM + tc; }
    __device__ __forceinline__ void bias(const Unit& u, int wc, int fq, f32x4 (&bv)[2][2]) const { S->plan_bias(u, wc, fq, bv); }
    __device__ __forceinline__ void operator()(AccRef acc, const Unit& u, int wr, int wc, int fr, int fq) const {
        const int row0 = __builtin_amdgcn_readfirstlane(tp[u.e]) * BM + u.pm * BM + wr * 64 + fr, col0 = u.pn * BM + wc * 32 + 8 * fq;
#pragma unroll
        for (int ai = 0; ai < 2; ++ai)
#pragma unroll
            for (int mp = 0; mp < 2; ++mp)
#pragma unroll
                for (int bj = 0; bj < 2; ++bj) { u32x2 w8[2];
#pragma unroll
                    for (int q = 0; q < 2; ++q) { const f32x4 y0 = acc[ai][bj][2 * mp + q][0] * WINV8, y1 = acc[ai][bj][2 * mp + q][1] * WINV8; w8[q].x = pk4_fp8(y0[0], y0[1], y0[2], y0[3]); w8[q].y = pk4_fp8(y1[0], y1[1], y1[2], y1[3]); }
                    *(u32x4*)(Y + (size_t)(row0 + ai * HALF + (2 * mp + (fq & 1)) * 16) * DM + (col0 - 8 * fq + 16 * (fq >> 1)) + bj * HALF) = widen16(w8[0], w8[1]); }
    }
};
}

#define XB_TMO      128
#define XB_XCNT(j)  (256  + 64 * (j))
#define XB_XSUB(j)  (1280 + 64 * (j))
#define XB_XGEN(j)  (2304 + 64 * (j))
#define XB_TOP      3328
#define XB_TOPGEN   3392
#define XCD_BAR_WORDS 3456
#define XB_SPIN_CAP (1u << 18)
__device__ __forceinline__ unsigned xb_ld(unsigned* p)              { return __hip_atomic_load(p, __ATOMIC_RELAXED, __HIP_MEMORY_SCOPE_AGENT); }
__device__ __forceinline__ unsigned xb_add(unsigned* p, unsigned v) { return __hip_atomic_fetch_add(p, v, __ATOMIC_RELAXED, __HIP_MEMORY_SCOPE_AGENT); }
__device__ __forceinline__ unsigned xb_xcc_id() { return (unsigned)__builtin_amdgcn_s_getreg((3 << 11) | 20) & 0xFu; }
#define XB_SPIN(cond, bar) do { unsigned _sp = 0; while (cond) { __builtin_amdgcn_s_sleep(1); \
    if ((++_sp & 255u) == 0u) { if (xb_ld(&(bar)[XB_TMO])) break; if (_sp > XB_SPIN_CAP) { atomicAdd(&(bar)[XB_TMO], 1u); break; } } } } while (0)
struct XcdBarrier { unsigned* bar; unsigned x; volatile LAS unsigned* st; };
__device__ __forceinline__ XcdBarrier xcd_barrier_post(unsigned* bar, volatile LAS unsigned* st) {
    XcdBarrier b; b.bar = bar; b.x = xb_xcc_id(); b.st = st;
    if (threadIdx.x == 0) (void)xb_add(&bar[XB_XCNT(b.x)], 1u);
    return b;
}
__device__ __forceinline__ void xcd_barrier_complete(unsigned* bar, unsigned x, unsigned& nloc, unsigned& nx) {
    const unsigned G = gridDim.x * gridDim.y * gridDim.z;
    unsigned sum, cnt, mine, sp = 0u;
    for (;;) {
        sum = 0u; cnt = 0u; mine = 0u;
#pragma unroll
        for (unsigned j = 0; j < 16; ++j) { const unsigned c = xb_ld(&bar[XB_XCNT(j)]); sum += c; cnt += (c > 0u) ? 1u : 0u; mine = (j == x) ? c : mine; }
        if (sum == G) break;
        __builtin_amdgcn_s_sleep(1);
        if ((++sp & 255u) == 0u) { if (xb_ld(&bar[XB_TMO])) break; if (sp > XB_SPIN_CAP) { atomicAdd(&bar[XB_TMO], 1u); break; } }
    }
    nloc = mine > 0u ? mine : 1u; nx = cnt > 0u ? cnt : 1u;
}
__device__ __forceinline__ void xcd_barrier(const XcdBarrier& b) {
    asm volatile("s_waitcnt vmcnt(0)" ::: "memory");
    __syncthreads();
    if (threadIdx.x == 0) {
        unsigned* bar = b.bar;
        __builtin_amdgcn_s_waitcnt(0);
        unsigned nloc = b.st[0], nx = b.st[1];
        if (nloc == 0u) { xcd_barrier_complete(bar, b.x, nloc, nx); b.st[0] = nloc; b.st[1] = nx; }
        const unsigned old = xb_add(&bar[XB_XSUB(b.x)], 1u);
        const unsigned gen = old / nloc;
        if (old + 1u == (gen + 1u) * nloc) {
            __builtin_amdgcn_fence(__ATOMIC_RELEASE, "agent");
            asm volatile("s_waitcnt vmcnt(0)" ::: "memory");
            const unsigned og = xb_add(&bar[XB_TOP], 1u);
            const unsigned tg = og / nx;
            if (og + 1u == (tg + 1u) * nx) xb_add(&bar[XB_TOPGEN], 1u);
            else XB_SPIN(xb_ld(&bar[XB_TOPGEN]) == tg, bar);
            __builtin_amdgcn_fence(__ATOMIC_ACQUIRE, "agent");
            xb_add(&bar[XB_XGEN(b.x)], 1u);
            asm volatile("s_waitcnt vmcnt(0)" ::: "memory");
        } else {
            XB_SPIN(xb_ld(&bar[XB_XGEN(b.x)]) == gen, bar);
            __builtin_amdgcn_fence(__ATOMIC_ACQUIRE, "agent");
            asm volatile("s_waitcnt vmcnt(0)" ::: "memory");
        }
    }
    __syncthreads();
}

struct Args { const void* in[22]; float* out; unsigned char* ws; int ph_lo, ph_hi, li, pad; };
struct Frame {
    LAS unsigned char* lds; volatile LAS unsigned* MISC; gu32* ctl;
    int tid, lane, wave, vcu, G;
    bool bg, conv; int wc8, cidx;
    unsigned char* ws;
};

template <class RowMap>
__device__ __forceinline__ void tr_item(const float* W, int N, int K, bf16_t* WT, const RowMap& rm, LAS float* scr, int k0, int n0, int lane) {
    const int n4 = lane & 15, kr = lane >> 4;
    f32x4 v[16];
#pragma unroll
    for (int i = 0; i < 16; ++i) v[i] = *(const GAS f32x4*)(W + (size_t)(k0 + kr + 4 * i) * N + n0 + 4 * n4);
#pragma unroll
    for (int i = 0; i < 16; ++i) { LAS float* p = scr + (kr + 4 * i) * 65 + 4 * n4; p[0] = v[i][0]; p[1] = v[i][1]; p[2] = v[i][2]; p[3] = v[i][3]; }
    LDS_WAIT(); asm volatile("" ::: "memory");
    const int c = (lane & 3) + 4 * (lane >> 5), nn = (lane >> 2) & 7;
#pragma unroll
    for (int it = 0; it < 8; ++it) { const int n = nn + 8 * it; const LAS float* s = scr + (8 * c) * 65 + n;
        u32x4 o; o.x = cvtpk(s[0], s[65]); o.y = cvtpk(s[2 * 65], s[3 * 65]); o.z = cvtpk(s[4 * 65], s[5 * 65]); o.w = cvtpk(s[6 * 65], s[7 * 65]);
        *(GAS u32x4*)(WT + (size_t)rm(n0 + n) * K + k0 + 8 * c) = o; }
    LDS_WAIT(); asm volatile("" ::: "memory");
}
template <class RowMap>
__device__ __forceinline__ void tr_item8(const float* W, int N, int K, unsigned char* WT, const RowMap& rm, LAS float* scr, int k0, int n0, int lane, float scale) {
    const int n4 = lane & 15, kr = lane >> 4;
    f32x4 v[16];
#pragma unroll
    for (int i = 0; i < 16; ++i) v[i] = *(const GAS f32x4*)(W + (size_t)(k0 + kr + 4 * i) * N + n0 + 4 * n4);
#pragma unroll
    for (int i = 0; i < 16; ++i) { LAS float* p = scr + (kr + 4 * i) * 65 + 4 * n4; p[0] = v[i][0] * scale; p[1] = v[i][1] * scale; p[2] = v[i][2] * scale; p[3] = v[i][3] * scale; }
    LDS_WAIT(); asm volatile("" ::: "memory");
    const int c = (lane & 1) + 2 * (lane >> 5), nn = (lane >> 1) & 15;
#pragma unroll
    for (int it = 0; it < 4; ++it) { const int n = nn + 16 * it; const LAS float* s = scr + (16 * c) * 65 + n;
        u32x4 o; o.x = pk4_fp8(s[0], s[65], s[2 * 65], s[3 * 65]); o.y = pk4_fp8(s[4 * 65], s[5 * 65], s[6 * 65], s[7 * 65]);
        o.z = pk4_fp8(s[8 * 65], s[9 * 65], s[10 * 65], s[11 * 65]); o.w = pk4_fp8(s[12 * 65], s[13 * 65], s[14 * 65], s[15 * 65]);
        *(GAS u32x4*)(WT + (size_t)rm(n0 + n) * K + k0 + 16 * c) = o; }
    LDS_WAIT(); asm volatile("" ::: "memory");
}
struct MapIdent { int off; __device__ __forceinline__ int operator()(int n) const { return off + n; } };
struct MapGateUp { int off; __device__ __forceinline__ int operator()(int n) const { return off + 256 * (n >> 7) + (n & 127); } };
struct MapInProj { __device__ __forceinline__ int operator()(int n) const {
    if (n < 512) return 256 * (n >> 7) + (n & 127);
    if (n < 1024) { const int c = n - 512; return 256 * (c >> 7) + 128 + (c & 127); }
    if (n < 2048) { const int c = (n - 1024) & 511, h = c >> 6, d = c & 63; return 256 * ((n < 1536 ? 4 : 6) + (h >> 2)) + 128 * (d >> 5) + (h & 3) * 32 + (d & 31); }
    return n; } };

__device__ __forceinline__ void sincos_d(double a, float& c, float& s) {
    const double TWO_PI = 6.283185307179586476925286766559, INV = 0.15915494309189533576888376337251;
    const double n = __builtin_rint(a * INV); double r = __builtin_fma(-n, TWO_PI, a); r = __builtin_fma(-n, 2.4492935982947064e-16, r) ;
    const double r2 = r * r; double sp = 0.0, cp = 0.0;
#pragma unroll
    for (int k = 13; k >= 1; --k) { sp = (sp + 1.0) * (r2 * (-1.0 / (double)((2 * k) * (2 * k + 1)))); cp = (cp + 1.0) * (r2 * (-1.0 / (double)((2 * k - 1) * (2 * k)))); }
    s = (float)(r * (1.0 + sp)); c = (float)(1.0 + cp);
}

constexpr int CV_I_IN = 16 * 40, CV_I_PW = 8 * 8, CV_I_OUT = 16 * 16, CV_I_E = 16 * 16;
constexpr int CV_NEXP = NEXP * 3 * CV_I_E, CV_NITEMS = CV_NEXP + CV_I_IN + CV_I_PW + CV_I_OUT;
constexpr int NCONVX = 4, NCONV = 8 * NCONVX, NWORK = 256 - NCONV;
#ifndef WD_P3_
#define WD_P3_ 2048
#endif
constexpr int WD_P3 = WD_P3_;
#ifndef P1_GT_
#define P1_GT_ 1280
#endif
constexpr int P1_GT = P1_GT_;
constexpr int P1_NG = 20;
#ifndef CV_NTAIL_
#define CV_NTAIL_ 6144
#endif
constexpr int CV_NTAIL = CV_NTAIL_;
#ifndef CV_S1_
#define CV_S1_ 5600
#define CV_S2_ 9400
#define CV_S3_ 11300
#endif
constexpr int CV_S1 = CV_S1_, CV_S2 = CV_S2_, CV_S3 = CV_S3_;
struct CvItem { const float* W; unsigned char* dst; int N, K, k0, n0, mode; };
__device__ __forceinline__ CvItem cv_decode(const Args& a, unsigned char* ws, int r) {
    CvItem c;
    if (r < CV_NEXP) {
        const int e = r / (3 * CV_I_E), q = r % (3 * CV_I_E), which = q / CV_I_E, t = q % CV_I_E; c.k0 = 64 * (t / 16); c.n0 = 64 * (t % 16); c.mode = which; c.N = DM; c.K = DM;
        if (which == 0) { c.W = (const float*)a.in[14] + (size_t)e * DM * DFF; c.dst = ws + WS_WGU + (size_t)e * 2048 * DM; }
        else if (which == 1) { c.W = (const float*)a.in[16] + (size_t)e * DM * DFF; c.dst = ws + WS_WGU + (size_t)e * 2048 * DM; }
        else { c.W = (const float*)a.in[18] + (size_t)e * DFF * DM; c.dst = ws + WS_WD + (size_t)e * DM * DFF; }
        return c; }
    r -= CV_NEXP;
    if (r < CV_I_IN) { c.W = (const float*)a.in[2]; c.dst = ws + WS_WIN; c.N = NPROJ; c.K = DM; c.k0 = 64 * (r / 40); c.n0 = 64 * (r % 40); c.mode = 3; return c; } r -= CV_I_IN;
    if (r < CV_I_PW) { c.W = (const float*)a.in[7]; c.dst = ws + WS_WPW; c.N = DCONV; c.K = DCONV; c.k0 = 64 * (r / 8); c.n0 = 64 * (r % 8); c.mode = 4; return c; } r -= CV_I_PW;
    c.W = (const float*)a.in[9]; c.dst = ws + WS_WOUT; c.N = DM; c.K = DM; c.k0 = 64 * (r / 16); c.n0 = 64 * (r % 16); c.mode = 5; return c;
}
__device__ __forceinline__ void cv_load(const CvItem& c, int lane, f32x4 (&v)[16]) {
    const int n4 = lane & 15, kr = lane >> 4;
#pragma unroll
    for (int i = 0; i < 16; ++i) v[i] = *(const GAS f32x4*)(c.W + (size_t)(c.k0 + kr + 4 * i) * c.N + c.n0 + 4 * n4);
}
__device__ __forceinline__ int cv_row(int mode, int n) {
    if (mode == 0) return 256 * (n >> 7) + (n & 127);
    if (mode == 1) return 128 + 256 * (n >> 7) + (n & 127);
    if (mode == 3) return MapInProj{}(n);
    return n;
}
template <int REMAP>
__device__ __forceinline__ int cv_remap(int j) { return REMAP == 1 ? (j >> 9) * 768 + (j & 511) : REMAP == 2 ? (j >> 8) * 768 + 512 + (j & 255) : j; }
template <int REMAP = 0>
__device__ __forceinline__ void convert_items(Frame& F, const Args& a, int first, int last, int wg, int NWG, int grp = 1) {
    const int lane = F.lane, p = F.wave & 3; const bool loader = F.wave < 4;
    const int stride = NWG * 4, base = first + wg * 4 + p;
    const int span = last - first - wg * 4; int nsteps = span <= 0 ? 0 : (span + stride - 1) / stride;
    if (grp == 2) { const int span1 = span - 4; nsteps += span1 <= 0 ? 0 : (span1 + stride - 1) / stride; }
    if (nsteps == 0) return;
#define CV_TILE(s_) (grp == 2 ? base + ((s_) >> 1) * stride + ((s_) & 1) * 4 : base + (s_) * stride)
    LAS float* slot0 = (LAS float*)(F.lds + (p * 2 + 0) * 16640); LAS float* slot1 = (LAS float*)(F.lds + (p * 2 + 1) * 16640);
    const int n4 = lane & 15, kr = lane >> 4;
    f32x4 vA[16], vB[16], vC[16]; CvItem cA, cB, cC; cA = cv_decode(a, F.ws, cv_remap<REMAP>(base < last ? base : first)); cB = cA; cC = cA; const int t1_ = CV_TILE(1), t2_ = CV_TILE(2);
    if (loader) { if (base < last) cv_load(cA, lane, vA); if (t1_ < last) { cB = cv_decode(a, F.ws, cv_remap<REMAP>(t1_)); cv_load(cB, lane, vB); }
                  if (t2_ < last) { cC = cv_decode(a, F.ws, cv_remap<REMAP>(t2_)); cv_load(cC, lane, vC); } }
#define CV_LOADER_STEP(vX, cX, slotX, s_) do { const int it_ = CV_TILE(s_), it3_ = CV_TILE((s_) + 3); if (it_ < last) { const float sc = cX.mode < 3 ? WSCALE8 : 1.0f; \
        _Pragma("unroll") for (int i = 0; i < 16; ++i) { LAS float* q_ = slotX + (kr + 4 * i) * 65 + 4 * n4; q_[0] = vX[i][0] * sc; q_[1] = vX[i][1] * sc; q_[2] = vX[i][2] * sc; q_[3] = vX[i][3] * sc; } \
        LDS_WAIT(); if (it3_ < last) { cX = cv_decode(a, F.ws, cv_remap<REMAP>(it3_)); cv_load(cX, lane, vX); } } } while (0)
#define CV_STORER_STEP(slotX, s_) do { const int it_ = CV_TILE(s_); if (it_ < last) { const CvItem cur = cv_decode(a, F.ws, cv_remap<REMAP>(it_)); \
        if (cur.mode < 3) { const int c = (lane & 1) + 2 * (lane >> 5), nn = (lane >> 1) & 15; \
            _Pragma("unroll") for (int q = 0; q < 4; ++q) { const int n = nn + 16 * q; const LAS float* s2 = slotX + (16 * c) * 65 + n; \
                u32x4 o; o.x = pk4_fp8(s2[0], s2[65], s2[2 * 65], s2[3 * 65]); o.y = pk4_fp8(s2[4 * 65], s2[5 * 65], s2[6 * 65], s2[7 * 65]); \
                o.z = pk4_fp8(s2[8 * 65], s2[9 * 65], s2[10 * 65], s2[11 * 65]); o.w = pk4_fp8(s2[12 * 65], s2[13 * 65], s2[14 * 65], s2[15 * 65]); \
                *(GAS u32x4*)(cur.dst + (size_t)cv_row(cur.mode, cur.n0 + n) * cur.K + cur.k0 + 16 * c) = o; } \
        } else { const int c = (lane & 3) + 4 * (lane >> 5), nn = (lane >> 2) & 7; \
            _Pragma("unroll") for (int q = 0; q < 8; ++q) { const int n = nn + 8 * q; const LAS float* s2 = slotX + (8 * c) * 65 + n; \
                u32x4 o; o.x = cvtpk(s2[0], s2[65]); o.y = cvtpk(s2[2 * 65], s2[3 * 65]); o.z = cvtpk(s2[4 * 65], s2[5 * 65]); o.w = cvtpk(s2[6 * 65], s2[7 * 65]); \
                *(GAS u32x4*)((bf16_t*)cur.dst + (size_t)cv_row(cur.mode, cur.n0 + n) * cur.K + cur.k0 + 8 * c) = o; } } \
        LDS_WAIT(); } } while (0)
#define CV_BAR() do { asm volatile("s_waitcnt lgkmcnt(0)" ::: "memory"); __builtin_amdgcn_s_barrier(); asm volatile("" ::: "memory"); } while (0)
    if (loader) {
        for (int s_ = 0; s_ < nsteps; s_ += 6) {
            CV_LOADER_STEP(vA, cA, slot0, s_); CV_BAR();
            if (s_ + 1 < nsteps) { CV_LOADER_STEP(vB, cB, slot1, s_ + 1); CV_BAR(); }
            if (s_ + 2 < nsteps) { CV_LOADER_STEP(vC, cC, slot0, s_ + 2); CV_BAR(); }
            if (s_ + 3 < nsteps) { CV_LOADER_STEP(vA, cA, slot1, s_ + 3); CV_BAR(); }
            if (s_ + 4 < nsteps) { CV_LOADER_STEP(vB, cB, slot0, s_ + 4); CV_BAR(); }
            if (s_ + 5 < nsteps) { CV_LOADER_STEP(vC, cC, slot1, s_ + 5); CV_BAR(); }
        }
    } else {
        for (int s_ = 0; s_ < nsteps; s_ += 2) {
            CV_BAR(); CV_STORER_STEP(slot0, s_);
            if (s_ + 1 < nsteps) { CV_BAR(); CV_STORER_STEP(slot1, s_ + 1); }
        }
    }
    CV_BAR();
#undef CV_LOADER_STEP
#undef CV_TILE
#undef CV_STORER_STEP
#undef CV_BAR
}
__device__ __forceinline__ void p0_prologue(Frame& F, const Args& a) {
    const int gw = F.vcu * 8 + F.wave, NGW = F.G * 8;
    const float* x = (const float*)a.in[0]; bf16_t* XB = (bf16_t*)(F.ws + WS_XB);
    const int* pos = (const int*)a.in[1]; float* rope = (float*)(F.ws + WS_ROPE);
    for (int m0 = gw; m0 < NTOK; m0 += 8 * NGW) {
        f32x4 v[8][4];
#pragma unroll
        for (int k = 0; k < 8; ++k) { const int m = m0 + k * NGW; if (m < NTOK) {
#pragma unroll
            for (int j = 0; j < 4; ++j) v[k][j] = ((const GAS f32x4*)(x + (size_t)m * DM) + F.lane)[64 * j]; } }
        if (m0 == gw) {
            const int i = F.tid & 31;
            double inv_freq = 1.0;
            for (int q = 0; q < i; ++q) inv_freq *= 0.7498942093324558;
            for (int idx = (F.vcu * 512 + F.tid); idx < NTOK * 32; idx += F.G * 512) {
                float c, s_; sincos_d((double)pos[idx >> 5] * inv_freq, c, s_);
                rope[idx] = c; rope[NTOK * 32 + idx] = s_;
            }
            const float* rw = (const float*)a.in[12]; bf16_t* WrT = (bf16_t*)(F.ws + WS_WRT);
            for (int idx = F.vcu * 512 + F.tid; idx < NEXP * DM; idx += F.G * 512) { const int e = idx >> 10, k = idx & 1023; const float wv = rw[k * NEXP + e]; const unsigned hb = cvtpk(wv, 0.f) & 0xffffu;
                WrT[idx] = (bf16_t)hb; WrT[NEXP * DM + idx] = (bf16_t)(cvtpk(wv - bf2f((bf16_t)hb), 0.f) & 0xffffu); }
        }
#pragma unroll
        for (int k = 0; k < 8; ++k) { const int m = m0 + k * NGW; if (m < NTOK) { GAS u32x2* o = (GAS u32x2*)(XB + (size_t)m * DM) + F.lane;
#pragma unroll
            for (int j = 0; j < 4; ++j) { u32x2 w; w.x = cvtpk(v[k][j][0], v[k][j][1]); w.y = cvtpk(v[k][j][2], v[k][j][3]); o[64 * j] = w; } } }
    }
    convert_items(F, a, F.G == 256 ? CV_NEXP : 0, CV_NITEMS, F.vcu, F.G);
}

namespace att {
constexpr int L_K = 0, L_V = 49152, L_WS = 98304, L_OST = L_WS + 8 * 256, L_END = L_OST + 8 * 4096;
__device__ __forceinline__ int crow(int r, int hi) { return (r & 3) + 8 * (r >> 2) + 4 * hi; }
__device__ __forceinline__ s16x4 vtr(const LAS char* p) { typedef short v4i16_t __attribute__((ext_vector_type(4))); return __builtin_bit_cast(s16x4, __builtin_amdgcn_ds_read_tr16_b64_v4i16((LAS v4i16_t*)p)); }
__device__ __forceinline__ void attn_unit(int b, int h, int br, int blk, const bf16_t* Q, const bf16_t* K, const bf16_t* V, bf16_t* OB, float* LSE, LAS unsigned char* lds) {
    const int tid = threadIdx.x, lane = tid & 63, r32 = lane & 31, hi = lane >> 5; const int wid = __builtin_amdgcn_readfirstlane(tid >> 6);
    const int d = 1 << (2 * br), per = 32 >> (2 * br), res = blk / per, i0 = 256 * (blk % per), kbase = i0 - 128;
    const int rowbase = b * SEQ + res;
#pragma unroll
    for (int T = 0; T < 6; ++T) {
        int sp = kbase + 64 * T + lane; sp = sp < 0 ? 0 : sp;
        const bf16_t* ks = K + (size_t)(rowbase + d * sp) * DATT + h * 64 + wid * 8;
        __builtin_amdgcn_global_load_lds((const unsigned*)ks, (LAS unsigned*)(lds + L_K + T * 8192 + wid * 1024), 16, 0, 0);
        int sv = kbase + 64 * T + 16 * (wid & 3) + (lane >> 2); sv = sv < 0 ? 0 : sv;
        const bf16_t* vs = V + (size_t)(rowbase + d * sv) * DATT + h * 64 + (wid >> 2) * 32 + (lane & 3) * 8;
        __builtin_amdgcn_global_load_lds((const unsigned*)vs, (LAS unsigned*)(lds + L_V + T * 8192 + wid * 1024), 16, 0, 0);
    }
    const int qsub = i0 + 32 * wid;
    const size_t qtok = (size_t)(rowbase + d * (qsub + r32));
    bf16x8 qr[4];
#pragma unroll
    for (int d0 = 0; d0 < 4; ++d0) qr[d0] = *(const bf16x8*)(Q + qtok * DATT + h * 64 + d0 * 16 + hi * 8);
    asm volatile("s_waitcnt vmcnt(0)" ::: "memory");
    __syncthreads();
    const int jmin = (i0 == 0) ? ((4 - wid) > 0 ? (4 - wid) : 0) : 0;
    f32x16 s[5];
    const float NEG = -INFINITY;
#pragma unroll
    for (int j = 0; j < 5; ++j) {
        if (j >= jmin) {
            const int tt = wid + j, T = tt >> 1, sub = tt & 1;
            const LAS unsigned char* kb = lds + L_K + T * 8192 + hi * 1024 + (32 * sub + r32) * 16;
            f32x16 acc = {};
#pragma unroll
            for (int d0 = 0; d0 < 4; ++d0) { const bf16x8 kf = *(const LAS bf16x8*)(kb + d0 * 2048); acc = __builtin_amdgcn_mfma_f32_32x32x16_bf16(kf, qr[d0], acc, 0, 0, 0); }
            if (j == 0) {
#pragma unroll
                for (int r = 0; r < 16; ++r) if (crow(r, hi) < r32) acc[r] = NEG;
            }
            if (j == 4) {
#pragma unroll
                for (int r = 0; r < 16; ++r) if (crow(r, hi) > r32) acc[r] = NEG;
            }
            s[j] = acc;
        } else {
#pragma unroll
            for (int r = 0; r < 16; ++r) s[j][r] = NEG;
        }
    }
    float m = NEG;
#pragma unroll
    for (int j = 0; j < 5; ++j)
#pragma unroll
        for (int r = 0; r < 16; ++r) m = fmaxf(m, s[j][r]);
    m = fmaxf(m, __shfl_xor(m, 32));
    float l = 0.f;
#pragma unroll
    for (int j = 0; j < 5; ++j)
#pragma unroll
        for (int r = 0; r < 16; ++r) { const float p = __builtin_amdgcn_exp2f(s[j][r] - m); s[j][r] = p; l += p; }
    l += __shfl_xor(l, 32);
    f32x16 o[2]; o[0] = f32x16{}; o[1] = f32x16{};
#pragma unroll
    for (int j = 0; j < 5; ++j) {
        if (j >= jmin) {
            const int tt = wid + j, T = tt >> 1, sub = tt & 1;
            const LAS char* vb = (const LAS char*)lds + L_V + T * 8192 + ((lane >> 4) & 1) * 32 + (lane & 3) * 8 + (32 * sub + 4 * hi + ((lane & 15) >> 2)) * 64;
#pragma unroll
            for (int ks = 0; ks < 2; ++ks) {
                u32x4 pw; pw.x = cvtpk(s[j][8 * ks + 0], s[j][8 * ks + 1]); pw.y = cvtpk(s[j][8 * ks + 2], s[j][8 * ks + 3]); pw.z = cvtpk(s[j][8 * ks + 4], s[j][8 * ks + 5]); pw.w = cvtpk(s[j][8 * ks + 6], s[j][8 * ks + 7]);
                const bf16x8 pa = __builtin_bit_cast(bf16x8, pw);
#pragma unroll
                for (int dh = 0; dh < 2; ++dh) {
                    const s16x4 lo = vtr(vb + dh * 4096 + ks * 1024), hi4 = vtr(vb + dh * 4096 + ks * 1024 + 512);
                    const bf16x8 vf = (bf16x8){lo[0], lo[1], lo[2], lo[3], hi4[0], hi4[1], hi4[2], hi4[3]};
                    o[dh] = __builtin_amdgcn_mfma_f32_32x32x16_bf16(pa, vf, o[dh], 0, 0, 0);
                }
            }
        }
    }
    LAS float* wsf = (LAS float*)(lds + L_WS) + wid * 64;
    if (hi == 0) wsf[r32] = __builtin_amdgcn_rcpf(l);
    LDS_WAIT(); asm volatile("" ::: "memory");
    LAS bf16_t* stg = (LAS bf16_t*)(lds + L_OST) + wid * 2048;
#pragma unroll
    for (int r = 0; r < 16; ++r) { const int orow = crow(r, hi); const float rl = wsf[orow];
#pragma unroll
        for (int dh = 0; dh < 2; ++dh) stg[orow * 64 + dh * 32 + r32] = (bf16_t)(cvtpk(o[dh][r] * rl, 0.f) & 0xffffu); }
    LDS_WAIT(); asm volatile("" ::: "memory");
    bf16_t* Ob = OB + (size_t)br * NTOK * DATT;
#pragma unroll
    for (int i = 0; i < 4; ++i) { const int row = i * 8 + (lane >> 3), ch = lane & 7; const u32x4 v = *(const LAS u32x4*)(stg + row * 64 + ch * 8);
        st16_wt(Ob + (size_t)(rowbase + d * (qsub + row)) * DATT + h * 64 + ch * 8, v); }
    if (hi == 0) LSE[((size_t)br * NTOK + qtok) * 8 + h] = m + __builtin_amdgcn_logf(l);
    __syncthreads();
}
struct UnitGeo { int rowbase, d, i0, h, br; };
__device__ __forceinline__ UnitGeo unit_geo(int j_in_xcd, int xcd) {
    const int bh = 2 * xcd + j_in_xcd / 96, jj = j_in_xcd % 96, br = jj >> 5, blk = jj & 31;
    UnitGeo g; g.br = br; g.h = bh & 7; g.d = 1 << (2 * br); const int per = 32 >> (2 * br); g.rowbase = (bh >> 3) * SEQ + blk / per; g.i0 = 256 * (blk % per); return g;
}
__device__ __forceinline__ void glds16(const void* gsrc, unsigned lds_dst) { unsigned keep;
    asm volatile("s_mov_b32 %0, m0\n\ts_mov_b32 m0, %2\n\ts_nop 0\n\tglobal_load_lds_dwordx4 %1, off\n\ts_mov_b32 m0, %0" : "=&s"(keep) : "v"(gsrc), "s"(lds_dst) : "memory"); }
__device__ __forceinline__ void dma_k(const UnitGeo& g, const bf16_t* K, unsigned ldsb, int wid, int lane) {
#pragma unroll
    for (int T = 0; T < 6; ++T) { int sp = g.i0 - 128 + 64 * T + lane; sp = sp < 0 ? 0 : sp;
        glds16(K + (size_t)(g.rowbase + g.d * sp) * DATT + g.h * 64 + wid * 8, (unsigned)__builtin_amdgcn_readfirstlane((int)(ldsb + L_K + T * 8192 + wid * 1024))); }
}
__device__ __forceinline__ void dma_v(const UnitGeo& g, const bf16_t* V, unsigned ldsb, int wid, int lane) {
#pragma unroll
    for (int T = 0; T < 6; ++T) { int sv = g.i0 - 128 + 64 * T + 16 * (wid & 3) + (lane >> 2); sv = sv < 0 ? 0 : sv;
        glds16(V + (size_t)(g.rowbase + g.d * sv) * DATT + g.h * 64 + (wid >> 2) * 32 + (lane & 3) * 8, (unsigned)__builtin_amdgcn_readfirstlane((int)(ldsb + L_V + T * 8192 + wid * 1024))); }
}
__device__ __forceinline__ void load_q(const UnitGeo& g, const bf16_t* Q, int wid, int r32, int hi, bf16x8 (&qr)[4]) {
    const bf16_t* qp = Q + (size_t)(g.rowbase + g.d * (g.i0 + 32 * wid + r32)) * DATT + g.h * 64 + hi * 8;
#pragma unroll
    for (int d0 = 0; d0 < 4; ++d0) asm volatile("global_load_dwordx4 %0, %1, off offset:%c2" : "=v"(qr[d0]) : "v"(qp), "i"(d0 * 32) : "memory");
}
__device__ __forceinline__ void attn_units(int j0, int jstep, int xcd, const bf16_t* Q, const bf16_t* K, const bf16_t* V, bf16_t* OB, float* LSE, LAS unsigned char* lds) {
    const int tid = threadIdx.x, lane = tid & 63, r32 = lane & 31, hi = lane >> 5; const int wid = __builtin_amdgcn_readfirstlane(tid >> 6);
    const unsigned ldsb = (unsigned)(size_t)lds;
    if (j0 >= 192) return;
    UnitGeo g = unit_geo(j0, xcd);
    bf16x8 qr[4];
    asm volatile("s_waitcnt vmcnt(0) lgkmcnt(0)" ::: "memory");
    dma_k(g, K, ldsb, wid, lane); load_q(g, Q, wid, r32, hi, qr);
    for (int j = j0; j < 192; j += jstep) {
        const int d = g.d, i0 = g.i0, h = g.h, br = g.br, rowbase = g.rowbase;
        dma_v(g, V, ldsb, wid, lane);
        asm volatile("s_waitcnt vmcnt(6)" : "+v"(qr[0]), "+v"(qr[1]), "+v"(qr[2]), "+v"(qr[3]) :: "memory");
        __builtin_amdgcn_s_barrier(); asm volatile("" ::: "memory");
        const int qsub = i0 + 32 * wid; const size_t qtok = (size_t)(rowbase + d * (qsub + r32));
        const int jmin = (i0 == 0) ? ((4 - wid) > 0 ? (4 - wid) : 0) : 0;
        f32x16 s[5]; const float NEG = -INFINITY;
#pragma unroll
        for (int t5 = 0; t5 < 5; ++t5) {
            const int tt = wid + t5, T = tt >> 1, sub = tt & 1;
            const LAS unsigned char* kb = lds + L_K + T * 8192 + hi * 1024 + (32 * sub + r32) * 16;
            bf16x8 kf[4];
#pragma unroll
            for (int d0 = 0; d0 < 4; ++d0) kf[d0] = *(const LAS bf16x8*)(kb + d0 * 2048);
            const float tbias = (t5 >= jmin) ? 0.f : NEG;
            f32x16 acc;
#pragma unroll
            for (int r = 0; r < 16; ++r) acc[r] = tbias;
#pragma unroll
            for (int d0 = 0; d0 < 4; ++d0) acc = __builtin_amdgcn_mfma_f32_32x32x16_bf16(kf[d0], qr[d0], acc, 0, 0, 0);
            if (t5 == 0) {
#pragma unroll
                for (int r = 0; r < 16; ++r) acc[r] = (crow(r, hi) < r32) ? NEG : acc[r];
            }
            if (t5 == 4) {
#pragma unroll
                for (int r = 0; r < 16; ++r) acc[r] = (crow(r, hi) > r32) ? NEG : acc[r];
            }
            s[t5] = acc;
        }
        float m = NEG;
#pragma unroll
        for (int t5 = 0; t5 < 5; ++t5)
#pragma unroll
            for (int r = 0; r < 16; ++r) m = fmaxf(m, s[t5][r]);
        m = fmaxf(m, __shfl_xor(m, 32));
        float l = 0.f;
#pragma unroll
        for (int t5 = 0; t5 < 5; ++t5)
#pragma unroll
            for (int r = 0; r < 16; ++r) { const float p = __builtin_amdgcn_exp2f(s[t5][r] - m); s[t5][r] = p; l += p; }
        l += __shfl_xor(l, 32);
        asm volatile("s_waitcnt vmcnt(0) lgkmcnt(0)" ::: "memory");
        __builtin_amdgcn_s_barrier(); asm volatile("" ::: "memory");
        const bool more = (j + jstep) < 192;
        UnitGeo gn = g;
        if (more) { gn = unit_geo(j + jstep, xcd); dma_k(gn, K, ldsb, wid, lane); load_q(gn, Q, wid, r32, hi, qr); }
        f32x16 o[2]; o[0] = f32x16{}; o[1] = f32x16{};
#pragma unroll
        for (int t5 = 0; t5 < 5; ++t5) {
            const int tt = wid + t5, T = tt >> 1, sub = tt & 1;
            const LAS char* vb = (const LAS char*)lds + L_V + T * 8192 + ((lane >> 4) & 1) * 32 + (lane & 3) * 8 + (32 * sub + 4 * hi + ((lane & 15) >> 2)) * 64;
            s16x4 lo[2][2], hi4[2][2];
#pragma unroll
            for (int ks = 0; ks < 2; ++ks)
#pragma unroll
                for (int dh = 0; dh < 2; ++dh) { lo[ks][dh] = vtr(vb + dh * 4096 + ks * 1024); hi4[ks][dh] = vtr(vb + dh * 4096 + ks * 1024 + 512); }
#pragma unroll
            for (int ks = 0; ks < 2; ++ks) {
                u32x4 pw; pw.x = cvtpk(s[t5][8 * ks + 0], s[t5][8 * ks + 1]); pw.y = cvtpk(s[t5][8 * ks + 2], s[t5][8 * ks + 3]); pw.z = cvtpk(s[t5][8 * ks + 4], s[t5][8 * ks + 5]); pw.w = cvtpk(s[t5][8 * ks + 6], s[t5][8 * ks + 7]);
                const bf16x8 pa = __builtin_bit_cast(bf16x8, pw);
#pragma unroll
                for (int dh = 0; dh < 2; ++dh) {
                    const bf16x8 vf = (bf16x8){lo[ks][dh][0], lo[ks][dh][1], lo[ks][dh][2], lo[ks][dh][3], hi4[ks][dh][0], hi4[ks][dh][1], hi4[ks][dh][2], hi4[ks][dh][3]};
                    o[dh] = __builtin_amdgcn_mfma_f32_32x32x16_bf16(pa, vf, o[dh], 0, 0, 0);
                }
            }
        }
        LAS float* wsf = (LAS float*)(lds + L_WS) + wid * 64;
        if (hi == 0) wsf[r32] = __builtin_amdgcn_rcpf(l);
        LDS_WAIT(); asm volatile("" ::: "memory");
        LAS bf16_t* stg = (LAS bf16_t*)(lds + L_OST) + wid * 2048;
#pragma unroll
        for (int r = 0; r < 16; ++r) { const int orow = crow(r, hi); const float rl = wsf[orow];
#pragma unroll
            for (int dh = 0; dh < 2; ++dh) stg[orow * 64 + dh * 32 + r32] = (bf16_t)(cvtpk(o[dh][r] * rl, 0.f) & 0xffffu); }
        LDS_WAIT(); asm volatile("" ::: "memory");
        bf16_t* Ob = OB + (size_t)br * NTOK * DATT;
#pragma unroll
        for (int i = 0; i < 4; ++i) { const int row = i * 8 + (lane >> 3), ch = lane & 7; const u32x4 v = *(const LAS u32x4*)(stg + row * 64 + ch * 8);
            st16_wt(Ob + (size_t)(rowbase + d * (qsub + row)) * DATT + h * 64 + ch * 8, v); }
        if (hi == 0) LSE[((size_t)br * NTOK + qtok) * 8 + h] = m + __builtin_amdgcn_logf(l);
        asm volatile("s_waitcnt lgkmcnt(0)" ::: "memory");
        __builtin_amdgcn_s_barrier(); asm volatile("" ::: "memory");
        g = gn;
    }
    asm volatile("s_waitcnt vmcnt(0)" ::: "memory");
}
}

__device__ __forceinline__ void conv_item(int item, const bf16_t* U, const float* cw, const float* cb, const float* lng, const float* lnb, bf16_t* S, LAS unsigned char* lds, int wave, int lane) {
    const int c = threadIdx.x, t0 = item * 64;
    LAS bf16_t* UT = (LAS bf16_t*)lds;
    LAS float* CT = (LAS float*)(lds + 32768);
    float w[31], x[62];
#pragma unroll
    for (int j = 0; j < 31; ++j) w[j] = cw[j * DCONV + c];
    const float bias = cb[c];
    const bool hist = (t0 % SEQ) != 0;
    const f32x4 g0 = *(const f32x4*)(lng + 8 * lane), g1 = *(const f32x4*)(lng + 8 * lane + 4), b0 = *(const f32x4*)(lnb + 8 * lane), b1 = *(const f32x4*)(lnb + 8 * lane + 4);
    u32x4 pre[4];
#define CV_ISSUE(tb) do { const int tb_ = (tb) < 0 ? 0 : (tb); _Pragma("unroll") for (int q = 0; q < 4; ++q) { const int idx = c + 512 * q; pre[q] = *(const u32x4*)(U + (size_t)(tb_ + (idx >> 6)) * DCONV + (idx & 63) * 8); } } while (0)
#define CV_WRITE() do { _Pragma("unroll") for (int q = 0; q < 4; ++q) { const int idx = c + 512 * q; *(LAS u32x4*)(UT + (idx >> 6) * DCONV + (idx & 63) * 8) = pre[q]; } } while (0)
    CV_ISSUE(t0 - 32);
    CV_WRITE();
    CV_ISSUE(t0);
    __syncthreads();
#pragma unroll
    for (int j = 0; j < 30; ++j) { const float v = bf2f(UT[(2 + j) * DCONV + c]); x[j] = hist ? v : 0.f; }
    for (int ch = 0; ch < 2; ++ch) {
        __syncthreads();
        CV_WRITE();
        if (ch == 0) CV_ISSUE(t0 + 32);
        __syncthreads();
#pragma unroll
        for (int j = 0; j < 32; ++j) x[30 + j] = bf2f(UT[j * DCONV + c]);
#pragma unroll
        for (int tt = 0; tt < 32; ++tt) { float y = bias;
#pragma unroll
            for (int j = 0; j < 31; ++j) y = __builtin_fmaf(w[j], x[tt + j], y);
            CT[tt * DCONV + c] = y; }
#pragma unroll
        for (int j = 0; j < 30; ++j) x[j] = x[32 + j];
        __syncthreads();
#pragma unroll
        for (int q = 0; q < 4; ++q) { const int tt = wave + 8 * q;
            const f32x4 v0 = *(const LAS f32x4*)(CT + tt * DCONV + 8 * lane), v1 = *(const LAS f32x4*)(CT + tt * DCONV + 8 * lane + 4);
            const float mean = wave_sum((v0[0] + v0[1]) + (v0[2] + v0[3]) + (v1[0] + v1[1]) + (v1[2] + v1[3])) * (1.f / DCONV);
            const f32x4 d0 = v0 - mean, d1 = v1 - mean;
            const float var = wave_sum((d0[0] * d0[0] + d0[1] * d0[1]) + (d0[2] * d0[2] + d0[3] * d0[3]) + (d1[0] * d1[0] + d1[1] * d1[1]) + (d1[2] * d1[2] + d1[3] * d1[3])) * (1.f / DCONV);
            const float rstd = 1.0f / sqrtf(var + LN_EPS);
            f32x4 y0 = d0 * rstd * g0 + b0, y1 = d1 * rstd * g1 + b1;
#pragma unroll
            for (int i = 0; i < 4; ++i) { y0[i] = y0[i] * fsigmoid(y0[i]); y1[i] = y1[i] * fsigmoid(y1[i]); }
            st16_wt(S + (size_t)(t0 + 32 * ch + tt) * DCONV + 8 * lane, pg8::pack8(y0, y1)); }
    }
    __syncthreads();
#undef CV_ISSUE
#undef CV_WRITE
}

__device__ __forceinline__ void combine_tokens(Frame& F, const bf16_t* OB, const float* LSE, bf16_t* AO, int gw, int NGW) {
    const int h = F.lane >> 3;
    for (int tok0 = gw * 4; tok0 < NTOK; tok0 += NGW * 4) {
        float ls[4][3]; u32x4 v[4][3];
#pragma unroll
        for (int t = 0; t < 4; ++t)
#pragma unroll
            for (int br = 0; br < 3; ++br) { ls[t][br] = LSE[((size_t)br * NTOK + tok0 + t) * 8 + h]; v[t][br] = *(const u32x4*)(OB + ((size_t)br * NTOK + tok0 + t) * DATT + 8 * F.lane); }
#pragma unroll
        for (int t = 0; t < 4; ++t) {
            const float mx = fmaxf(ls[t][0], fmaxf(ls[t][1], ls[t][2]));
            float wt[3]; float sum = 0.f;
#pragma unroll
            for (int br = 0; br < 3; ++br) { wt[br] = __builtin_amdgcn_exp2f(ls[t][br] - mx); sum += wt[br]; }
            const float rs = 1.0f / sum;
            f32x4 a0 = {0.f, 0.f, 0.f, 0.f}, a1 = {0.f, 0.f, 0.f, 0.f};
#pragma unroll
            for (int br = 0; br < 3; ++br) { const float wv = wt[br] * rs; const u32x4 q = v[t][br];
                a0[0] += wv * bflo(q.x); a0[1] += wv * bfhi(q.x); a0[2] += wv * bflo(q.y); a0[3] += wv * bfhi(q.y);
                a1[0] += wv * bflo(q.z); a1[1] += wv * bfhi(q.z); a1[2] += wv * bflo(q.w); a1[3] += wv * bfhi(q.w); }
            st16_wt(AO + (size_t)(tok0 + t) * DM + DCONV + 8 * F.lane, pg8::pack8(a0, a1));
        }
    }
}

constexpr int RT_X = 0, RT_XP = 2064;
constexpr int RT_LCNT = 147456, RT_BASE = RT_LCNT + 128, RT_TE = RT_BASE + 128, RT_TG = RT_TE + 1024, RT_END = RT_TG + 1024;
static_assert(64 * RT_XP <= RT_LCNT && 8 * 32 * 33 * 4 <= 64 * RT_XP, "route LDS map");
__device__ __forceinline__ void route_phase(Frame& F, const Args& a) {
    volatile LAS int* lcnt = (volatile LAS int*)(F.lds + RT_LCNT); volatile LAS int* lbase = (volatile LAS int*)(F.lds + RT_BASE);
    volatile LAS int* te = (volatile LAS int*)(F.lds + RT_TE); volatile LAS float* tg = (volatile LAS float*)(F.lds + RT_TG);
    const float* rb = (const float*)a.in[13]; const float* g1 = (const float*)a.in[10]; const float* b1 = (const float*)a.in[11];
    const bf16_t* MIXb = (const bf16_t*)(F.ws + WS_Z); const float* Xin = (const float*)a.in[0]; bf16_t* X1B = (bf16_t*)(F.ws + WS_X1B); unsigned char* X18 = F.ws + WS_X1F8;
    const bf16_t* WrT = (const bf16_t*)(F.ws + WS_WRT);
    int* TOKE = (int*)(F.ws + WS_TOKE); float* TOKG = (float*)(F.ws + WS_TOKG); int* LIST = (int*)(F.ws + WS_LIST);
    const int r32 = F.lane & 31, hi = F.lane >> 5;
    f32x4 gv[4], bv[4];
#pragma unroll
    for (int j = 0; j < 4; ++j) { gv[j] = *(const f32x4*)(g1 + 4 * F.lane + 256 * j); bv[j] = *(const f32x4*)(b1 + 4 * F.lane + 256 * j); }
    for (int tb = F.vcu; tb < NTOK / 64; tb += F.G) {
        if (F.tid < 32) lcnt[F.tid] = 0;
        for (int it = 0; it < 8; ++it) {
            const int tl = F.wave * 8 + it, tok = tb * 64 + tl;
            f32x4 xv[4]; float sum = 0.f;
#pragma unroll
            for (int j = 0; j < 4; ++j) { const u32x2 mx = *(const u32x2*)(MIXb + (size_t)tok * DM + 4 * F.lane + 256 * j);
                xv[j] = *(const f32x4*)(Xin + (size_t)tok * DM + 4 * F.lane + 256 * j) * DN_ALPHA + (f32x4){bflo(mx.x), bfhi(mx.x), bflo(mx.y), bfhi(mx.y)}; sum += (xv[j][0] + xv[j][1]) + (xv[j][2] + xv[j][3]); }
            const float mean = wave_sum(sum) * (1.f / DM); float sq = 0.f;
#pragma unroll
            for (int j = 0; j < 4; ++j) { xv[j] = xv[j] - mean; sq += (xv[j][0] * xv[j][0] + xv[j][1] * xv[j][1]) + (xv[j][2] * xv[j][2] + xv[j][3] * xv[j][3]); }
            const float rstd = 1.0f / sqrtf(wave_sum(sq) * (1.f / DM) + LN_EPS);
#pragma unroll
            for (int j = 0; j < 4; ++j) { xv[j] = xv[j] * rstd * gv[j] + bv[j];
                u32x2 w; w.x = cvtpk(xv[j][0], xv[j][1]); w.y = cvtpk(xv[j][2], xv[j][3]); *(u32x2*)(X1B + (size_t)tok * DM + 4 * F.lane + 256 * j) = w;
                *(LAS u32x2*)(F.lds + RT_X + tl * RT_XP + (4 * F.lane + 256 * j) * 2) = w;
                *(unsigned*)(X18 + (size_t)tok * DM + 4 * F.lane + 256 * j) = pk4_fp8(xv[j][0], xv[j][1], xv[j][2], xv[j][3]); }
        }
        __syncthreads();
        const int mb = F.wave & 1, kq = F.wave >> 1;
        f32x16 acc = {};
        {
            bf16x8 bfr[16], bfl[16];
#pragma unroll
            for (int s_ = 0; s_ < 16; ++s_) { bfr[s_] = *(const bf16x8*)(WrT + (size_t)r32 * DM + 16 * (kq * 16 + s_) + 8 * hi); bfl[s_] = *(const bf16x8*)(WrT + (size_t)NEXP * DM + (size_t)r32 * DM + 16 * (kq * 16 + s_) + 8 * hi); }
#pragma unroll
            for (int s_ = 0; s_ < 16; ++s_) { const bf16x8 af = *(const LAS bf16x8*)(F.lds + RT_X + (32 * mb + r32) * RT_XP + (16 * (kq * 16 + s_) + 8 * hi) * 2);
                acc = __builtin_amdgcn_mfma_f32_32x32x16_bf16(af, bfr[s_], acc, 0, 0, 0); acc = __builtin_amdgcn_mfma_f32_32x32x16_bf16(af, bfl[s_], acc, 0, 0, 0); }
        }
        __syncthreads();
        {
            LAS float* P = (LAS float*)(F.lds + RT_X) + (size_t)(mb * 4 + kq) * 32 * 33;
#pragma unroll
            for (int r = 0; r < 16; ++r) P[((r & 3) + 8 * (r >> 2) + 4 * hi) * 33 + r32] = acc[r];
        }
        __syncthreads();
        if (F.wave == 0) {
            const LAS float* P = (const LAS float*)(F.lds + RT_X) + (size_t)((F.lane >> 5) * 4) * 32 * 33 + (F.lane & 31) * 33;
            float l[32];
#pragma unroll
            for (int e = 0; e < 32; ++e) l[e] = ((P[e] + P[32 * 33 + e]) + (P[2 * 32 * 33 + e] + P[3 * 32 * 33 + e])) + rb[e];
            float tv[4]; int ti[4];
#pragma unroll
            for (int k = 0; k < 4; ++k) { float best = l[0]; int bi = 0;
#pragma unroll
                for (int e = 1; e < 32; ++e) { const bool gt = l[e] > best; best = gt ? l[e] : best; bi = gt ? e : bi; }
                tv[k] = best; ti[k] = bi;
#pragma unroll
                for (int e = 0; e < 32; ++e) l[e] = (e == bi) ? -INFINITY : l[e]; }
            float ex[4], es = 0.f;
#pragma unroll
            for (int k = 0; k < 4; ++k) { ex[k] = __builtin_amdgcn_exp2f((tv[k] - tv[0]) * 1.4426950408889634f); es += ex[k]; }
            const float ies = 1.0f / es;
#pragma unroll
            for (int k = 0; k < 4; ++k) { const int lr = __hip_atomic_fetch_add((LAS int*)(F.lds + RT_LCNT) + ti[k], 1, __ATOMIC_RELAXED, __HIP_MEMORY_SCOPE_WORKGROUP);
                te[F.lane * 4 + k] = ti[k] | (lr << 5); tg[F.lane * 4 + k] = ex[k] * ies; }
        }
        __syncthreads();
        if (F.tid < 32) lbase[F.tid] = (int)__hip_atomic_fetch_add((unsigned*)(F.ctl + CW_GCNT + 64 * F.tid), (unsigned)lcnt[F.tid], RLX_AGENT);
        __syncthreads();
        if (F.tid < 256) { const int tl = F.tid >> 2, k = F.tid & 3, tok = tb * 64 + tl; const int w = te[tl * 4 + k], e = w & 31, rank = lbase[e] + (w >> 5);
            LIST[e * NTOK + rank] = tok; TOKE[tok * 4 + k] = e | (rank << 5); TOKG[tok * 4 + k] = tg[tl * 4 + k]; }
        __syncthreads();
    }
}
__device__ __forceinline__ void moe_prefix(Frame& F) {
    if (F.tid < 64) {
        const int c = (F.lane < 32) ? (int)__hip_atomic_load(F.ctl + CW_GCNT + 64 * (F.lane & 31), RLX_AGENT) : 0;
        const int t = (c + 255) >> 8; int incl = t;
#pragma unroll
        for (int o = 1; o < 32; o <<= 1) { const int y = __shfl_up(incl, o); if (F.lane >= o) incl += y; }
        if (F.lane < 32) { F.MISC[80 + F.lane] = (unsigned)c; F.MISC[32 + F.lane] = (unsigned)(incl - t); }
        if (F.lane == 31) F.MISC[64] = (unsigned)incl;
    }
    __syncthreads();
}

__device__ __forceinline__ void final_phase(Frame& F, const Args& a) {
    const int gw = F.vcu * 8 + F.wave, NGW = F.G * 8;
    const bf16_t* X1B = (const bf16_t*)(F.ws + WS_X1B); const unsigned char* Y = F.ws + WS_Y;
    const int* TOKE = (const int*)(F.ws + WS_TOKE); const float* TOKG = (const float*)(F.ws + WS_TOKG);
    const float* g2 = (const float*)a.in[20]; const float* b2 = (const float*)a.in[21];
    f32x4 gv[4], bv[4];
#pragma unroll
    for (int j = 0; j < 4; ++j) { gv[j] = *(const f32x4*)(g2 + 4 * F.lane + 256 * j); bv[j] = *(const f32x4*)(b2 + 4 * F.lane + 256 * j); }
    typedef int i32x4 __attribute__((ext_vector_type(4)));
    unsigned yn[4][4]; u32x2 xn[4]; f32x4 gn = {0.f, 0.f, 0.f, 0.f}; i32x4 inn = {0, 0, 0, 0}; f32x4 gnn = {0.f, 0.f, 0.f, 0.f};
#define FP_ROWS(tok_, iw_) do { _Pragma("unroll") for (int k = 0; k < 4; ++k) { const int w_ = (iw_)[k]; const size_t slot = (size_t)F.MISC[32 + (w_ & 31)] * 256 + (w_ >> 5); \
        _Pragma("unroll") for (int j = 0; j < 4; ++j) yn[k][j] = *(const unsigned*)(Y + slot * DM + 4 * F.lane + 256 * j); } \
        _Pragma("unroll") for (int j = 0; j < 4; ++j) xn[j] = *(const u32x2*)(X1B + (size_t)(tok_) * DM + 4 * F.lane + 256 * j); } while (0)
    if (gw < NTOK) { const i32x4 i0 = *(const i32x4*)(TOKE + (size_t)gw * 4); gn = *(const f32x4*)(TOKG + (size_t)gw * 4); FP_ROWS(gw, i0); }
    if (gw + NGW < NTOK) { inn = *(const i32x4*)(TOKE + (size_t)(gw + NGW) * 4); gnn = *(const f32x4*)(TOKG + (size_t)(gw + NGW) * 4); }
    for (int tok = gw; tok < NTOK; tok += NGW) {
        f32x4 v[4];
#pragma unroll
        for (int j = 0; j < 4; ++j) { v[j][0] = DN_ALPHA * bflo(xn[j].x); v[j][1] = DN_ALPHA * bfhi(xn[j].x); v[j][2] = DN_ALPHA * bflo(xn[j].y); v[j][3] = DN_ALPHA * bfhi(xn[j].y); }
#pragma unroll
        for (int k = 0; k < 4; ++k) { const float g = gn[k];
#pragma unroll
            for (int j = 0; j < 4; ++j) { const f32x2 ylo = __builtin_amdgcn_cvt_pk_f32_fp8((int)yn[k][j], false), yhi = __builtin_amdgcn_cvt_pk_f32_fp8((int)yn[k][j], true);
                v[j][0] += g * ylo[0]; v[j][1] += g * ylo[1]; v[j][2] += g * yhi[0]; v[j][3] += g * yhi[1]; } }
        if (tok + NGW < NTOK) { gn = gnn; FP_ROWS(tok + NGW, inn); }
        if (tok + 2 * NGW < NTOK) { inn = *(const i32x4*)(TOKE + (size_t)(tok + 2 * NGW) * 4); gnn = *(const f32x4*)(TOKG + (size_t)(tok + 2 * NGW) * 4); }
        float sum = 0.f;
#pragma unroll
        for (int j = 0; j < 4; ++j) sum += (v[j][0] + v[j][1]) + (v[j][2] + v[j][3]);
        const float mean = wave_sum(sum) * (1.f / DM); float sq = 0.f;
#pragma unroll
        for (int j = 0; j < 4; ++j) { v[j] = v[j] - mean; sq += (v[j][0] * v[j][0] + v[j][1] * v[j][1]) + (v[j][2] * v[j][2] + v[j][3] * v[j][3]); }
        const float rstd = 1.0f / sqrtf(wave_sum(sq) * (1.f / DM) + LN_EPS);
#pragma unroll
        for (int j = 0; j < 4; ++j) { f32x4 o = v[j] * rstd * gv[j] + bv[j];
            if (TS_A >= 0 && blockIdx.x == 0) { const float tus = 0.01f * (float)(F.MISC[121 + (TS_A >= 0 ? TS_A : 0)] - F.MISC[120 + (TS_A >= 0 ? TS_A : 0)]); o = o + sqrtf(256e-6f * tus); }
            if (TS_B >= 0 && blockIdx.x == 0 && tok == gw && F.wave == 0 && F.lane == 0 && j == 0) { const float tus = 0.01f * (float)(F.MISC[121 + (TS_B >= 0 ? TS_B : 0)] - F.MISC[120 + (TS_B >= 0 ? TS_B : 0)]); o[0] += 1.0f + 0.1f * tus; }
            *(f32x4*)(a.out + (size_t)tok * DM + 4 * F.lane + 256 * j) = o; }
    }
#undef FP_ROWS
}

__global__ void __launch_bounds__(512, 2) mega_fwd(Args args) {
    extern __shared__ __attribute__((aligned(16))) unsigned char lds[];
    Frame F;
    F.lds = (LAS unsigned char*)lds;
    F.MISC = (volatile LAS unsigned*)(F.lds + MISC_OFF);
    F.tid = threadIdx.x; F.lane = F.tid & 63; F.wave = __builtin_amdgcn_readfirstlane(F.tid >> 6);
    F.G = gridDim.x; { const int bx = blockIdx.x; F.vcu = (F.G % 8 == 0) ? (bx % 8) * (F.G / 8) + bx / 8 : bx; }
    { GAS unsigned char* wsg = (GAS unsigned char*)args.ws; asm volatile("" : "+s"(wsg)); F.ws = (unsigned char*)wsg; }
    F.ctl = (gu32*)(F.ws + WS_CTL);
    F.bg = false; { const int xg = F.vcu >> 5, lc = F.vcu & 31; F.conv = F.bg && lc >= 32 - NCONVX; F.wc8 = lc * 8 + xg; F.cidx = xg * NCONVX + (lc - (32 - NCONVX)); }
    for (int u = F.tid; u < 256; u += 512) F.MISC[u] = 0u;
    __syncthreads();
    XcdBarrier bar; bar.bar = (unsigned*)(F.ctl + CW_BAR); bar.x = 0; bar.st = nullptr;
    if (N_LAUNCHES != PER_PHASE) bar = xcd_barrier_post((unsigned*)(F.ctl + CW_BAR), F.MISC + 8);
#define GRID_BAR(seam) do { if (N_LAUNCHES == PER_PHASE) { if (F.tid == 0) __hip_atomic_store(F.ctl + CW_TMO, 0xBADBA0u | (unsigned)(seam), RLX_AGENT); } else { xcd_barrier(bar); } } while (0)
#define STAMP(k) do { if (TS_A >= 0 || TS_B >= 0) { if (blockIdx.x == 0 && F.tid == 0) F.MISC[120 + (k)] = (unsigned)__builtin_amdgcn_s_memrealtime(); } } while (0)
    STAMP(0);
    const int lo = args.ph_lo, hi = args.ph_hi;
#define IN(k) (lo <= (k) && (k) < hi)
#define BOTH(k) (IN(k) && IN((k) + 1))
    unsigned char* ws = F.ws;
    bf16_t* XB = (bf16_t*)(ws + WS_XB); bf16_t* Ub = (bf16_t*)(ws + WS_U); bf16_t* Qb = (bf16_t*)(ws + WS_Q); bf16_t* Kb = (bf16_t*)(ws + WS_K); bf16_t* Vb = (bf16_t*)(ws + WS_V);
    bf16_t* Sb = (bf16_t*)(ws + WS_S); bf16_t* OB = (bf16_t*)(ws + WS_OB); float* LSE = (float*)(ws + WS_LSE); bf16_t* AO = (bf16_t*)(ws + WS_AO);
    bf16_t* MIXb = (bf16_t*)(ws + WS_Z); unsigned char* X18 = ws + WS_X1F8; unsigned char* H8 = ws + WS_H; unsigned char* Yb = ws + WS_Y;

    if (IN(0)) { p0_prologue(F, args); if (BOTH(0)) GRID_BAR(0); STAMP(1); }
    if (IN(1)) {
        if (F.G == 256) {
            const int xg = F.vcu >> 5, lc = F.vcu & 31;
            if (lc >= P1_NG) convert_items<1>(F, args, P1_GT, NEXP * 2 * CV_I_E, xg * (32 - P1_NG) + (lc - P1_NG), 8 * (32 - P1_NG));
            else {
                pg8::DenseOrder S; S.init(NTOK, NPROJ, DM, 8 * P1_NG, lc * 8 + xg, ws + WS_WIN);
                pg8::EpiInProj E{Ub, Qb, Kb, Vb, (const float*)(ws + WS_ROPE)};
                pg8::gemm_phase<pg8::EpiInProj, pg8::DenseOrder, true>(F.lds, XB, DM, S, E);
                convert_items<1>(F, args, 0, P1_GT, lc * 8 + xg, 8 * P1_NG);
            }
        } else {
            pg8::DenseOrder S; S.init(NTOK, NPROJ, DM, F.G, (int)blockIdx.x, ws + WS_WIN);
            pg8::EpiInProj E{Ub, Qb, Kb, Vb, (const float*)(ws + WS_ROPE)};
            pg8::gemm_phase<pg8::EpiInProj, pg8::DenseOrder, true>(F.lds, XB, DM, S, E);
        }
        if (BOTH(1)) GRID_BAR(1); STAMP(2);
    }
    if (IN(2)) {
        const int per = F.G / 8, xcd = F.vcu / per, loc = F.vcu % per;
        if (F.bg) {
            if (!F.conv) for (int j = loc; j < 192; j += 32 - NCONVX) { const int bh = 2 * xcd + j / 96, jj = j % 96; att::attn_unit(bh >> 3, bh & 7, jj >> 5, jj & 31, Qb, Kb, Vb, OB, LSE, F.lds); }
        } else if (F.G == 256) {
            att::attn_units(loc, per, xcd, Qb, Kb, Vb, OB, LSE, F.lds);
            __syncthreads();
        } else if (F.G % 8 == 0 && per >= 1) {
            for (int j = loc; j < 192; j += per) { const int bh = 2 * xcd + j / 96, jj = j % 96; att::attn_unit(bh >> 3, bh & 7, jj >> 5, jj & 31, Qb, Kb, Vb, OB, LSE, F.lds); }
        } else {
            for (int j = F.vcu; j < 1536; j += F.G) { const int bh = j / 96, jj = j % 96; att::attn_unit(bh >> 3, bh & 7, jj >> 5, jj & 31, Qb, Kb, Vb, OB, LSE, F.lds); }
        }
        for (int it = F.vcu; it < NTOK / 64; it += F.G)
            conv_item(it, Ub, (const float*)args.in[3], (const float*)args.in[4], (const float*)args.in[5], (const float*)args.in[6], Sb, F.lds, F.wave, F.lane);
        if (F.conv) convert_items(F, args, CV_S1, CV_S2, F.cidx, NCONV);
        if (BOTH(2)) GRID_BAR(2); STAMP(3);
    }
    if (IN(3)) {
        constexpr int NPW = (NTOK / 256) * (DCONV / 256);
        const int wid_ = F.bg ? F.wc8 : (int)blockIdx.x, nw_ = F.bg ? NWORK : (int)F.G;
        if (F.conv) convert_items(F, args, CV_S2, CV_S3, F.cidx, NCONV);
        else {
            if (nw_ > NPW) { if (wid_ >= NPW) { combine_tokens(F, OB, LSE, AO, (wid_ - NPW) * 8 + F.wave, (nw_ - NPW) * 8);
                if (F.G == 256) { __syncthreads(); convert_items<2>(F, args, 0, WD_P3, wid_ - NPW, 128); } } }
            else combine_tokens(F, OB, LSE, AO, wid_ * 8 + F.wave, nw_ * 8);
            pg8::DenseOrder S; S.init(NTOK, DCONV, DCONV, nw_, wid_, ws + WS_WPW);
            pg8::EpiBiasBf16 E{AO, DM, (const float*)args.in[8]};
            pg8::gemm_phase<pg8::EpiBiasBf16, pg8::DenseOrder, true>(F.lds, Sb, DCONV, S, E);
        }
        if (BOTH(3)) GRID_BAR(3); STAMP(4);
    }
    if (IN(4)) {
        pg8::DenseOrder S; S.init(NTOK, DM, DM, F.G, (int)blockIdx.x, ws + WS_WOUT);
        pg8::EpiPlainBf16 E{MIXb, DM};
        pg8::gemm_phase<pg8::EpiPlainBf16, pg8::DenseOrder, true>(F.lds, AO, DM, S, E);
        if (BOTH(4)) GRID_BAR(4); STAMP(5);
    }
    if (IN(5)) { route_phase(F, args); if (BOTH(5)) GRID_BAR(5); STAMP(6); }
    if (IN(6)) {
        const bool dsplit = (F.G == 256);
        moe_prefix(F);
        {
            pg8::MoeOrder S{(const volatile LAS int*)(F.MISC + 32), (const volatile LAS int*)(F.MISC + 80), (const int*)(ws + WS_LIST), (const char*)(ws + WS_WGU), 8, 2048, DM / 2, F.vcu, F.G, F.lds};
            pg8::EpiSwiglu E{H8, (const float*)args.in[15], (const float*)args.in[17], (const volatile LAS int*)(F.MISC + 32), &S};
            S.plan([&](const pg8::Unit& u, int tc) { return E.bias_ptr(u, tc); }, WSCALE8);
            pg8::gemm_phase<pg8::EpiSwiglu, pg8::MoeOrder, true, true>(F.lds, X18, DM / 2, S, E);
        }
        if (dsplit) {
            const int Ltot = (int)F.MISC[64] * 8, CH = (Ltot + 7) >> 3, k = CH & 31, c = F.vcu & 31, V = 64 - k;
            const int v0 = c < k ? c : k + 2 * (c - k);
            convert_items<2>(F, args, WD_P3, NEXP * CV_I_E, (F.vcu >> 5) * V + v0, 8 * V, c < k ? 1 : 2);
        }
        if (BOTH(6)) GRID_BAR(6); STAMP(7);
    }
    if (IN(7)) {
        moe_prefix(F);
        pg8::MoeOrder S{(const volatile LAS int*)(F.MISC + 32), (const volatile LAS int*)(F.MISC + 80), nullptr, (const char*)(ws + WS_WD), 4, 1024, DFF / 2, F.vcu, F.G, F.lds};
        pg8::EpiDown E{Yb, (const float*)args.in[19], (const volatile LAS int*)(F.MISC + 32), &S};
        S.plan([&](const pg8::Unit& u, int tc) { return E.bias_ptr(u, tc); }, WSCALE8);
        pg8::gemm_phase<pg8::EpiDown, pg8::MoeOrder, true, true>(F.lds, H8, DFF / 2, S, E);
        if (BOTH(7)) GRID_BAR(7); STAMP(8);
    }
    if (IN(8)) { moe_prefix(F); final_phase(F, args); }
#undef IN
#undef BOTH
}

extern "C" void kernel_launch(void* const* d_in, const int* in_sizes, int n_in, void* d_out, int out_size, void* d_ws, size_t ws_size, hipStream_t stream) {
    static int grid = 0;
    if (grid == 0) {
        if (n_in != 22 || out_size != NTOK * DM || ws_size < WS_END) { fprintf(stderr, "kernel_launch: unexpected problem (n_in %d out %d ws %zu need %zu)\n", n_in, out_size, ws_size, (size_t)WS_END); grid = -1; return; }
        int dev = 0, cus = 0;
        if (hipGetDevice(&dev) != hipSuccess || hipDeviceGetAttribute(&cus, hipDeviceAttributeMultiprocessorCount, dev) != hipSuccess) { grid = -1; return; }
        if (hipFuncSetAttribute((const void*)mega_fwd, hipFuncAttributeMaxDynamicSharedMemorySize, LDS_BYTES) != hipSuccess) { fprintf(stderr, "kernel_launch: hipFuncSetAttribute failed\n"); grid = -1; return; }
        (void)hipGetLastError();
        grid = cus;
    }
    if (grid < 0) return;
    if (hipMemsetAsync((char*)d_ws + WS_CTL, 0, CTL_ZERO_BYTES, stream) != hipSuccess) return;
    Args a{};
    for (int i = 0; i < 22; ++i) a.in[i] = d_in[i];
    a.out = (float*)d_out; a.ws = (unsigned char*)d_ws;
    for (int li = 0; li < N_LAUNCHES; ++li) {
        a.ph_lo = (N_LAUNCHES == PER_PHASE) ? li : 0; a.ph_hi = (N_LAUNCHES == PER_PHASE) ? li + 1 : PER_PHASE; a.li = li;
        hipLaunchKernelGGL(mega_fwd, dim3(grid), dim3(512), LDS_BYTES, stream, a);
    }
}
```

```cpp
#include <hip/hip_runtime.h>
#include <cstdio>
#include <cstdint>

#define GAS __attribute__((address_space(1)))
#define LAS __attribute__((address_space(3)))
typedef unsigned short bf16_t;
typedef short bf16x8 __attribute__((ext_vector_type(8)));
typedef short s16x4 __attribute__((ext_vector_type(4)));
typedef float f32x4 __attribute__((ext_vector_type(4)));
typedef float f32x2 __attribute__((ext_vector_type(2)));
typedef float f32x16 __attribute__((ext_vector_type(16)));
typedef unsigned u32x4 __attribute__((ext_vector_type(4)));
typedef unsigned u32x2 __attribute__((ext_vector_type(2)));
typedef __bf16 bf16x2_t __attribute__((ext_vector_type(2)));

#ifndef MK_N_LAUNCHES
#define MK_N_LAUNCHES 1
#endif
#ifndef TS_A
#define TS_A -1
#endif
#ifndef TS_B
#define TS_B -1
#endif
constexpr int N_LAUNCHES = MK_N_LAUNCHES;
constexpr int PER_PHASE = 9;

constexpr int BATCH = 2, SEQ = 8192, DM = 1024, NTOK = BATCH * SEQ;
constexpr int DCONV = 512, DATT = 512, NHEAD = 8, HD = 64, NPROJ = 2560, CONVK = 31;
constexpr int NEXP = 32, TOPK = 4, DFF = 1024;
constexpr float LN_EPS = 1e-5f;
constexpr float DN_ALPHA = 1.189207115002721f;
constexpr float SWI_LIMIT = 7.0f, SWI_ALPHA = 1.702f;
constexpr float WSCALE8 = 32.0f, WINV8 = 1.0f / 32.0f;
constexpr float QSCALE = 0.125f * 1.4426950408889634f;
constexpr int MAXSLOT = NTOK * TOPK + NEXP * 256;

constexpr size_t MiB = 1u << 20;
constexpr size_t WS_CTL = 0, CTL_ZERO_BYTES = 1 * MiB;
constexpr size_t WS_TOKE = 1 * MiB;
constexpr size_t WS_TOKG = WS_TOKE + 256 * 1024;
constexpr size_t WS_LIST = 2 * MiB;
constexpr size_t WS_ROPE = 4 * MiB;
constexpr size_t WS_WIN = 8 * MiB;
constexpr size_t WS_WPW = 13 * MiB;
constexpr size_t WS_WRT = 13 * MiB + 512 * 1024;
constexpr size_t WS_WOUT = 14 * MiB;
constexpr size_t WS_WD = 16 * MiB;
constexpr size_t WS_WGU = 48 * MiB;
constexpr size_t WS_AO = 112 * MiB;
constexpr size_t WS_Z = 144 * MiB;
constexpr size_t WS_Y = 48 * MiB;
constexpr size_t WS_X1B = 208 * MiB;
constexpr size_t WS_X1F8 = 240 * MiB;
constexpr size_t WS_XB = 256 * MiB;
constexpr size_t WS_U = 288 * MiB;
constexpr size_t WS_Q = 304 * MiB, WS_K = 320 * MiB, WS_V = 336 * MiB;
constexpr size_t WS_S = 352 * MiB;
constexpr size_t WS_OB = 368 * MiB;
constexpr size_t WS_LSE = 416 * MiB;
constexpr size_t WS_H = 256 * MiB;
constexpr size_t WS_END = 418 * MiB;
static_assert(WS_Y + (size_t)MAXSLOT * DM <= WS_Z && WS_H + (size_t)MAXSLOT * DM <= WS_OB && WS_WGU + (size_t)NEXP * 2048 * DM <= WS_AO, "ws overlays");
constexpr int CW_TMO = 0, CW_CODE = 1;
constexpr int CW_GCNT = 64;
constexpr int CW_BAR = 4096;

constexpr int LDS_BYTES = 163840;
constexpr int MISC_OFF = LDS_BYTES - 1024;
constexpr int RING_BYTES = 131072;

#define RLX_AGENT __ATOMIC_RELAXED, __HIP_MEMORY_SCOPE_AGENT
#define LDS_WAIT() asm volatile("s_waitcnt lgkmcnt(0)" ::: "memory")
#define VM_WAIT() asm volatile("s_waitcnt vmcnt(0)" ::: "memory")
typedef GAS unsigned gu32;

__device__ __forceinline__ unsigned cvtpk(float lo, float hi) { f32x2 v = {lo, hi}; bf16x2_t b = __builtin_convertvector(v, bf16x2_t); return __builtin_bit_cast(unsigned, b); }
__device__ __forceinline__ unsigned pk4_fp8(float a, float b, float c, float d) { int w = 0; w = __builtin_amdgcn_cvt_pk_fp8_f32(a, b, w, false); w = __builtin_amdgcn_cvt_pk_fp8_f32(c, d, w, true); return (unsigned)w; }
__device__ __forceinline__ void st16_wt(void* p, u32x4 v) { asm volatile("global_store_dwordx4 %0, %1, off sc1\n\ts_nop 1" :: "v"(p), "v"(v) : "memory"); }
__device__ __forceinline__ float bf2f(bf16_t h) { return __uint_as_float((unsigned)h << 16); }
__device__ __forceinline__ float bflo(unsigned w) { return __uint_as_float(w << 16); }
__device__ __forceinline__ float bfhi(unsigned w) { return __uint_as_float(w & 0xffff0000u); }
__device__ __forceinline__ float wave_sum(float v) {
#pragma unroll
    for (int o = 1; o < 64; o <<= 1) v += __shfl_xor(v, o);
    return v;
}
__device__ __forceinline__ float fsigmoid(float x) { return __builtin_amdgcn_rcpf(1.0f + __builtin_amdgcn_exp2f(-1.4426950408889634f * x)); }

namespace pg8 {
constexpr int BM = 256, BK = 64, HALF = 128, HTB = HALF * BK * 2, STAGE_BYTES = 8 * HTB, NXCD = 8, WGM = 8;
__host__ __device__ __forceinline__ int lds_byte(int r, int c) { const int st = (r >> 4) * 2 + (c >> 5), rr = r & 15, cc = c & 31, ob = rr * 64 + cc * 2; return st * 1024 + (ob ^ (((ob >> 9) & 1) << 5)); }
__host__ __device__ __forceinline__ void stage_rc(int b, int& R, int& C) { const int st = b / 1024, sb = b % 1024, swz = sb ^ (((sb >> 9) & 1) << 5); R = (st >> 1) * 16 + swz / 64; C = (st & 1) * 32 + (swz % 64) / 2; }
__host__ __device__ __forceinline__ int perm32(int rho) { const int n = rho >> 4, i = rho & 15; return 8 * (i >> 2) + 4 * n + (i & 3); }

struct Unit { int pm, pn, e, idx; };

struct DenseOrder {
    int nM, nN, nwg, G, c, K; const char* Bt;
    __device__ void init(int M, int N, int K_, int G_, int c_, const void* Bt_) { nM = M / BM; nN = N / BM; nwg = nM * nN; G = G_; c = c_; K = K_; Bt = (const char*)Bt_; }
    __device__ __forceinline__ bool next(int i, Unit& u) const {
        const long L = (long)i * G + c; if (L >= nwg) return false;
        int wgid = (int)L; { const int q = nwg / NXCD, r = nwg % NXCD, xcd = wgid % NXCD, off = wgid / NXCD; wgid = (xcd < r ? xcd * (q + 1) : r * (q + 1) + (xcd - r) * q) + off; }
        const int nig = WGM * nN, gid = wgid / nig, fm = gid * WGM, gsz = (nM - fm) < WGM ? (nM - fm) : WGM;
        u.pm = fm + ((wgid % nig) % gsz); u.pn = (wgid % nig) / gsz; u.e = 0; u.idx = i; return true;
    }
    __device__ __forceinline__ const char* b_base(const Unit& u) const { return Bt + (size_t)u.pn * BM * K * 2; }
    __device__ __forceinline__ void a_off(const Unit& u, unsigned (&v)[2][2]) const {
#pragma unroll
        for (int i = 0; i < 2; ++i) { int R, C; stage_rc((int)threadIdx.x * 16 + i * 8192, R, C);
#pragma unroll
            for (int h = 0; h < 2; ++h) v[h][i] = (unsigned)((u.pm * BM + h * HALF + R) * K + C) * 2u; }
    }
};
constexpr int PLAN_OFF = 131072, PLAN_UNITS = 12, PLAN_STRIDE = 2048, PLAN_DESC = PLAN_OFF + PLAN_UNITS * PLAN_STRIDE;
struct MoeOrder {
    const volatile LAS int* tp;
    const volatile LAS int* cnt;
    const int* list;
    const char* Bt; int NT, nrowB;
    int pitch;
    int vcu, G;
    LAS unsigned char* lds;
    __device__ __forceinline__ int tpu(int j) const { return __builtin_amdgcn_readfirstlane(tp[j]); }
    template <class BiasPtr> __device__ __forceinline__ void plan(const BiasPtr& biasptr, float bscale) const {
        const int tid = threadIdx.x, lane = tid & 63, li = lane < 32 ? lane : 32;
        const int vt = tp[li], vc = cnt[lane & 31];
        auto T = [&](int j) { return __builtin_amdgcn_readlane(vt, j); };
        const int per = G >> 3, x = vcu / per, c = vcu % per;
        const int Ltot = T(32) * NT, CH = (Ltot + 7) >> 3;
        int ce_ = 0, tl_ = 0, th_ = T(1);
        auto unit_of = [&](int i, Unit& u, int& t0) {
            const int loc = i * per + c, L = x * CH + loc; const bool ok = loc < CH && L < Ltot;
            u.e = 0; u.pn = 0; u.pm = 0; u.idx = i; t0 = 0;
            if (ok) {
                while (L >= th_ * NT && ce_ < NEXP - 1) { ++ce_; tl_ = th_; th_ = T(ce_ + 1); }
                const int q = L - tl_ * NT, te = th_ - tl_;
                const int pn = (int)(((float)q + 0.5f) * __builtin_amdgcn_rcpf((float)te));
                u.e = ce_; u.pn = pn; u.pm = q - pn * te; t0 = tl_; }
            return ok; };
        int val[PLAN_UNITS];
        if (tid < 256) {
#pragma unroll
            for (int i = 0; i < PLAN_UNITS; ++i) { Unit u; int t0; const bool ok = unit_of(i, u, t0);
                if (tid == 0) { volatile LAS int* d = (volatile LAS int*)(lds + PLAN_DESC) + 4 * i; d[0] = u.e; d[1] = u.pn; d[2] = u.pm; d[3] = ok ? 1 : 0; }
                const int ce = __builtin_amdgcn_readlane(vc, u.e), r = u.pm * BM + tid;
                val[i] = list ? 0 : t0 * BM + r;
                if (list && ok && r < ce) val[i] = list[u.e * NTOK + r]; }
#pragma unroll
            for (int i = 0; i < PLAN_UNITS; ++i) ((LAS int*)(lds + PLAN_OFF + i * PLAN_STRIDE))[tid] = val[i];
        } else {
#pragma unroll
            for (int i = 0; i < PLAN_UNITS; ++i) { Unit u; int t0; const bool ok = unit_of(i, u, t0);
                val[i] = 0; if (ok) val[i] = *(const int*)biasptr(u, tid - 256); }
#pragma unroll
            for (int i = 0; i < PLAN_UNITS; ++i) ((LAS float*)(lds + PLAN_OFF + i * PLAN_STRIDE))[tid] = __builtin_bit_cast(float, val[i]) * bscale;
        }
        __syncthreads();
    }
    __device__ __forceinline__ bool next(int i, Unit& u) const {
        if (i >= PLAN_UNITS) return false;
        const volatile LAS int* d = (const volatile LAS int*)(lds + PLAN_DESC) + 4 * i;
        if (__builtin_amdgcn_readfirstlane(d[3]) == 0) return false;
        u.e = __builtin_amdgcn_readfirstlane(d[0]); u.pn = __builtin_amdgcn_readfirstlane(d[1]); u.pm = __builtin_amdgcn_readfirstlane(d[2]); u.idx = i; return true;
    }
    __device__ __forceinline__ const char* b_base(const Unit& u) const { return Bt + ((size_t)u.e * nrowB + (size_t)u.pn * BM) * pitch * 2; }
    __device__ __forceinline__ void a_off(const Unit& u, unsigned (&v)[2][2]) const {
        const LAS int* rows = (const LAS int*)(lds + PLAN_OFF + u.idx * PLAN_STRIDE);
#pragma unroll
        for (int i = 0; i < 2; ++i) { int R, C; stage_rc((int)threadIdx.x * 16 + i * 8192, R, C);
#pragma unroll
            for (int h = 0; h < 2; ++h) v[h][i] = (unsigned)(rows[h * HALF + R] * pitch + C) * 2u; }
    }
    __device__ __forceinline__ void plan_bias(const Unit& u, int wc, int fq, f32x4 (&bv)[2][2]) const {
        const LAS float* pb = (const LAS float*)(lds + PLAN_OFF + u.idx * PLAN_STRIDE + 1024);
#pragma unroll
        for (int bj = 0; bj < 2; ++bj)
#pragma unroll
            for (int n = 0; n < 2; ++n) bv[bj][n] = *(const LAS f32x4*)(pb + bj * HALF + wc * 32 + 8 * fq + 4 * n);
    }
};

template <class Epi, class Sched, bool ALIGN_EPI, bool FP8 = false>
__device__ __forceinline__ void gemm_phase(LAS unsigned char* lds, const void* Abase_, int K, const Sched& S, const Epi& E) {
    const char* Abase = (const char*)Abase_;
    const int tid = threadIdx.x, wid = __builtin_amdgcn_readfirstlane(tid >> 6), lane = tid & 63, wr = wid >> 2, wc = wid & 3, fr = lane & 15, fq = lane >> 4;
    const int nt = K / BK;
    unsigned voffB[2];
#pragma unroll
    for (int i = 0; i < 2; ++i) { int R, C; stage_rc(tid * 16 + i * 8192, R, C); const int Rb = Epi::PERM ? ((R & ~31) + perm32(R & 31)) : R; voffB[i] = (unsigned)(Rb * K + C) * 2u; }
    const size_t kstep = (size_t)(BK * 2);
    const size_t hstep = (size_t)HALF * K * 2;
    const unsigned ldsw = (unsigned)wid * 1024u;
    const int aoff = lds_byte(wr * 64 + fr, fq * 8), boff = lds_byte(wc * 32 + fr, fq * 8);
#define PG8_SA(b, h) (((b) * 2 + (h)) * HTB)
#define PG8_SB(b, h) ((4 + (b) * 2 + (h)) * HTB)
#define PG8_UPTR(p) ((const char*)(((unsigned long long)(unsigned)__builtin_amdgcn_readfirstlane((int)((unsigned long long)(p) >> 32)) << 32) | (unsigned long long)(unsigned)__builtin_amdgcn_readfirstlane((int)(unsigned)(unsigned long long)(p))))
#define PG8_STAGEB(bufoff, gbase) do { const char* gb_ = PG8_UPTR(gbase); _Pragma("unroll") for (int _i = 0; _i < 2; ++_i) \
        __builtin_amdgcn_global_load_lds((const unsigned*)(gb_ + voffB[_i]), (LAS unsigned*)(lds + (bufoff) + ldsw + _i * 8192), 16, 0, 0); } while (0)
#define PG8_STAGEA(bufoff, vo, h, kb) do { const char* ga_ = PG8_UPTR(Abase + (kb)); _Pragma("unroll") for (int _i = 0; _i < 2; ++_i) \
        __builtin_amdgcn_global_load_lds((const unsigned*)(ga_ + (vo)[h][_i]), (LAS unsigned*)(lds + (bufoff) + ldsw + _i * 8192), 16, 0, 0); } while (0)
#define PG8_STAGEA2(bufoff, h, kb) do { const char* ga_ = PG8_UPTR(Abase + (kb)); _Pragma("unroll") for (int _i = 0; _i < 2; ++_i) \
        __builtin_amdgcn_global_load_lds((const unsigned*)(ga_ + (last ? vN[h][_i] : vA[h][_i])), (LAS unsigned*)(lds + (bufoff) + ldsw + _i * 8192), 16, 0, 0); } while (0)
#define PG8_LD8(addr_) __builtin_shufflevector(*(const LAS v4i_*)(addr_), *(const LAS v4i_*)((addr_) + 1024), 0, 1, 2, 3, 4, 5, 6, 7)
#define PG8_LDA(dst, b, h) do { _Pragma("unroll") for (int m = 0; m < 4; ++m) dst[m] = PG8_LD8(lds + PG8_SA(b, h) + aoff + m * 2048); } while (0)
#define PG8_LDB(dst, b, h) do { _Pragma("unroll") for (int n = 0; n < 2; ++n) dst[n] = PG8_LD8(lds + PG8_SB(b, h) + boff + n * 2048); } while (0)
#define PG8_LO(x) __builtin_bit_cast(bf16x8, __builtin_shufflevector(x, x, 0, 1, 2, 3))
#define PG8_HI(x) __builtin_bit_cast(bf16x8, __builtin_shufflevector(x, x, 4, 5, 6, 7))
#define PG8_MMA(ai, bj, At, Bt) do { if constexpr (FP8) __builtin_amdgcn_sched_barrier(0); __builtin_amdgcn_s_setprio(1); _Pragma("unroll") for (int m = 0; m < 4; ++m) _Pragma("unroll") for (int n = 0; n < 2; ++n) { \
        if constexpr (FP8) asm volatile("v_mfma_scale_f32_16x16x128_f8f6f4 %0, %1, %2, %0, %3, %3 op_sel_hi:[0,0,0]" : "+v"(acc[ai][bj][m][n]) : "v"(Bt[n]), "v"(At[m]), "v"(sc8));   \
        else { acc[ai][bj][m][n] = __builtin_amdgcn_mfma_f32_16x16x32_bf16(PG8_LO(Bt[n]), PG8_LO(At[m]), acc[ai][bj][m][n], 0, 0, 0); \
               acc[ai][bj][m][n] = __builtin_amdgcn_mfma_f32_16x16x32_bf16(PG8_HI(Bt[n]), PG8_HI(At[m]), acc[ai][bj][m][n], 0, 0, 0); } } \
        __builtin_amdgcn_s_setprio(0); if constexpr (FP8) __builtin_amdgcn_sched_barrier(0); } while (0)
#define PG8_WAIT_V(n) asm volatile("s_waitcnt vmcnt(" #n ")" ::: "memory")
#define PG8_WAIT_L(n) asm volatile("s_waitcnt lgkmcnt(" #n ")" ::: "memory")
#define PG8_BAR __builtin_amdgcn_s_barrier()
#define PG8_SCHED __builtin_amdgcn_sched_barrier(0)
    Unit cur, nxt; int ui = 0;
    if (!S.next(0, cur)) return;
    f32x4 acc[2][2][4][2], bvn[2][2];
    E.bias(cur, wc, fq, bvn);
#pragma unroll
    for (int a = 0; a < 2; ++a)
#pragma unroll
        for (int b = 0; b < 2; ++b)
#pragma unroll
            for (int m = 0; m < 4; ++m)
#pragma unroll
                for (int n = 0; n < 2; ++n) acc[a][b][m][n] = bvn[b][n];
    typedef int v4i_ __attribute__((ext_vector_type(4))); typedef int v8i_ __attribute__((ext_vector_type(8)));
    v8i_ At[4], B0[2], B1[2];
    int sc8 = 0x7f7f7f7f; asm volatile("" : "+v"(sc8));
    unsigned vA[2][2], vN[2][2];
    S.a_off(cur, vA);
    const char* cB = S.b_base(cur);
    PG8_STAGEB(PG8_SB(0, 0), cB); PG8_STAGEB(PG8_SB(0, 1), cB + hstep); PG8_STAGEA(PG8_SA(0, 0), vA, 0, 0); PG8_STAGEA(PG8_SA(0, 1), vA, 1, 0);
    if (wr == 1) PG8_BAR;
    PG8_WAIT_V(2); PG8_BAR;
    PG8_STAGEB(PG8_SB(1, 0), cB + kstep); PG8_STAGEA(PG8_SA(1, 0), vA, 0, kstep); PG8_STAGEB(PG8_SB(1, 1), cB + hstep + kstep);
    PG8_WAIT_V(6); PG8_BAR;
    for (;;) {
        const bool has_next = S.next(ui + 1, nxt);
        const char* nB = cB;
#pragma unroll
        for (int h = 0; h < 2; ++h)
#pragma unroll
            for (int i = 0; i < 2; ++i) vN[h][i] = vA[h][i];
        if (has_next) { S.a_off(nxt, vN); nB = S.b_base(nxt); }
#pragma unroll 1
        for (int t = 0; t < nt; t += 2) {
            const bool last = (t == nt - 2);
            const size_t k1 = (size_t)(t + 1) * kstep;
            const size_t k2 = last ? 0 : (size_t)(t + 2) * kstep, k3 = k2 + kstep;
            const char* b2 = last ? nB : cB + (size_t)(t + 2) * kstep; const char* b3 = b2 + kstep;
            PG8_LDB(B0, 0, 0); PG8_LDB(B1, 0, 1); PG8_SCHED; PG8_LDA(At, 0, 0); PG8_STAGEA(PG8_SA(1, 1), vA, 1, k1);
            PG8_WAIT_V(8); PG8_WAIT_L(0); PG8_BAR; PG8_MMA(0, 0, At, B0); PG8_MMA(0, 1, At, B1); PG8_BAR; PG8_SCHED;
            PG8_LDA(At, 0, 1); PG8_STAGEB(PG8_SB(0, 0), b2); PG8_STAGEB(PG8_SB(0, 1), b2 + hstep); PG8_STAGEA2(PG8_SA(0, 0), 0, k2);
            PG8_WAIT_V(8); PG8_WAIT_L(0); PG8_BAR; PG8_MMA(1, 0, At, B0); PG8_MMA(1, 1, At, B1); PG8_BAR; PG8_SCHED;
            PG8_LDB(B0, 1, 0); PG8_LDB(B1, 1, 1); PG8_SCHED; PG8_LDA(At, 1, 0); PG8_STAGEA2(PG8_SA(0, 1), 1, k2);
            PG8_WAIT_V(8); PG8_WAIT_L(0); PG8_BAR; PG8_MMA(0, 0, At, B0); PG8_MMA(0, 1, At, B1); PG8_BAR; PG8_SCHED;
            PG8_LDA(At, 1, 1); PG8_STAGEB(PG8_SB(1, 0), b3); PG8_STAGEB(PG8_SB(1, 1), b3 + hstep); PG8_STAGEA2(PG8_SA(1, 0), 0, k3);
            PG8_WAIT_V(8); PG8_WAIT_L(0); PG8_BAR; PG8_MMA(1, 0, At, B0); PG8_MMA(1, 1, At, B1); PG8_BAR; PG8_SCHED;
        }
        if constexpr (ALIGN_EPI) { if (wr == 0) PG8_BAR; }
        if constexpr (FP8) asm volatile("s_nop 15\n\ts_nop 7" ::: "memory");
        if (has_next) E.bias(nxt, wc, fq, bvn);
        if (!Epi::AFTER_DRAIN || has_next) E(acc, cur, wr, wc, fr, fq);
        if (!has_next) break;
#pragma unroll
        for (int a = 0; a < 2; ++a)
#pragma unroll
            for (int b = 0; b < 2; ++b)
#pragma unroll
                for (int m = 0; m < 4; ++m)
#pragma unroll
                    for (int n = 0; n < 2; ++n) acc[a][b][m][n] = bvn[b][n];
        cur = nxt; cB = nB; ++ui;
#pragma unroll
        for (int h = 0; h < 2; ++h)
#pragma unroll
            for (int i = 0; i < 2; ++i) vA[h][i] = vN[h][i];
        if constexpr (ALIGN_EPI) { if (wr == 1) PG8_BAR; }
    }
    PG8_WAIT_V(0);
    if constexpr (!ALIGN_EPI) { if (wr == 0) PG8_BAR; }
    PG8_BAR;
    if constexpr (Epi::AFTER_DRAIN) E(acc, cur, wr, wc, fr, fq);
#undef PG8_SA
#undef PG8_SB
#undef PG8_STAGEA
#undef PG8_UPTR
#undef PG8_STAGEA2
#undef PG8_STAGEB
#undef PG8_LDA
#undef PG8_LD8
#undef PG8_LO
#undef PG8_HI
#undef PG8_LDB
#undef PG8_MMA
#undef PG8_WAIT_V
#undef PG8_WAIT_L
#undef PG8_BAR
#undef PG8_SCHED
}

typedef const f32x4 (&AccRef)[2][2][4][2];
__device__ __forceinline__ u32x4 pack8(f32x4 a, f32x4 b) { u32x4 w; w.x = cvtpk(a[0], a[1]); w.y = cvtpk(a[2], a[3]); w.z = cvtpk(b[0], b[1]); w.w = cvtpk(b[2], b[3]); return w; }

struct EpiInProj {
    static constexpr bool PERM = true, AFTER_DRAIN = false;
    bf16_t *U, *Q, *Kb, *V; const float* rope;
    __device__ __forceinline__ void bias(const Unit&, int, int, f32x4 (&bv)[2][2]) const { bv[0][0] = bv[0][1] = bv[1][0] = bv[1][1] = (f32x4){0.f, 0.f, 0.f, 0.f}; }
    __device__ __forceinline__ void operator()(AccRef acc, const Unit& u, int wr, int wc, int fr, int fq) const {
        const int row0 = u.pm * BM + wr * 64 + fr;
        if (u.pn < 4) {
#pragma unroll
            for (int ai = 0; ai < 2; ++ai)
#pragma unroll
                for (int m = 0; m < 4; ++m) { const int row = row0 + ai * HALF + m * 16; f32x4 o[2];
#pragma unroll
                    for (int n = 0; n < 2; ++n)
#pragma unroll
                        for (int i = 0; i < 4; ++i) o[n][i] = acc[ai][0][m][n][i] * fsigmoid(acc[ai][1][m][n][i]);
                    st16_wt(U + (size_t)row * DCONV + u.pn * 128 + wc * 32 + 8 * fq, pack8(o[0], o[1])); }
        } else if (u.pn < 8) {
            const bool isq = u.pn < 6; bf16_t* dst = isq ? Q : Kb; const float sc = isq ? QSCALE : 1.0f;
            const int head = 4 * (u.pn & 1) + wc;
#pragma unroll
            for (int ai = 0; ai < 2; ++ai) { f32x4 cs[4][2], sn[4][2];
#pragma unroll
                for (int m = 0; m < 4; ++m) { const int row = row0 + ai * HALF + m * 16;
#pragma unroll
                    for (int n = 0; n < 2; ++n) { cs[m][n] = *(const f32x4*)(rope + (size_t)row * 32 + 8 * fq + 4 * n); sn[m][n] = *(const f32x4*)(rope + (size_t)NTOK * 32 + (size_t)row * 32 + 8 * fq + 4 * n); } }
#pragma unroll
                for (int m = 0; m < 4; ++m) { const int row = row0 + ai * HALF + m * 16; f32x4 lo[2], hi[2];
#pragma unroll
                    for (int n = 0; n < 2; ++n) { const f32x4 a = acc[ai][0][m][n], b = acc[ai][1][m][n];
                        lo[n] = (a * cs[m][n] - b * sn[m][n]) * sc; hi[n] = (b * cs[m][n] + a * sn[m][n]) * sc; }
                    bf16_t* p = dst + (size_t)row * DATT + head * 64 + 8 * fq;
                    st16_wt(p, pack8(lo[0], lo[1])); st16_wt(p + 32, pack8(hi[0], hi[1])); } }
        } else {
#pragma unroll
            for (int ai = 0; ai < 2; ++ai)
#pragma unroll
                for (int m = 0; m < 4; ++m) { const int row = row0 + ai * HALF + m * 16;
#pragma unroll
                    for (int bj = 0; bj < 2; ++bj) st16_wt(V + (size_t)row * DATT + (u.pn - 8) * 256 + bj * 128 + wc * 32 + 8 * fq, pack8(acc[ai][bj][m][0], acc[ai][bj][m][1])); }
        }
    }
};
struct EpiBiasBf16 {
    static constexpr bool PERM = true, AFTER_DRAIN = false;
    bf16_t* O; int ldc; const float* bvec;
    __device__ __forceinline__ void bias(const Unit& u, int wc, int fq, f32x4 (&bv)[2][2]) const {
        const int col0 = u.pn * BM + wc * 32 + 8 * fq;
#pragma unroll
        for (int bj = 0; bj < 2; ++bj)
#pragma unroll
            for (int n = 0; n < 2; ++n) bv[bj][n] = *(const f32x4*)(bvec + col0 + bj * HALF + 4 * n);
    }
    __device__ __forceinline__ void operator()(AccRef acc, const Unit& u, int wr, int wc, int fr, int fq) const {
        const int row0 = u.pm * BM + wr * 64 + fr, col0 = u.pn * BM + wc * 32 + 8 * fq;
#pragma unroll
        for (int ai = 0; ai < 2; ++ai)
#pragma unroll
            for (int m = 0; m < 4; ++m) { bf16_t* rowp = O + (size_t)(row0 + ai * HALF + m * 16) * ldc + col0;
#pragma unroll
                for (int bj = 0; bj < 2; ++bj) st16_wt(rowp + bj * HALF, pack8(acc[ai][bj][m][0], acc[ai][bj][m][1])); }
    }
};
struct EpiPlainBf16 {
    static constexpr bool PERM = true, AFTER_DRAIN = false;
    bf16_t* O; int ldc;
    __device__ __forceinline__ void bias(const Unit&, int, int, f32x4 (&bv)[2][2]) const { bv[0][0] = bv[0][1] = bv[1][0] = bv[1][1] = (f32x4){0.f, 0.f, 0.f, 0.f}; }
    __device__ __forceinline__ void operator()(AccRef acc, const Unit& u, int wr, int wc, int fr, int fq) const {
        const int row0 = u.pm * BM + wr * 64 + fr, col0 = u.pn * BM + wc * 32 + 8 * fq;
#pragma unroll
        for (int ai = 0; ai < 2; ++ai)
#pragma unroll
            for (int m = 0; m < 4; ++m) { bf16_t* rowp = O + (size_t)(row0 + ai * HALF + m * 16) * ldc + col0;
#pragma unroll
                for (int bj = 0; bj < 2; ++bj) st16_wt(rowp + bj * HALF, pack8(acc[ai][bj][m][0], acc[ai][bj][m][1])); }
    }
};
__device__ __forceinline__ u32x4 widen16(u32x2 a, u32x2 b) {
    const auto r0 = __builtin_amdgcn_permlane16_swap(a.x, b.x, false, false); const auto r1 = __builtin_amdgcn_permlane16_swap(a.y, b.y, false, false);
    u32x4 o; o.x = r0[0]; o.y = r1[0]; o.z = r0[1]; o.w = r1[1]; return o;
}
struct EpiSwiglu {
    static constexpr bool PERM = true, AFTER_DRAIN = false;
    unsigned char* H; const float *bg, *bu; const volatile LAS int* tp;
    const MoeOrder* S;
    __device__ __forceinline__ const float* bias_ptr(const Unit& u, int tc) const { return (tc < 128 ? bg + tc : bu + (tc - 128)) + (size_t)u.e * DFF + u.pn * 128; }
    __device__ __forceinline__ void bias(const Unit& u, int wc, int fq, f32x4 (&bv)[2][2]) const { S->plan_bias(u, wc, fq, bv); }
    __device__ __forceinline__ void operator()(AccRef acc, const Unit& u, int wr, int wc, int fr, int fq) const {
        const int row0 = __builtin_amdgcn_readfirstlane(tp[u.e]) * BM + u.pm * BM + wr * 64 + fr, col0 = u.pn * 128 + wc * 32 + 8 * fq;
#pragma unroll
        for (int ai = 0; ai < 2; ++ai) { u32x2 w8[4];
#pragma unroll
            for (int m = 0; m < 4; ++m) { f32x4 o[2];
#pragma unroll
                for (int n = 0; n < 2; ++n)
#pragma unroll
                    for (int i = 0; i < 4; i += 2) { const f32x2 ua = {acc[ai][1][m][n][i], acc[ai][1][m][n][i + 1]};
                        f32x2 gm; gm.x = __builtin_amdgcn_fmed3f(acc[ai][0][m][n][i], -3.0e38f, SWI_LIMIT * WSCALE8); gm.y = __builtin_amdgcn_fmed3f(acc[ai][0][m][n][i + 1], -3.0e38f, SWI_LIMIT * WSCALE8);
                        const f32x2 ea = gm * (-SWI_ALPHA * 1.4426950408889634f * WINV8);
                        f32x2 ex; ex.x = __builtin_amdgcn_exp2f(ea.x); ex.y = __builtin_amdgcn_exp2f(ea.y);
                        const f32x2 dn = ex + 1.0f; f32x2 rc; rc.x = __builtin_amdgcn_rcpf(dn.x); rc.y = __builtin_amdgcn_rcpf(dn.y);
                        f32x2 u1 = __builtin_elementwise_fma(ua, (f32x2){WINV8 * WINV8, WINV8 * WINV8}, (f32x2){WINV8, WINV8});
                        u1.x = __builtin_amdgcn_fmed3f(u1.x, (1.0f - SWI_LIMIT) * WINV8, (1.0f + SWI_LIMIT) * WINV8); u1.y = __builtin_amdgcn_fmed3f(u1.y, (1.0f - SWI_LIMIT) * WINV8, (1.0f + SWI_LIMIT) * WINV8);
                        const f32x2 r = (u1 * gm) * rc; o[n][i] = r.x; o[n][i + 1] = r.y; }
                w8[m].x = pk4_fp8(o[0][0], o[0][1], o[0][2], o[0][3]); w8[m].y = pk4_fp8(o[1][0], o[1][1], o[1][2], o[1][3]); }
#pragma unroll
            for (int mp = 0; mp < 2; ++mp) { const u32x4 v16 = widen16(w8[2 * mp], w8[2 * mp + 1]);
                *(u32x4*)(H + (size_t)(row0 + ai * HALF + (2 * mp + (fq & 1)) * 16) * DFF + (col0 - 8 * fq + 16 * (fq >> 1))) = v16; } }
    }
};
struct EpiDown {
    static constexpr bool PERM = true, AFTER_DRAIN = false;
    unsigned char* Y; const float* bd; const volatile LAS int* tp;
    const MoeOrder* S;
    __device__ __forceinline__ const float* bias_ptr(const Unit& u, int tc) const { return bd + (size_t)u.e * DM + u.pn * BM + tc; }
    __device__ __forceinline__ void bias(const Unit& u, int wc, int fq, f32x4 (&bv)[2][2]) const { S->plan_bias(u, wc, fq, bv); }
    __device__ __forceinline__ void operator()(AccRef acc, const Unit& u, int wr, int wc, int fr, int fq) const {
        const int row0 = __builtin_amdgcn_readfirstlane(tp[u.e]) * BM + u.pm * BM + wr * 64 + fr, col0 = u.pn * BM + wc * 32 + 8 * fq;
#pragma unroll
        for (int ai = 0; ai < 2; ++ai)
#pragma unroll
            for (int mp = 0; mp < 2; ++mp)
#pragma unroll
                for (int bj = 0; bj < 2; ++bj) { u32x2 w8[2];
#pragma unroll
                    for (int q = 0; q < 2; ++q) { const f32x4 y0 = acc[ai][bj][2 * mp + q][0] * WINV8, y1 = acc[ai][bj][2 * mp + q][1] * WINV8; w8[q].x = pk4_fp8(y0[0], y0[1], y0[2], y0[3]); w8[q].y = pk4_fp8(y1[0], y1[1], y1[2], y1[3]); }
                    *(u32x4*)(Y + (size_t)(row0 + ai * HALF + (2 * mp + (fq & 1)) * 16) * DM + (col0 - 8 * fq + 16 * (fq >> 1)) + bj * HALF) = widen16(w8[0], w8[1]); }
    }
};
}

#define XB_TMO      128
#define XB_XCNT(j)  (256  + 64 * (j))
#define XB_XSUB(j)  (1280 + 64 * (j))
#define XB_XGEN(j)  (2304 + 64 * (j))
#define XB_TOP      3328
#define XB_TOPGEN   3392
#define XCD_BAR_WORDS 3456
#define XB_SPIN_CAP (1u << 18)
__device__ __forceinline__ unsigned xb_ld(unsigned* p)              { return __hip_atomic_load(p, __ATOMIC_RELAXED, __HIP_MEMORY_SCOPE_AGENT); }
__device__ __forceinline__ unsigned xb_add(unsigned* p, unsigned v) { return __hip_atomic_fetch_add(p, v, __ATOMIC_RELAXED, __HIP_MEMORY_SCOPE_AGENT); }
__device__ __forceinline__ unsigned xb_xcc_id() { return (unsigned)__builtin_amdgcn_s_getreg((3 << 11) | 20) & 0xFu; }
#define XB_SPIN(cond, bar) do { unsigned _sp = 0; while (cond) { __builtin_amdgcn_s_sleep(1); \
    if ((++_sp & 255u) == 0u) { if (xb_ld(&(bar)[XB_TMO])) break; if (_sp > XB_SPIN_CAP) { atomicAdd(&(bar)[XB_TMO], 1u); break; } } } } while (0)
struct XcdBarrier { unsigned* bar; unsigned x; volatile LAS unsigned* st; };
__device__ __forceinline__ XcdBarrier xcd_barrier_post(unsigned* bar, volatile LAS unsigned* st) {
    XcdBarrier b; b.bar = bar; b.x = xb_xcc_id(); b.st = st;
    if (threadIdx.x == 0) (void)xb_add(&bar[XB_XCNT(b.x)], 1u);
    return b;
}
__device__ __forceinline__ void xcd_barrier_complete(unsigned* bar, unsigned x, unsigned& nloc, unsigned& nx) {
    const unsigned G = gridDim.x * gridDim.y * gridDim.z;
    unsigned sum, cnt, mine, sp = 0u;
    for (;;) {
        sum = 0u; cnt = 0u; mine = 0u;
#pragma unroll
        for (unsigned j = 0; j < 16; ++j) { const unsigned c = xb_ld(&bar[XB_XCNT(j)]); sum += c; cnt += (c > 0u) ? 1u : 0u; mine = (j == x) ? c : mine; }
        if (sum == G) break;
        __builtin_amdgcn_s_sleep(1);
        if ((++sp & 255u) == 0u) { if (xb_ld(&bar[XB_TMO])) break; if (sp > XB_SPIN_CAP) { atomicAdd(&bar[XB_TMO], 1u); break; } }
    }
    nloc = mine > 0u ? mine : 1u; nx = cnt > 0u ? cnt : 1u;
}
__device__ __forceinline__ void xcd_barrier(const XcdBarrier& b) {
    asm volatile("s_waitcnt vmcnt(0)" ::: "memory");
    __syncthreads();
    if (threadIdx.x == 0) {
        unsigned* bar = b.bar;
        __builtin_amdgcn_s_waitcnt(0);
        unsigned nloc = b.st[0], nx = b.st[1];
        if (nloc == 0u) { xcd_barrier_complete(bar, b.x, nloc, nx); b.st[0] = nloc; b.st[1] = nx; }
        const unsigned old = xb_add(&bar[XB_XSUB(b.x)], 1u);
        const unsigned gen = old / nloc;
        if (old + 1u == (gen + 1u) * nloc) {
            __builtin_amdgcn_fence(__ATOMIC_RELEASE, "agent");
            asm volatile("s_waitcnt vmcnt(0)" ::: "memory");
            const unsigned og = xb_add(&bar[XB_TOP], 1u);
            const unsigned tg = og / nx;
            if (og + 1u == (tg + 1u) * nx) xb_add(&bar[XB_TOPGEN], 1u);
            else XB_SPIN(xb_ld(&bar[XB_TOPGEN]) == tg, bar);
            __builtin_amdgcn_fence(__ATOMIC_ACQUIRE, "agent");
            xb_add(&bar[XB_XGEN(b.x)], 1u);
            asm volatile("s_waitcnt vmcnt(0)" ::: "memory");
        } else {
            XB_SPIN(xb_ld(&bar[XB_XGEN(b.x)]) == gen, bar);
            __builtin_amdgcn_fence(__ATOMIC_ACQUIRE, "agent");
            asm volatile("s_waitcnt vmcnt(0)" ::: "memory");
        }
    }
    __syncthreads();
}

struct Args { const void* in[22]; float* out; unsigned char* ws; int ph_lo, ph_hi, li, pad; };
struct Frame {
    LAS unsigned char* lds; volatile LAS unsigned* MISC; gu32* ctl;
    int tid, lane, wave, vcu, G;
    bool bg, conv; int wc8, cidx;
    unsigned char* ws;
};

template <class RowMap>
__device__ __forceinline__ void tr_item(const float* W, int N, int K, bf16_t* WT, const RowMap& rm, LAS float* scr, int k0, int n0, int lane) {
    const int n4 = lane & 15, kr = lane >> 4;
    f32x4 v[16];
#pragma unroll
    for (int i = 0; i < 16; ++i) v[i] = *(const GAS f32x4*)(W + (size_t)(k0 + kr + 4 * i) * N + n0 + 4 * n4);
#pragma unroll
    for (int i = 0; i < 16; ++i) { LAS float* p = scr + (kr + 4 * i) * 65 + 4 * n4; p[0] = v[i][0]; p[1] = v[i][1]; p[2] = v[i][2]; p[3] = v[i][3]; }
    LDS_WAIT(); asm volatile("" ::: "memory");
    const int c = (lane & 3) + 4 * (lane >> 5), nn = (lane >> 2) & 7;
#pragma unroll
    for (int it = 0; it < 8; ++it) { const int n = nn + 8 * it; const LAS float* s = scr + (8 * c) * 65 + n;
        u32x4 o; o.x = cvtpk(s[0], s[65]); o.y = cvtpk(s[2 * 65], s[3 * 65]); o.z = cvtpk(s[4 * 65], s[5 * 65]); o.w = cvtpk(s[6 * 65], s[7 * 65]);
        *(GAS u32x4*)(WT + (size_t)rm(n0 + n) * K + k0 + 8 * c) = o; }
    LDS_WAIT(); asm volatile("" ::: "memory");
}
template <class RowMap>
__device__ __forceinline__ void tr_item8(const float* W, int N, int K, unsigned char* WT, const RowMap& rm, LAS float* scr, int k0, int n0, int lane, float scale) {
    const int n4 = lane & 15, kr = lane >> 4;
    f32x4 v[16];
#pragma unroll
    for (int i = 0; i < 16; ++i) v[i] = *(const GAS f32x4*)(W + (size_t)(k0 + kr + 4 * i) * N + n0 + 4 * n4);
#pragma unroll
    for (int i = 0; i < 16; ++i) { LAS float* p = scr + (kr + 4 * i) * 65 + 4 * n4; p[0] = v[i][0] * scale; p[1] = v[i][1] * scale; p[2] = v[i][2] * scale; p[3] = v[i][3] * scale; }
    LDS_WAIT(); asm volatile("" ::: "memory");
    const int c = (lane & 1) + 2 * (lane >> 5), nn = (lane >> 1) & 15;
#pragma unroll
    for (int it = 0; it < 4; ++it) { const int n = nn + 16 * it; const LAS float* s = scr + (16 * c) * 65 + n;
        u32x4 o; o.x = pk4_fp8(s[0], s[65], s[2 * 65], s[3 * 65]); o.y = pk4_fp8(s[4 * 65], s[5 * 65], s[6 * 65], s[7 * 65]);
        o.z = pk4_fp8(s[8 * 65], s[9 * 65], s[10 * 65], s[11 * 65]); o.w = pk4_fp8(s[12 * 65], s[13 * 65], s[14 * 65], s[15 * 65]);
        *(GAS u32x4*)(WT + (size_t)rm(n0 + n) * K + k0 + 16 * c) = o; }
    LDS_WAIT(); asm volatile("" ::: "memory");
}
struct MapIdent { int off; __device__ __forceinline__ int operator()(int n) const { return off + n; } };
struct MapGateUp { int off; __device__ __forceinline__ int operator()(int n) const { return off + 256 * (n >> 7) + (n & 127); } };
struct MapInProj { __device__ __forceinline__ int operator()(int n) const {
    if (n < 512) return 256 * (n >> 7) + (n & 127);
    if (n < 1024) { const int c = n - 512; return 256 * (c >> 7) + 128 + (c & 127); }
    if (n < 2048) { const int c = (n - 1024) & 511, h = c >> 6, d = c & 63; return 256 * ((n < 1536 ? 4 : 6) + (h >> 2)) + 128 * (d >> 5) + (h & 3) * 32 + (d & 31); }
    return n; } };

__device__ __forceinline__ void sincos_d(double a, float& c, float& s) {
    const double TWO_PI = 6.283185307179586476925286766559, INV = 0.15915494309189533576888376337251;
    const double n = __builtin_rint(a * INV); double r = __builtin_fma(-n, TWO_PI, a); r = __builtin_fma(-n, 2.4492935982947064e-16, r) ;
    const double r2 = r * r; double sp = 0.0, cp = 0.0;
#pragma unroll
    for (int k = 13; k >= 1; --k) { sp = (sp + 1.0) * (r2 * (-1.0 / (double)((2 * k) * (2 * k + 1)))); cp = (cp + 1.0) * (r2 * (-1.0 / (double)((2 * k - 1) * (2 * k)))); }
    s = (float)(r * (1.0 + sp)); c = (float)(1.0 + cp);
}

constexpr int CV_I_IN = 16 * 40, CV_I_PW = 8 * 8, CV_I_OUT = 16 * 16, CV_I_E = 16 * 16;
constexpr int CV_NEXP = NEXP * 3 * CV_I_E, CV_NITEMS = CV_NEXP + CV_I_IN + CV_I_PW + CV_I_OUT;
constexpr int NCONVX = 4, NCONV = 8 * NCONVX, NWORK = 256 - NCONV;
#ifndef WD_P3_
#define WD_P3_ 2048
#endif
constexpr int WD_P3 = WD_P3_;
#ifndef P1_GT_
#define P1_GT_ 1280
#endif
constexpr int P1_GT = P1_GT_;
constexpr int P1_NG = 20;
#ifndef CV_NTAIL_
#define CV_NTAIL_ 6144
#endif
constexpr int CV_NTAIL = CV_NTAIL_;
#ifndef CV_S1_
#define CV_S1_ 5600
#define CV_S2_ 9400
#define CV_S3_ 11300
#endif
constexpr int CV_S1 = CV_S1_, CV_S2 = CV_S2_, CV_S3 = CV_S3_;
struct CvItem { const float* W; unsigned char* dst; int N, K, k0, n0, mode; };
__device__ __forceinline__ CvItem cv_decode(const Args& a, unsigned char* ws, int r) {
    CvItem c;
    if (r < CV_NEXP) {
        const int e = r / (3 * CV_I_E), q = r % (3 * CV_I_E), which = q / CV_I_E, t = q % CV_I_E; c.k0 = 64 * (t / 16); c.n0 = 64 * (t % 16); c.mode = which; c.N = DM; c.K = DM;
        if (which == 0) { c.W = (const float*)a.in[14] + (size_t)e * DM * DFF; c.dst = ws + WS_WGU + (size_t)e * 2048 * DM; }
        else if (which == 1) { c.W = (const float*)a.in[16] + (size_t)e * DM * DFF; c.dst = ws + WS_WGU + (size_t)e * 2048 * DM; }
        else { c.W = (const float*)a.in[18] + (size_t)e * DFF * DM; c.dst = ws + WS_WD + (size_t)e * DM * DFF; }
        return c; }
    r -= CV_NEXP;
    if (r < CV_I_IN) { c.W = (const float*)a.in[2]; c.dst = ws + WS_WIN; c.N = NPROJ; c.K = DM; c.k0 = 64 * (r / 40); c.n0 = 64 * (r % 40); c.mode = 3; return c; } r -= CV_I_IN;
    if (r < CV_I_PW) { c.W = (const float*)a.in[7]; c.dst = ws + WS_WPW; c.N = DCONV; c.K = DCONV; c.k0 = 64 * (r / 8); c.n0 = 64 * (r % 8); c.mode = 4; return c; } r -= CV_I_PW;
    c.W = (const float*)a.in[9]; c.dst = ws + WS_WOUT; c.N = DM; c.K = DM; c.k0 = 64 * (r / 16); c.n0 = 64 * (r % 16); c.mode = 5; return c;
}
__device__ __forceinline__ void cv_load(const CvItem& c, int lane, f32x4 (&v)[16]) {
    const int n4 = lane & 15, kr = lane >> 4;
#pragma unroll
    for (int i = 0; i < 16; ++i) v[i] = *(const GAS f32x4*)(c.W + (size_t)(c.k0 + kr + 4 * i) * c.N + c.n0 + 4 * n4);
}
__device__ __forceinline__ int cv_row(int mode, int n) {
    if (mode == 0) return 256 * (n >> 7) + (n & 127);
    if (mode == 1) return 128 + 256 * (n >> 7) + (n & 127);
    if (mode == 3) return MapInProj{}(n);
    return n;
}
template <int REMAP>
__device__ __forceinline__ int cv_remap(int j) { return REMAP == 1 ? (j >> 9) * 768 + (j & 511) : REMAP == 2 ? (j >> 8) * 768 + 512 + (j & 255) : j; }
template <int REMAP = 0>
__device__ __forceinline__ void convert_items(Frame& F, const Args& a, int first, int last, int wg, int NWG, int grp = 1) {
    const int lane = F.lane, p = F.wave & 3; const bool loader = F.wave < 4;
    const int stride = NWG * 4, base = first + wg * 4 + p;
    const int span = last - first - wg * 4; int nsteps = span <= 0 ? 0 : (span + stride - 1) / stride;
    if (grp == 2) { const int span1 = span - 4; nsteps += span1 <= 0 ? 0 : (span1 + stride - 1) / stride; }
    if (nsteps == 0) return;
#define CV_TILE(s_) (grp == 2 ? base + ((s_) >> 1) * stride + ((s_) & 1) * 4 : base + (s_) * stride)
    LAS float* slot0 = (LAS float*)(F.lds + (p * 2 + 0) * 16640); LAS float* slot1 = (LAS float*)(F.lds + (p * 2 + 1) * 16640);
    const int n4 = lane & 15, kr = lane >> 4;
    f32x4 vA[16], vB[16], vC[16]; CvItem cA, cB, cC; cA = cv_decode(a, F.ws, cv_remap<REMAP>(base < last ? base : first)); cB = cA; cC = cA; const int t1_ = CV_TILE(1), t2_ = CV_TILE(2);
    if (loader) { if (base < last) cv_load(cA, lane, vA); if (t1_ < last) { cB = cv_decode(a, F.ws, cv_remap<REMAP>(t1_)); cv_load(cB, lane, vB); }
                  if (t2_ < last) { cC = cv_decode(a, F.ws, cv_remap<REMAP>(t2_)); cv_load(cC, lane, vC); } }
#define CV_LOADER_STEP(vX, cX, slotX, s_) do { const int it_ = CV_TILE(s_), it3_ = CV_TILE((s_) + 3); if (it_ < last) { const float sc = cX.mode < 3 ? WSCALE8 : 1.0f; \
        _Pragma("unroll") for (int i = 0; i < 16; ++i) { LAS float* q_ = slotX + (kr + 4 * i) * 65 + 4 * n4; q_[0] = vX[i][0] * sc; q_[1] = vX[i][1] * sc; q_[2] = vX[i][2] * sc; q_[3] = vX[i][3] * sc; } \
        LDS_WAIT(); if (it3_ < last) { cX = cv_decode(a, F.ws, cv_remap<REMAP>(it3_)); cv_load(cX, lane, vX); } } } while (0)
#define CV_STORER_STEP(slotX, s_) do { const int it_ = CV_TILE(s_); if (it_ < last) { const CvItem cur = cv_decode(a, F.ws, cv_remap<REMAP>(it_)); \
        if (cur.mode < 3) { const int c = (lane & 1) + 2 * (lane >> 5), nn = (lane >> 1) & 15; \
            _Pragma("unroll") for (int q = 0; q < 4; ++q) { const int n = nn + 16 * q; const LAS float* s2 = slotX + (16 * c) * 65 + n; \
                u32x4 o; o.x = pk4_fp8(s2[0], s2[65], s2[2 * 65], s2[3 * 65]); o.y = pk4_fp8(s2[4 * 65], s2[5 * 65], s2[6 * 65], s2[7 * 65]); \
                o.z = pk4_fp8(s2[8 * 65], s2[9 * 65], s2[10 * 65], s2[11 * 65]); o.w = pk4_fp8(s2[12 * 65], s2[13 * 65], s2[14 * 65], s2[15 * 65]); \
                *(GAS u32x4*)(cur.dst + (size_t)cv_row(cur.mode, cur.n0 + n) * cur.K + cur.k0 + 16 * c) = o; } \
        } else { const int c = (lane & 3) + 4 * (lane >> 5), nn = (lane >> 2) & 7; \
            _Pragma("unroll") for (int q = 0; q < 8; ++q) { const int n = nn + 8 * q; const LAS float* s2 = slotX + (8 * c) * 65 + n; \
                u32x4 o; o.x = cvtpk(s2[0], s2[65]); o.y = cvtpk(s2[2 * 65], s2[3 * 65]); o.z = cvtpk(s2[4 * 65], s2[5 * 65]); o.w = cvtpk(s2[6 * 65], s2[7 * 65]); \
                *(GAS u32x4*)((bf16_t*)cur.dst + (size_t)cv_row(cur.mode, cur.n0 + n) * cur.K + cur.k0 + 8 * c) = o; } } \
        LDS_WAIT(); } } while (0)
#define CV_BAR() do { asm volatile("s_waitcnt lgkmcnt(0)" ::: "memory"); __builtin_amdgcn_s_barrier(); asm volatile("" ::: "memory"); } while (0)
    if (loader) {
        for (int s_ = 0; s_ < nsteps; s_ += 6) {
            CV_LOADER_STEP(vA, cA, slot0, s_); CV_BAR();
            if (s_ + 1 < nsteps) { CV_LOADER_STEP(vB, cB, slot1, s_ + 1); CV_BAR(); }
            if (s_ + 2 < nsteps) { CV_LOADER_STEP(vC, cC, slot0, s_ + 2); CV_BAR(); }
            if (s_ + 3 < nsteps) { CV_LOADER_STEP(vA, cA, slot1, s_ + 3); CV_BAR(); }
            if (s_ + 4 < nsteps) { CV_LOADER_STEP(vB, cB, slot0, s_ + 4); CV_BAR(); }
            if (s_ + 5 < nsteps) { CV_LOADER_STEP(vC, cC, slot1, s_ + 5); CV_BAR(); }
        }
    } else {
        for (int s_ = 0; s_ < nsteps; s_ += 2) {
            CV_BAR(); CV_STORER_STEP(slot0, s_);
            if (s_ + 1 < nsteps) { CV_BAR(); CV_STORER_STEP(slot1, s_ + 1); }
        }
    }
    CV_BAR();
#undef CV_LOADER_STEP
#undef CV_TILE
#undef CV_STORER_STEP
#undef CV_BAR
}
__device__ __forceinline__ void p0_prologue(Frame& F, const Args& a) {
    const int gw = F.vcu * 8 + F.wave, NGW = F.G * 8;
    const float* x = (const float*)a.in[0]; bf16_t* XB = (bf16_t*)(F.ws + WS_XB);
    const int* pos = (const int*)a.in[1]; float* rope = (float*)(F.ws + WS_ROPE);
    for (int m0 = gw; m0 < NTOK; m0 += 8 * NGW) {
        f32x4 v[8][4];
#pragma unroll
        for (int k = 0; k < 8; ++k) { const int m = m0 + k * NGW; if (m < NTOK) {
#pragma unroll
            for (int j = 0; j < 4; ++j) v[k][j] = ((const GAS f32x4*)(x + (size_t)m * DM) + F.lane)[64 * j]; } }
        if (m0 == gw) {
            const int i = F.tid & 31;
            double inv_freq = 1.0;
            for (int q = 0; q < i; ++q) inv_freq *= 0.7498942093324558;
            for (int idx = (F.vcu * 512 + F.tid); idx < NTOK * 32; idx += F.G * 512) {
                float c, s_; sincos_d((double)pos[idx >> 5] * inv_freq, c, s_);
                rope[idx] = c; rope[NTOK * 32 + idx] = s_;
            }
            const float* rw = (const float*)a.in[12]; bf16_t* WrT = (bf16_t*)(F.ws + WS_WRT);
            for (int idx = F.vcu * 512 + F.tid; idx < NEXP * DM; idx += F.G * 512) { const int e = idx >> 10, k = idx & 1023; const float wv = rw[k * NEXP + e]; const unsigned hb = cvtpk(wv, 0.f) & 0xffffu;
                WrT[idx] = (bf16_t)hb; WrT[NEXP * DM + idx] = (bf16_t)(cvtpk(wv - bf2f((bf16_t)hb), 0.f) & 0xffffu); }
        }
#pragma unroll
        for (int k = 0; k < 8; ++k) { const int m = m0 + k * NGW; if (m < NTOK) { GAS u32x2* o = (GAS u32x2*)(XB + (size_t)m * DM) + F.lane;
#pragma unroll
            for (int j = 0; j < 4; ++j) { u32x2 w; w.x = cvtpk(v[k][j][0], v[k][j][1]); w.y = cvtpk(v[k][j][2], v[k][j][3]); o[64 * j] = w; } } }
    }
    convert_items(F, a, F.G == 256 ? CV_NEXP : 0, CV_NITEMS, F.vcu, F.G);
}

namespace att {
constexpr int L_K = 0, L_V = 49152, L_WS = 98304, L_OST = L_WS + 8 * 256, L_END = L_OST + 8 * 4096;
__device__ __forceinline__ int crow(int r, int hi) { return (r & 3) + 8 * (r >> 2) + 4 * hi; }
__device__ __forceinline__ s16x4 vtr(const LAS char* p) { typedef short v4i16_t __attribute__((ext_vector_type(4))); return __builtin_bit_cast(s16x4, __builtin_amdgcn_ds_read_tr16_b64_v4i16((LAS v4i16_t*)p)); }
__device__ __forceinline__ void attn_unit(int b, int h, int br, int blk, const bf16_t* Q, const bf16_t* K, const bf16_t* V, bf16_t* OB, float* LSE, LAS unsigned char* lds) {
    const int tid = threadIdx.x, lane = tid & 63, r32 = lane & 31, hi = lane >> 5; const int wid = __builtin_amdgcn_readfirstlane(tid >> 6);
    const int d = 1 << (2 * br), per = 32 >> (2 * br), res = blk / per, i0 = 256 * (blk % per), kbase = i0 - 128;
    const int rowbase = b * SEQ + res;
#pragma unroll
    for (int T = 0; T < 6; ++T) {
        int sp = kbase + 64 * T + lane; sp = sp < 0 ? 0 : sp;
        const bf16_t* ks = K + (size_t)(rowbase + d * sp) * DATT + h * 64 + wid * 8;
        __builtin_amdgcn_global_load_lds((const unsigned*)ks, (LAS unsigned*)(lds + L_K + T * 8192 + wid * 1024), 16, 0, 0);
        int sv = kbase + 64 * T + 16 * (wid & 3) + (lane >> 2); sv = sv < 0 ? 0 : sv;
        const bf16_t* vs = V + (size_t)(rowbase + d * sv) * DATT + h * 64 + (wid >> 2) * 32 + (lane & 3) * 8;
        __builtin_amdgcn_global_load_lds((const unsigned*)vs, (LAS unsigned*)(lds + L_V + T * 8192 + wid * 1024), 16, 0, 0);
    }
    const int qsub = i0 + 32 * wid;
    const size_t qtok = (size_t)(rowbase + d * (qsub + r32));
    bf16x8 qr[4];
#pragma unroll
    for (int d0 = 0; d0 < 4; ++d0) qr[d0] = *(const bf16x8*)(Q + qtok * DATT + h * 64 + d0 * 16 + hi * 8);
    asm volatile("s_waitcnt vmcnt(0)" ::: "memory");
    __syncthreads();
    const int jmin = (i0 == 0) ? ((4 - wid) > 0 ? (4 - wid) : 0) : 0;
    f32x16 s[5];
    const float NEG = -INFINITY;
#pragma unroll
    for (int j = 0; j < 5; ++j) {
        if (j >= jmin) {
            const int tt = wid + j, T = tt >> 1, sub = tt & 1;
            const LAS unsigned char* kb = lds + L_K + T * 8192 + hi * 1024 + (32 * sub + r32) * 16;
            f32x16 acc = {};
#pragma unroll
            for (int d0 = 0; d0 < 4; ++d0) { const bf16x8 kf = *(const LAS bf16x8*)(kb + d0 * 2048); acc = __builtin_amdgcn_mfma_f32_32x32x16_bf16(kf, qr[d0], acc, 0, 0, 0); }
            if (j == 0) {
#pragma unroll
                for (int r = 0; r < 16; ++r) if (crow(r, hi) < r32) acc[r] = NEG;
            }
            if (j == 4) {
#pragma unroll
                for (int r = 0; r < 16; ++r) if (crow(r, hi) > r32) acc[r] = NEG;
            }
            s[j] = acc;
        } else {
#pragma unroll
            for (int r = 0; r < 16; ++r) s[j][r] = NEG;
        }
    }
    float m = NEG;
#pragma unroll
    for (int j = 0; j < 5; ++j)
#pragma unroll
        for (int r = 0; r < 16; ++r) m = fmaxf(m, s[j][r]);
    m = fmaxf(m, __shfl_xor(m, 32));
    float l = 0.f;
#pragma unroll
    for (int j = 0; j < 5; ++j)
#pragma unroll
        for (int r = 0; r < 16; ++r) { const float p = __builtin_amdgcn_exp2f(s[j][r] - m); s[j][r] = p; l += p; }
    l += __shfl_xor(l, 32);
    f32x16 o[2]; o[0] = f32x16{}; o[1] = f32x16{};
#pragma unroll
    for (int j = 0; j < 5; ++j) {
        if (j >= jmin) {
            const int tt = wid + j, T = tt >> 1, sub = tt & 1;
            const LAS char* vb = (const LAS char*)lds + L_V + T * 8192 + ((lane >> 4) & 1) * 32 + (lane & 3) * 8 + (32 * sub + 4 * hi + ((lane & 15) >> 2)) * 64;
#pragma unroll
            for (int ks = 0; ks < 2; ++ks) {
                u32x4 pw; pw.x = cvtpk(s[j][8 * ks + 0], s[j][8 * ks + 1]); pw.y = cvtpk(s[j][8 * ks + 2], s[j][8 * ks + 3]); pw.z = cvtpk(s[j][8 * ks + 4], s[j][8 * ks + 5]); pw.w = cvtpk(s[j][8 * ks + 6], s[j][8 * ks + 7]);
                const bf16x8 pa = __builtin_bit_cast(bf16x8, pw);
#pragma unroll
                for (int dh = 0; dh < 2; ++dh) {
                    const s16x4 lo = vtr(vb + dh * 4096 + ks * 1024), hi4 = vtr(vb + dh * 4096 + ks * 1024 + 512);
                    const bf16x8 vf = (bf16x8){lo[0], lo[1], lo[2], lo[3], hi4[0], hi4[1], hi4[2], hi4[3]};
                    o[dh] = __builtin_amdgcn_mfma_f32_32x32x16_bf16(pa, vf, o[dh], 0, 0, 0);
                }
            }
        }
    }
    LAS float* wsf = (LAS float*)(lds + L_WS) + wid * 64;
    if (hi == 0) wsf[r32] = __builtin_amdgcn_rcpf(l);
    LDS_WAIT(); asm volatile("" ::: "memory");
    LAS bf16_t* stg = (LAS bf16_t*)(lds + L_OST) + wid * 2048;
#pragma unroll
    for (int r = 0; r < 16; ++r) { const int orow = crow(r, hi); const float rl = wsf[orow];
#pragma unroll
        for (int dh = 0; dh < 2; ++dh) stg[orow * 64 + dh * 32 + r32] = (bf16_t)(cvtpk(o[dh][r] * rl, 0.f) & 0xffffu); }
    LDS_WAIT(); asm volatile("" ::: "memory");
    bf16_t* Ob = OB + (size_t)br * NTOK * DATT;
#pragma unroll
    for (int i = 0; i < 4; ++i) { const int row = i * 8 + (lane >> 3), ch = lane & 7; const u32x4 v = *(const LAS u32x4*)(stg + row * 64 + ch * 8);
        st16_wt(Ob + (size_t)(rowbase + d * (qsub + row)) * DATT + h * 64 + ch * 8, v); }
    if (hi == 0) LSE[((size_t)br * NTOK + qtok) * 8 + h] = m + __builtin_amdgcn_logf(l);
    __syncthreads();
}
struct UnitGeo { int rowbase, d, i0, h, br; };
__device__ __forceinline__ UnitGeo unit_geo(int j_in_xcd, int xcd) {
    const int bh = 2 * xcd + j_in_xcd / 96, jj = j_in_xcd % 96, br = jj >> 5, blk = jj & 31;
    UnitGeo g; g.br = br; g.h = bh & 7; g.d = 1 << (2 * br); const int per = 32 >> (2 * br); g.rowbase = (bh >> 3) * SEQ + blk / per; g.i0 = 256 * (blk % per); return g;
}
__device__ __forceinline__ void glds16(const void* gsrc, unsigned lds_dst) { unsigned keep;
    asm volatile("s_mov_b32 %0, m0\n\ts_mov_b32 m0, %2\n\ts_nop 0\n\tglobal_load_lds_dwordx4 %1, off\n\ts_mov_b32 m0, %0" : "=&s"(keep) : "v"(gsrc), "s"(lds_dst) : "memory"); }
__device__ __forceinline__ void dma_k(const UnitGeo& g, const bf16_t* K, unsigned ldsb, int wid, int lane) {
#pragma unroll
    for (int T = 0; T < 6; ++T) { int sp = g.i0 - 128 + 64 * T + lane; sp = sp < 0 ? 0 : sp;
        glds16(K + (size_t)(g.rowbase + g.d * sp) * DATT + g.h * 64 + wid * 8, (unsigned)__builtin_amdgcn_readfirstlane((int)(ldsb + L_K + T * 8192 + wid * 1024))); }
}
__device__ __forceinline__ void dma_v(const UnitGeo& g, const bf16_t* V, unsigned ldsb, int wid, int lane) {
#pragma unroll
    for (int T = 0; T < 6; ++T) { int sv = g.i0 - 128 + 64 * T + 16 * (wid & 3) + (lane >> 2); sv = sv < 0 ? 0 : sv;
        glds16(V + (size_t)(g.rowbase + g.d * sv) * DATT + g.h * 64 + (wid >> 2) * 32 + (lane & 3) * 8, (unsigned)__builtin_amdgcn_readfirstlane((int)(ldsb + L_V + T * 8192 + wid * 1024))); }
}
__device__ __forceinline__ void load_q(const UnitGeo& g, const bf16_t* Q, int wid, int r32, int hi, bf16x8 (&qr)[4]) {
    const bf16_t* qp = Q + (size_t)(g.rowbase + g.d * (g.i0 + 32 * wid + r32)) * DATT + g.h * 64 + hi * 8;
#pragma unroll
    for (int d0 = 0; d0 < 4; ++d0) asm volatile("global_load_dwordx4 %0, %1, off offset:%c2" : "=v"(qr[d0]) : "v"(qp), "i"(d0 * 32) : "memory");
}
__device__ __forceinline__ void attn_units(int j0, int jstep, int xcd, const bf16_t* Q, const bf16_t* K, const bf16_t* V, bf16_t* OB, float* LSE, LAS unsigned char* lds) {
    const int tid = threadIdx.x, lane = tid & 63, r32 = lane & 31, hi = lane >> 5; const int wid = __builtin_amdgcn_readfirstlane(tid >> 6);
    const unsigned ldsb = (unsigned)(size_t)lds;
    if (j0 >= 192) return;
    UnitGeo g = unit_geo(j0, xcd);
    bf16x8 qr[4];
    asm volatile("s_waitcnt vmcnt(0) lgkmcnt(0)" ::: "memory");
    dma_k(g, K, ldsb, wid, lane); load_q(g, Q, wid, r32, hi, qr);
    for (int j = j0; j < 192; j += jstep) {
        const int d = g.d, i0 = g.i0, h = g.h, br = g.br, rowbase = g.rowbase;
        dma_v(g, V, ldsb, wid, lane);
        asm volatile("s_waitcnt vmcnt(6)" : "+v"(qr[0]), "+v"(qr[1]), "+v"(qr[2]), "+v"(qr[3]) :: "memory");
        __builtin_amdgcn_s_barrier(); asm volatile("" ::: "memory");
        const int qsub = i0 + 32 * wid; const size_t qtok = (size_t)(rowbase + d * (qsub + r32));
        const int jmin = (i0 == 0) ? ((4 - wid) > 0 ? (4 - wid) : 0) : 0;
        f32x16 s[5]; const float NEG = -INFINITY;
#pragma unroll
        for (int t5 = 0; t5 < 5; ++t5) {
            const int tt = wid + t5, T = tt >> 1, sub = tt & 1;
            const LAS unsigned char* kb = lds + L_K + T * 8192 + hi * 1024 + (32 * sub + r32) * 16;
            bf16x8 kf[4];
#pragma unroll
            for (int d0 = 0; d0 < 4; ++d0) kf[d0] = *(const LAS bf16x8*)(kb + d0 * 2048);
            const float tbias = (t5 >= jmin) ? 0.f : NEG;
            f32x16 acc;
#pragma unroll
            for (int r = 0; r < 16; ++r) acc[r] = tbias;
#pragma unroll
            for (int d0 = 0; d0 < 4; ++d0) acc = __builtin_amdgcn_mfma_f32_32x32x16_bf16(kf[d0], qr[d0], acc, 0, 0, 0);
            if (t5 == 0) {
#pragma unroll
                for (int r = 0; r < 16; ++r) acc[r] = (crow(r, hi) < r32) ? NEG : acc[r];
            }
            if (t5 == 4) {
#pragma unroll
                for (int r = 0; r < 16; ++r) acc[r] = (crow(r, hi) > r32) ? NEG : acc[r];
            }
            s[t5] = acc;
        }
        float m = NEG;
#pragma unroll
        for (int t5 = 0; t5 < 5; ++t5)
#pragma unroll
            for (int r = 0; r < 16; ++r) m = fmaxf(m, s[t5][r]);
        m = fmaxf(m, __shfl_xor(m, 32));
        float l = 0.f;
#pragma unroll
        for (int t5 = 0; t5 < 5; ++t5)
#pragma unroll
            for (int r = 0; r < 16; ++r) { const float p = __builtin_amdgcn_exp2f(s[t5][r] - m); s[t5][r] = p; l += p; }
        l += __shfl_xor(l, 32);
        asm volatile("s_waitcnt vmcnt(0) lgkmcnt(0)" ::: "memory");
        __builtin_amdgcn_s_barrier(); asm volatile("" ::: "memory");
        const bool more = (j + jstep) < 192;
        UnitGeo gn = g;
        if (more) { gn = unit_geo(j + jstep, xcd); dma_k(gn, K, ldsb, wid, lane); load_q(gn, Q, wid, r32, hi, qr); }
        f32x16 o[2]; o[0] = f32x16{}; o[1] = f32x16{};
#pragma unroll
        for (int t5 = 0; t5 < 5; ++t5) {
            const int tt = wid + t5, T = tt >> 1, sub = tt & 1;
            const LAS char* vb = (const LAS char*)lds + L_V + T * 8192 + ((lane >> 4) & 1) * 32 + (lane & 3) * 8 + (32 * sub + 4 * hi + ((lane & 15) >> 2)) * 64;
            s16x4 lo[2][2], hi4[2][2];
#pragma unroll
            for (int ks = 0; ks < 2; ++ks)
#pragma unroll
                for (int dh = 0; dh < 2; ++dh) { lo[ks][dh] = vtr(vb + dh * 4096 + ks * 1024); hi4[ks][dh] = vtr(vb + dh * 4096 + ks * 1024 + 512); }
#pragma unroll
            for (int ks = 0; ks < 2; ++ks) {
                u32x4 pw; pw.x = cvtpk(s[t5][8 * ks + 0], s[t5][8 * ks + 1]); pw.y = cvtpk(s[t5][8 * ks + 2], s[t5][8 * ks + 3]); pw.z = cvtpk(s[t5][8 * ks + 4], s[t5][8 * ks + 5]); pw.w = cvtpk(s[t5][8 * ks + 6], s[t5][8 * ks + 7]);
                const bf16x8 pa = __builtin_bit_cast(bf16x8, pw);
#pragma unroll
                for (int dh = 0; dh < 2; ++dh) {
                    const bf16x8 vf = (bf16x8){lo[ks][dh][0], lo[ks][dh][1], lo[ks][dh][2], lo[ks][dh][3], hi4[ks][dh][0], hi4[ks][dh][1], hi4[ks][dh][2], hi4[ks][dh][3]};
                    o[dh] = __builtin_amdgcn_mfma_f32_32x32x16_bf16(pa, vf, o[dh], 0, 0, 0);
                }
            }
        }
        LAS float* wsf = (LAS float*)(lds + L_WS) + wid * 64;
        if (hi == 0) wsf[r32] = __builtin_amdgcn_rcpf(l);
        LDS_WAIT(); asm volatile("" ::: "memory");
        LAS bf16_t* stg = (LAS bf16_t*)(lds + L_OST) + wid * 2048;
#pragma unroll
        for (int r = 0; r < 16; ++r) { const int orow = crow(r, hi); const float rl = wsf[orow];
#pragma unroll
            for (int dh = 0; dh < 2; ++dh) stg[orow * 64 + dh * 32 + r32] = (bf16_t)(cvtpk(o[dh][r] * rl, 0.f) & 0xffffu); }
        LDS_WAIT(); asm volatile("" ::: "memory");
        bf16_t* Ob = OB + (size_t)br * NTOK * DATT;
#pragma unroll
        for (int i = 0; i < 4; ++i) { const int row = i * 8 + (lane >> 3), ch = lane & 7; const u32x4 v = *(const LAS u32x4*)(stg + row * 64 + ch * 8);
            st16_wt(Ob + (size_t)(rowbase + d * (qsub + row)) * DATT + h * 64 + ch * 8, v); }
        if (hi == 0) LSE[((size_t)br * NTOK + qtok) * 8 + h] = m + __builtin_amdgcn_logf(l);
        asm volatile("s_waitcnt lgkmcnt(0)" ::: "memory");
        __builtin_amdgcn_s_barrier(); asm volatile("" ::: "memory");
        g = gn;
    }
    asm volatile("s_waitcnt vmcnt(0)" ::: "memory");
}
}

__device__ __forceinline__ void conv_item(int item, const bf16_t* U, const float* cw, const float* cb, const float* lng, const float* lnb, bf16_t* S, LAS unsigned char* lds, int wave, int lane) {
    const int c = threadIdx.x, t0 = item * 64;
    LAS bf16_t* UT = (LAS bf16_t*)lds;
    LAS float* CT = (LAS float*)(lds + 32768);
    float w[31], x[62];
#pragma unroll
    for (int j = 0; j < 31; ++j) w[j] = cw[j * DCONV + c];
    const float bias = cb[c];
    const bool hist = (t0 % SEQ) != 0;
    const f32x4 g0 = *(const f32x4*)(lng + 8 * lane), g1 = *(const f32x4*)(lng + 8 * lane + 4), b0 = *(const f32x4*)(lnb + 8 * lane), b1 = *(const f32x4*)(lnb + 8 * lane + 4);
    u32x4 pre[4];
#define CV_ISSUE(tb) do { const int tb_ = (tb) < 0 ? 0 : (tb); _Pragma("unroll") for (int q = 0; q < 4; ++q) { const int idx = c + 512 * q; pre[q] = *(const u32x4*)(U + (size_t)(tb_ + (idx >> 6)) * DCONV + (idx & 63) * 8); } } while (0)
#define CV_WRITE() do { _Pragma("unroll") for (int q = 0; q < 4; ++q) { const int idx = c + 512 * q; *(LAS u32x4*)(UT + (idx >> 6) * DCONV + (idx & 63) * 8) = pre[q]; } } while (0)
    CV_ISSUE(t0 - 32);
    CV_WRITE();
    CV_ISSUE(t0);
    __syncthreads();
#pragma unroll
    for (int j = 0; j < 30; ++j) { const float v = bf2f(UT[(2 + j) * DCONV + c]); x[j] = hist ? v : 0.f; }
    for (int ch = 0; ch < 2; ++ch) {
        __syncthreads();
        CV_WRITE();
        if (ch == 0) CV_ISSUE(t0 + 32);
        __syncthreads();
#pragma unroll
        for (int j = 0; j < 32; ++j) x[30 + j] = bf2f(UT[j * DCONV + c]);
#pragma unroll
        for (int tt = 0; tt < 32; ++tt) { float y = bias;
#pragma unroll
            for (int j = 0; j < 31; ++j) y = __builtin_fmaf(w[j], x[tt + j], y);
            CT[tt * DCONV + c] = y; }
#pragma unroll
        for (int j = 0; j < 30; ++j) x[j] = x[32 + j];
        __syncthreads();
#pragma unroll
        for (int q = 0; q < 4; ++q) { const int tt = wave + 8 * q;
            const f32x4 v0 = *(const LAS f32x4*)(CT + tt * DCONV + 8 * lane), v1 = *(const LAS f32x4*)(CT + tt * DCONV + 8 * lane + 4);
            const float mean = wave_sum((v0[0] + v0[1]) + (v0[2] + v0[3]) + (v1[0] + v1[1]) + (v1[2] + v1[3])) * (1.f / DCONV);
            const f32x4 d0 = v0 - mean, d1 = v1 - mean;
            const float var = wave_sum((d0[0] * d0[0] + d0[1] * d0[1]) + (d0[2] * d0[2] + d0[3] * d0[3]) + (d1[0] * d1[0] + d1[1] * d1[1]) + (d1[2] * d1[2] + d1[3] * d1[3])) * (1.f / DCONV);
            const float rstd = 1.0f / sqrtf(var + LN_EPS);
            f32x4 y0 = d0 * rstd * g0 + b0, y1 = d1 * rstd * g1 + b1;
#pragma unroll
            for (int i = 0; i < 4; ++i) { y0[i] = y0[i] * fsigmoid(y0[i]); y1[i] = y1[i] * fsigmoid(y1[i]); }
            st16_wt(S + (size_t)(t0 + 32 * ch + tt) * DCONV + 8 * lane, pg8::pack8(y0, y1)); }
    }
    __syncthreads();
#undef CV_ISSUE
#undef CV_WRITE
}

__device__ __forceinline__ void combine_tokens(Frame& F, const bf16_t* OB, const float* LSE, bf16_t* AO, int gw, int NGW) {
    const int h = F.lane >> 3;
    for (int tok0 = gw * 4; tok0 < NTOK; tok0 += NGW * 4) {
        float ls[4][3]; u32x4 v[4][3];
#pragma unroll
        for (int t = 0; t < 4; ++t)
#pragma unroll
            for (int br = 0; br < 3; ++br) { ls[t][br] = LSE[((size_t)br * NTOK + tok0 + t) * 8 + h]; v[t][br] = *(const u32x4*)(OB + ((size_t)br * NTOK + tok0 + t) * DATT + 8 * F.lane); }
#pragma unroll
        for (int t = 0; t < 4; ++t) {
            const float mx = fmaxf(ls[t][0], fmaxf(ls[t][1], ls[t][2]));
            float wt[3]; float sum = 0.f;
#pragma unroll
            for (int br = 0; br < 3; ++br) { wt[br] = __builtin_amdgcn_exp2f(ls[t][br] - mx); sum += wt[br]; }
            const float rs = 1.0f / sum;
            f32x4 a0 = {0.f, 0.f, 0.f, 0.f}, a1 = {0.f, 0.f, 0.f, 0.f};
#pragma unroll
            for (int br = 0; br < 3; ++br) { const float wv = wt[br] * rs; const u32x4 q = v[t][br];
                a0[0] += wv * bflo(q.x); a0[1] += wv * bfhi(q.x); a0[2] += wv * bflo(q.y); a0[3] += wv * bfhi(q.y);
                a1[0] += wv * bflo(q.z); a1[1] += wv * bfhi(q.z); a1[2] += wv * bflo(q.w); a1[3] += wv * bfhi(q.w); }
            st16_wt(AO + (size_t)(tok0 + t) * DM + DCONV + 8 * F.lane, pg8::pack8(a0, a1));
        }
    }
}

constexpr int RT_X = 0, RT_XP = 2064;
constexpr int RT_LCNT = 147456, RT_BASE = RT_LCNT + 128, RT_TE = RT_BASE + 128, RT_TG = RT_TE + 1024, RT_END = RT_TG + 1024;
static_assert(64 * RT_XP <= RT_LCNT && 8 * 32 * 33 * 4 <= 64 * RT_XP, "route LDS map");
__device__ __forceinline__ void route_phase(Frame& F, const Args& a) {
    volatile LAS int* lcnt = (volatile LAS int*)(F.lds + RT_LCNT); volatile LAS int* lbase = (volatile LAS int*)(F.lds + RT_BASE);
    volatile LAS int* te = (volatile LAS int*)(F.lds + RT_TE); volatile LAS float* tg = (volatile LAS float*)(F.lds + RT_TG);
    const float* rb = (const float*)a.in[13]; const float* g1 = (const float*)a.in[10]; const float* b1 = (const float*)a.in[11];
    const bf16_t* MIXb = (const bf16_t*)(F.ws + WS_Z); const float* Xin = (const float*)a.in[0]; bf16_t* X1B = (bf16_t*)(F.ws + WS_X1B); unsigned char* X18 = F.ws + WS_X1F8;
    const bf16_t* WrT = (const bf16_t*)(F.ws + WS_WRT);
    int* TOKE = (int*)(F.ws + WS_TOKE); float* TOKG = (float*)(F.ws + WS_TOKG); int* LIST = (int*)(F.ws + WS_LIST);
    const int r32 = F.lane & 31, hi = F.lane >> 5;
    f32x4 gv[4], bv[4];
#pragma unroll
    for (int j = 0; j < 4; ++j) { gv[j] = *(const f32x4*)(g1 + 4 * F.lane + 256 * j); bv[j] = *(const f32x4*)(b1 + 4 * F.lane + 256 * j); }
    for (int tb = F.vcu; tb < NTOK / 64; tb += F.G) {
        if (F.tid < 32) lcnt[F.tid] = 0;
        for (int it = 0; it < 8; ++it) {
            const int tl = F.wave * 8 + it, tok = tb * 64 + tl;
            f32x4 xv[4]; float sum = 0.f;
#pragma unroll
            for (int j = 0; j < 4; ++j) { const u32x2 mx = *(const u32x2*)(MIXb + (size_t)tok * DM + 4 * F.lane + 256 * j);
                xv[j] = *(const f32x4*)(Xin + (size_t)tok * DM + 4 * F.lane + 256 * j) * DN_ALPHA + (f32x4){bflo(mx.x), bfhi(mx.x), bflo(mx.y), bfhi(mx.y)}; sum += (xv[j][0] + xv[j][1]) + (xv[j][2] + xv[j][3]); }
            const float mean = wave_sum(sum) * (1.f / DM); float sq = 0.f;
#pragma unroll
            for (int j = 0; j < 4; ++j) { xv[j] = xv[j] - mean; sq += (xv[j][0] * xv[j][0] + xv[j][1] * xv[j][1]) + (xv[j][2] * xv[j][2] + xv[j][3] * xv[j][3]); }
            const float rstd = 1.0f / sqrtf(wave_sum(sq) * (1.f / DM) + LN_EPS);
#pragma unroll
            for (int j = 0; j < 4; ++j) { xv[j] = xv[j] * rstd * gv[j] + bv[j];
                u32x2 w; w.x = cvtpk(xv[j][0], xv[j][1]); w.y = cvtpk(xv[j][2], xv[j][3]); *(u32x2*)(X1B + (size_t)tok * DM + 4 * F.lane + 256 * j) = w;
                *(LAS u32x2*)(F.lds + RT_X + tl * RT_XP + (4 * F.lane + 256 * j) * 2) = w;
                *(unsigned*)(X18 + (size_t)tok * DM + 4 * F.lane + 256 * j) = pk4_fp8(xv[j][0], xv[j][1], xv[j][2], xv[j][3]); }
        }
        __syncthreads();
        const int mb = F.wave & 1, kq = F.wave >> 1;
        f32x16 acc = {};
        {
            bf16x8 bfr[16], bfl[16];
#pragma unroll
            for (int s_ = 0; s_ < 16; ++s_) { bfr[s_] = *(const bf16x8*)(WrT + (size_t)r32 * DM + 16 * (kq * 16 + s_) + 8 * hi); bfl[s_] = *(const bf16x8*)(WrT + (size_t)NEXP * DM + (size_t)r32 * DM + 16 * (kq * 16 + s_) + 8 * hi); }
#pragma unroll
            for (int s_ = 0; s_ < 16; ++s_) { const bf16x8 af = *(const LAS bf16x8*)(F.lds + RT_X + (32 * mb + r32) * RT_XP + (16 * (kq * 16 + s_) + 8 * hi) * 2);
                acc = __builtin_amdgcn_mfma_f32_32x32x16_bf16(af, bfr[s_], acc, 0, 0, 0); acc = __builtin_amdgcn_mfma_f32_32x32x16_bf16(af, bfl[s_], acc, 0, 0, 0); }
        }
        __syncthreads();
        {
            LAS float* P = (LAS float*)(F.lds + RT_X) + (size_t)(mb * 4 + kq) * 32 * 33;
#pragma unroll
            for (int r = 0; r < 16; ++r) P[((r & 3) + 8 * (r >> 2) + 4 * hi) * 33 + r32] = acc[r];
        }
        __syncthreads();
        if (F.wave == 0) {
            const LAS float* P = (const LAS float*)(F.lds + RT_X) + (size_t)((F.lane >> 5) * 4) * 32 * 33 + (F.lane & 31) * 33;
            float l[32];
#pragma unroll
            for (int e = 0; e < 32; ++e) l[e] = ((P[e] + P[32 * 33 + e]) + (P[2 * 32 * 33 + e] + P[3 * 32 * 33 + e])) + rb[e];
            float tv[4]; int ti[4];
#pragma unroll
            for (int k = 0; k < 4; ++k) { float best = l[0]; int bi = 0;
#pragma unroll
                for (int e = 1; e < 32; ++e) { const bool gt = l[e] > best; best = gt ? l[e] : best; bi = gt ? e : bi; }
                tv[k] = best; ti[k] = bi;
#pragma unroll
                for (int e = 0; e < 32; ++e) l[e] = (e == bi) ? -INFINITY : l[e]; }
            float ex[4], es = 0.f;
#pragma unroll
            for (int k = 0; k < 4; ++k) { ex[k] = __builtin_amdgcn_exp2f((tv[k] - tv[0]) * 1.4426950408889634f); es += ex[k]; }
            const float ies = 1.0f / es;
#pragma unroll
            for (int k = 0; k < 4; ++k) { const int lr = __hip_atomic_fetch_add((LAS int*)(F.lds + RT_LCNT) + ti[k], 1, __ATOMIC_RELAXED, __HIP_MEMORY_SCOPE_WORKGROUP);
                te[F.lane * 4 + k] = ti[k] | (lr << 5); tg[F.lane * 4 + k] = ex[k] * ies; }
        }
        __syncthreads();
        if (F.tid < 32) lbase[F.tid] = (int)__hip_atomic_fetch_add((unsigned*)(F.ctl + CW_GCNT + 64 * F.tid), (unsigned)lcnt[F.tid], RLX_AGENT);
        __syncthreads();
        if (F.tid < 256) { const int tl = F.tid >> 2, k = F.tid & 3, tok = tb * 64 + tl; const int w = te[tl * 4 + k], e = w & 31, rank = lbase[e] + (w >> 5);
            LIST[e * NTOK + rank] = tok; TOKE[tok * 4 + k] = e | (rank << 5); TOKG[tok * 4 + k] = tg[tl * 4 + k]; }
        __syncthreads();
    }
}
__device__ __forceinline__ void moe_prefix(Frame& F) {
    if (F.tid < 64) {
        const int c = (F.lane < 32) ? (int)__hip_atomic_load(F.ctl + CW_GCNT + 64 * (F.lane & 31), RLX_AGENT) : 0;
        const int t = (c + 255) >> 8; int incl = t;
#pragma unroll
        for (int o = 1; o < 32; o <<= 1) { const int y = __shfl_up(incl, o); if (F.lane >= o) incl += y; }
        if (F.lane < 32) { F.MISC[80 + F.lane] = (unsigned)c; F.MISC[32 + F.lane] = (unsigned)(incl - t); }
        if (F.lane == 31) F.MISC[64] = (unsigned)incl;
    }
    __syncthreads();
}

__device__ __forceinline__ void final_phase(Frame& F, const Args& a) {
    const int gw = F.vcu * 8 + F.wave, NGW = F.G * 8;
    const bf16_t* X1B = (const bf16_t*)(F.ws + WS_X1B); const unsigned char* Y = F.ws + WS_Y;
    const int* TOKE = (const int*)(F.ws + WS_TOKE); const float* TOKG = (const float*)(F.ws + WS_TOKG);
    const float* g2 = (const float*)a.in[20]; const float* b2 = (const float*)a.in[21];
    f32x4 gv[4], bv[4];
#pragma unroll
    for (int j = 0; j < 4; ++j) { gv[j] = *(const f32x4*)(g2 + 4 * F.lane + 256 * j); bv[j] = *(const f32x4*)(b2 + 4 * F.lane + 256 * j); }
    typedef int i32x4 __attribute__((ext_vector_type(4)));
    unsigned yn[4][4]; u32x2 xn[4]; f32x4 gn = {0.f, 0.f, 0.f, 0.f}; i32x4 inn = {0, 0, 0, 0}; f32x4 gnn = {0.f, 0.f, 0.f, 0.f};
#define FP_ROWS(tok_, iw_) do { _Pragma("unroll") for (int k = 0; k < 4; ++k) { const int w_ = (iw_)[k]; const size_t slot = (size_t)F.MISC[32 + (w_ & 31)] * 256 + (w_ >> 5); \
        _Pragma("unroll") for (int j = 0; j < 4; ++j) yn[k][j] = *(const unsigned*)(Y + slot * DM + 4 * F.lane + 256 * j); } \
        _Pragma("unroll") for (int j = 0; j < 4; ++j) xn[j] = *(const u32x2*)(X1B + (size_t)(tok_) * DM + 4 * F.lane + 256 * j); } while (0)
    if (gw < NTOK) { const i32x4 i0 = *(const i32x4*)(TOKE + (size_t)gw * 4); gn = *(const f32x4*)(TOKG + (size_t)gw * 4); FP_ROWS(gw, i0); }
    if (gw + NGW < NTOK) { inn = *(const i32x4*)(TOKE + (size_t)(gw + NGW) * 4); gnn = *(const f32x4*)(TOKG + (size_t)(gw + NGW) * 4); }
    for (int tok = gw; tok < NTOK; tok += NGW) {
        f32x4 v[4];
#pragma unroll
        for (int j = 0; j < 4; ++j) { v[j][0] = DN_ALPHA * bflo(xn[j].x); v[j][1] = DN_ALPHA * bfhi(xn[j].x); v[j][2] = DN_ALPHA * bflo(xn[j].y); v[j][3] = DN_ALPHA * bfhi(xn[j].y); }
#pragma unroll
        for (int k = 0; k < 4; ++k) { const float g = gn[k];
#pragma unroll
            for (int j = 0; j < 4; ++j) { const f32x2 ylo = __builtin_amdgcn_cvt_pk_f32_fp8((int)yn[k][j], false), yhi = __builtin_amdgcn_cvt_pk_f32_fp8((int)yn[k][j], true);
                v[j][0] += g * ylo[0]; v[j][1] += g * ylo[1]; v[j][2] += g * yhi[0]; v[j][3] += g * yhi[1]; } }
        if (tok + NGW < NTOK) { gn = gnn; FP_ROWS(tok + NGW, inn); }
        if (tok + 2 * NGW < NTOK) { inn = *(const i32x4*)(TOKE + (size_t)(tok + 2 * NGW) * 4); gnn = *(const f32x4*)(TOKG + (size_t)(tok + 2 * NGW) * 4); }
        float sum = 0.f;
#pragma unroll
        for (int j = 0; j < 4; ++j) sum += (v[j][0] + v[j][1]) + (v[j][2] + v[j][3]);
        const float mean = wave_sum(sum) * (1.f / DM); float sq = 0.f;
#pragma unroll
        for (int j = 0; j < 4; ++j) { v[j] = v[j] - mean; sq += (v[j][0] * v[j][0] + v[j][1] * v[j][1]) + (v[j][2] * v[j][2] + v[j][3] * v[j][3]); }
        const float rstd = 1.0f / sqrtf(wave_sum(sq) * (1.f / DM) + LN_EPS);
#pragma unroll
        for (int j = 0; j < 4; ++j) { f32x4 o = v[j] * rstd * gv[j] + bv[j];
            if (TS_A >= 0 && blockIdx.x == 0) { const float tus = 0.01f * (float)(F.MISC[121 + (TS_A >= 0 ? TS_A : 0)] - F.MISC[120 + (TS_A >= 0 ? TS_A : 0)]); o = o + sqrtf(256e-6f * tus); }
            if (TS_B >= 0 && blockIdx.x == 0 && tok == gw && F.wave == 0 && F.lane == 0 && j == 0) { const float tus = 0.01f * (float)(F.MISC[121 + (TS_B >= 0 ? TS_B : 0)] - F.MISC[120 + (TS_B >= 0 ? TS_B : 0)]); o[0] += 1.0f + 0.1f * tus; }
            *(f32x4*)(a.out + (size_t)tok * DM + 4 * F.lane + 256 * j) = o; }
    }
#undef FP_ROWS
}

__global__ void __launch_bounds__(512, 2) mega_fwd(Args args) {
    extern __shared__ __attribute__((aligned(16))) unsigned char lds[];
    Frame F;
    F.lds = (LAS unsigned char*)lds;
    F.MISC = (volatile LAS unsigned*)(F.lds + MISC_OFF);
    F.tid = threadIdx.x; F.lane = F.tid & 63; F.wave = __builtin_amdgcn_readfirstlane(F.tid >> 6);
    F.G = gridDim.x; { const int bx = blockIdx.x; F.vcu = (F.G % 8 == 0) ? (bx % 8) * (F.G / 8) + bx / 8 : bx; }
    { GAS unsigned char* wsg = (GAS unsigned char*)args.ws; asm volatile("" : "+s"(wsg)); F.ws = (unsigned char*)wsg; }
    F.ctl = (gu32*)(F.ws + WS_CTL);
    F.bg = false; { const int xg = F.vcu >> 5, lc = F.vcu & 31; F.conv = F.bg && lc >= 32 - NCONVX; F.wc8 = lc * 8 + xg; F.cidx = xg * NCONVX + (lc - (32 - NCONVX)); }
    for (int u = F.tid; u < 256; u += 512) F.MISC[u] = 0u;
    __syncthreads();
    XcdBarrier bar; bar.bar = (unsigned*)(F.ctl + CW_BAR); bar.x = 0; bar.st = nullptr;
    if (N_LAUNCHES != PER_PHASE) bar = xcd_barrier_post((unsigned*)(F.ctl + CW_BAR), F.MISC + 8);
#define GRID_BAR(seam) do { if (N_LAUNCHES == PER_PHASE) { if (F.tid == 0) __hip_atomic_store(F.ctl + CW_TMO, 0xBADBA0u | (unsigned)(seam), RLX_AGENT); } else { xcd_barrier(bar); } } while (0)
#define STAMP(k) do { if (TS_A >= 0 || TS_B >= 0) { if (blockIdx.x == 0 && F.tid == 0) F.MISC[120 + (k)] = (unsigned)__builtin_amdgcn_s_memrealtime(); } } while (0)
    STAMP(0);
    const int lo = args.ph_lo, hi = args.ph_hi;
#define IN(k) (lo <= (k) && (k) < hi)
#define BOTH(k) (IN(k) && IN((k) + 1))
    unsigned char* ws = F.ws;
    bf16_t* XB = (bf16_t*)(ws + WS_XB); bf16_t* Ub = (bf16_t*)(ws + WS_U); bf16_t* Qb = (bf16_t*)(ws + WS_Q); bf16_t* Kb = (bf16_t*)(ws + WS_K); bf16_t* Vb = (bf16_t*)(ws + WS_V);
    bf16_t* Sb = (bf16_t*)(ws + WS_S); bf16_t* OB = (bf16_t*)(ws + WS_OB); float* LSE = (float*)(ws + WS_LSE); bf16_t* AO = (bf16_t*)(ws + WS_AO);
    bf16_t* MIXb = (bf16_t*)(ws + WS_Z); unsigned char* X18 = ws + WS_X1F8; unsigned char* H8 = ws + WS_H; unsigned char* Yb = ws + WS_Y;

    if (IN(0)) { p0_prologue(F, args); if (BOTH(0)) GRID_BAR(0); STAMP(1); }
    if (IN(1)) {
        if (F.G == 256) {
            const int xg = F.vcu >> 5, lc = F.vcu & 31;
            if (lc >= P1_NG) convert_items<1>(F, args, P1_GT, NEXP * 2 * CV_I_E, xg * (32 - P1_NG) + (lc - P1_NG), 8 * (32 - P1_NG));
            else {
                pg8::DenseOrder S; S.init(NTOK, NPROJ, DM, 8 * P1_NG, lc * 8 + xg, ws + WS_WIN);
                pg8::EpiInProj E{Ub, Qb, Kb, Vb, (const float*)(ws + WS_ROPE)};
                pg8::gemm_phase<pg8::EpiInProj, pg8::DenseOrder, true>(F.lds, XB, DM, S, E);
                convert_items<1>(F, args, 0, P1_GT, lc * 8 + xg, 8 * P1_NG);
            }
        } else {
            pg8::DenseOrder S; S.init(NTOK, NPROJ, DM, F.G, (int)blockIdx.x, ws + WS_WIN);
            pg8::EpiInProj E{Ub, Qb, Kb, Vb, (const float*)(ws + WS_ROPE)};
            pg8::gemm_phase<pg8::EpiInProj, pg8::DenseOrder, true>(F.lds, XB, DM, S, E);
        }
        if (BOTH(1)) GRID_BAR(1); STAMP(2);
    }
    if (IN(2)) {
        const int per = F.G / 8, xcd = F.vcu / per, loc = F.vcu % per;
        if (F.bg) {
            if (!F.conv) for (int j = loc; j < 192; j += 32 - NCONVX) { const int bh = 2 * xcd + j / 96, jj = j % 96; att::attn_unit(bh >> 3, bh & 7, jj >> 5, jj & 31, Qb, Kb, Vb, OB, LSE, F.lds); }
        } else if (F.G == 256) {
            att::attn_units(loc, per, xcd, Qb, Kb, Vb, OB, LSE, F.lds);
            __syncthreads();
        } else if (F.G % 8 == 0 && per >= 1) {
            for (int j = loc; j < 192; j += per) { const int bh = 2 * xcd + j / 96, jj = j % 96; att::attn_unit(bh >> 3, bh & 7, jj >> 5, jj & 31, Qb, Kb, Vb, OB, LSE, F.lds); }
        } else {
            for (int j = F.vcu; j < 1536; j += F.G) { const int bh = j / 96, jj = j % 96; att::attn_unit(bh >> 3, bh & 7, jj >> 5, jj & 31, Qb, Kb, Vb, OB, LSE, F.lds); }
        }
        for (int it = F.vcu; it < NTOK / 64; it += F.G)
            conv_item(it, Ub, (const float*)args.in[3], (const float*)args.in[4], (const float*)args.in[5], (const float*)args.in[6], Sb, F.lds, F.wave, F.lane);
        if (F.conv) convert_items(F, args, CV_S1, CV_S2, F.cidx, NCONV);
        if (BOTH(2)) GRID_BAR(2); STAMP(3);
    }
    if (IN(3)) {
        constexpr int NPW = (NTOK / 256) * (DCONV / 256);
        const int wid_ = F.bg ? F.wc8 : (int)blockIdx.x, nw_ = F.bg ? NWORK : (int)F.G;
        if (F.conv) convert_items(F, args, CV_S2, CV_S3, F.cidx, NCONV);
        else {
            if (nw_ > NPW) { if (wid_ >= NPW) { combine_tokens(F, OB, LSE, AO, (wid_ - NPW) * 8 + F.wave, (nw_ - NPW) * 8);
                if (F.G == 256) { __syncthreads(); convert_items<2>(F, args, 0, WD_P3, wid_ - NPW, 128); } } }
            else combine_tokens(F, OB, LSE, AO, wid_ * 8 + F.wave, nw_ * 8);
            pg8::DenseOrder S; S.init(NTOK, DCONV, DCONV, nw_, wid_, ws + WS_WPW);
            pg8::EpiBiasBf16 E{AO, DM, (const float*)args.in[8]};
            pg8::gemm_phase<pg8::EpiBiasBf16, pg8::DenseOrder, true>(F.lds, Sb, DCONV, S, E);
        }
        if (BOTH(3)) GRID_BAR(3); STAMP(4);
    }
    if (IN(4)) {
        pg8::DenseOrder S; S.init(NTOK, DM, DM, F.G, (int)blockIdx.x, ws + WS_WOUT);
        pg8::EpiPlainBf16 E{MIXb, DM};
        pg8::gemm_phase<pg8::EpiPlainBf16, pg8::DenseOrder, true>(F.lds, AO, DM, S, E);
        if (BOTH(4)) GRID_BAR(4); STAMP(5);
    }
    if (IN(5)) { route_phase(F, args); if (BOTH(5)) GRID_BAR(5); STAMP(6); }
    if (IN(6)) {
        const bool dsplit = (F.G == 256);
        moe_prefix(F);
        {
            pg8::MoeOrder S{(const volatile LAS int*)(F.MISC + 32), (const volatile LAS int*)(F.MISC + 80), (const int*)(ws + WS_LIST), (const char*)(ws + WS_WGU), 8, 2048, DM / 2, F.vcu, F.G, F.lds};
            pg8::EpiSwiglu E{H8, (const float*)args.in[15], (const float*)args.in[17], (const volatile LAS int*)(F.MISC + 32), &S};
            S.plan([&](const pg8::Unit& u, int tc) { return E.bias_ptr(u, tc); }, WSCALE8);
            pg8::gemm_phase<pg8::EpiSwiglu, pg8::MoeOrder, true, true>(F.lds, X18, DM / 2, S, E);
        }
        if (dsplit) {
            const int Ltot = (int)F.MISC[64] * 8, CH = (Ltot + 7) >> 3, k = CH & 31, c = F.vcu & 31, V = 64 - k;
            const int v0 = c < k ? c : k + 2 * (c - k);
            convert_items<2>(F, args, WD_P3, NEXP * CV_I_E, (F.vcu >> 5) * V + v0, 8 * V, c < k ? 1 : 2);
        }
        if (BOTH(6)) GRID_BAR(6); STAMP(7);
    }
    if (IN(7)) {
        moe_prefix(F);
        pg8::MoeOrder S{(const volatile LAS int*)(F.MISC + 32), (const volatile LAS int*)(F.MISC + 80), nullptr, (const char*)(ws + WS_WD), 4, 1024, DFF / 2, F.vcu, F.G, F.lds};
        pg8::EpiDown E{Yb, (const float*)args.in[19], (const volatile LAS int*)(F.MISC + 32), &S};
        S.plan([&](const pg8::Unit& u, int tc) { return E.bias_ptr(u, tc); }, WSCALE8);
        pg8::gemm_phase<pg8::EpiDown, pg8::MoeOrder, true, true>(F.lds, H8, DFF / 2, S, E);
        if (BOTH(7)) GRID_BAR(7); STAMP(8);
    }
    if (IN(8)) { moe_prefix(F); final_phase(F, args); }
#undef IN
#undef BOTH
}

extern "C" void kernel_launch(void* const* d_in, const int* in_sizes, int n_in, void* d_out, int out_size, void* d_ws, size_t ws_size, hipStream_t stream) {
    static int grid = 0;
    if (grid == 0) {
        if (n_in != 22 || out_size != NTOK * DM || ws_size < WS_END) { fprintf(stderr, "kernel_launch: unexpected problem (n_in %d out %d ws %zu need %zu)\n", n_in, out_size, ws_size, (size_t)WS_END); grid = -1; return; }
        int dev = 0, cus = 0;
        if (hipGetDevice(&dev) != hipSuccess || hipDeviceGetAttribute(&cus, hipDeviceAttributeMultiprocessorCount, dev) != hipSuccess) { grid = -1; return; }
        if (hipFuncSetAttribute((const void*)mega_fwd, hipFuncAttributeMaxDynamicSharedMemorySize, LDS_BYTES) != hipSuccess) { fprintf(stderr, "kernel_launch: hipFuncSetAttribute failed\n"); grid = -1; return; }
        (void)hipGetLastError();
        grid = cus;
    }
    if (grid < 0) return;
    if (hipMemsetAsync((char*)d_ws + WS_CTL, 0, CTL_ZERO_BYTES, stream) != hipSuccess) return;
    Args a{};
    for (int i = 0; i < 22; ++i) a.in[i] = d_in[i];
    a.out = (float*)d_out; a.ws = (unsigned char*)d_ws;
    for (int li = 0; li < N_LAUNCHES; ++li) {
        a.ph_lo = (N_LAUNCHES == PER_PHASE) ? li : 0; a.ph_hi = (N_LAUNCHES == PER_PHASE) ? li + 1 : PER_PHASE; a.li = li;
        hipLaunchKernelGGL(mega_fwd, dim3(grid), dim3(512), LDS_BYTES, stream, a);
    }
}
```

```cpp
#include <hip/hip_runtime.h>
#include <cstdio>
#include <cstdint>

#define GAS __attribute__((address_space(1)))
#define LAS __attribute__((address_space(3)))
typedef unsigned short bf16_t;
typedef short bf16x8 __attribute__((ext_vector_type(8)));
typedef short s16x4 __attribute__((ext_vector_type(4)));
typedef float f32x4 __attribute__((ext_vector_type(4)));
typedef float f32x2 __attribute__((ext_vector_type(2)));
typedef float f32x16 __attribute__((ext_vector_type(16)));
typedef unsigned u32x4 __attribute__((ext_vector_type(4)));
typedef unsigned u32x2 __attribute__((ext_vector_type(2)));
typedef __bf16 bf16x2_t __attribute__((ext_vector_type(2)));

#ifndef MK_N_LAUNCHES
#define MK_N_LAUNCHES 1
#endif
#ifndef TS_A
#define TS_A -1
#endif
#ifndef TS_B
#define TS_B -1
#endif
constexpr int N_LAUNCHES = MK_N_LAUNCHES;
constexpr int PER_PHASE = 9;

constexpr int BATCH = 2, SEQ = 8192, DM = 1024, NTOK = BATCH * SEQ;
constexpr int DCONV = 512, DATT = 512, NHEAD = 8, HD = 64, NPROJ = 2560, CONVK = 31;
constexpr int NEXP = 32, TOPK = 4, DFF = 1024;
constexpr float LN_EPS = 1e-5f;
constexpr float DN_ALPHA = 1.189207115002721f;
constexpr float SWI_LIMIT = 7.0f, SWI_ALPHA = 1.702f;
constexpr float WSCALE8 = 32.0f, WINV8 = 1.0f / 32.0f;
constexpr float QSCALE = 0.125f * 1.4426950408889634f;
constexpr int MAXSLOT = NTOK * TOPK + NEXP * 256;

constexpr size_t MiB = 1u << 20;
constexpr size_t WS_CTL = 0, CTL_ZERO_BYTES = 1 * MiB;
constexpr size_t WS_TOKE = 1 * MiB;
constexpr size_t WS_TOKG = WS_TOKE + 256 * 1024;
constexpr size_t WS_LIST = 2 * MiB;
constexpr size_t WS_ROPE = 4 * MiB;
constexpr size_t WS_WIN = 8 * MiB;
constexpr size_t WS_WPW = 13 * MiB;
constexpr size_t WS_WRT = 13 * MiB + 512 * 1024;
constexpr size_t WS_WOUT = 14 * MiB;
constexpr size_t WS_WD = 16 * MiB;
constexpr size_t WS_WGU = 48 * MiB;
constexpr size_t WS_AO = 112 * MiB;
constexpr size_t WS_Z = 144 * MiB;
constexpr size_t WS_Y = 48 * MiB;
constexpr size_t WS_X1B = 208 * MiB;
constexpr size_t WS_X1F8 = 240 * MiB;
constexpr size_t WS_XB = 256 * MiB;
constexpr size_t WS_U = 288 * MiB;
constexpr size_t WS_Q = 304 * MiB, WS_K = 320 * MiB, WS_V = 336 * MiB;
constexpr size_t WS_S = 352 * MiB;
constexpr size_t WS_OB = 368 * MiB;
constexpr size_t WS_LSE = 416 * MiB;
constexpr size_t WS_H = 256 * MiB;
constexpr size_t WS_END = 418 * MiB;
static_assert(WS_Y + (size_t)MAXSLOT * DM <= WS_Z && WS_H + (size_t)MAXSLOT * DM <= WS_OB && WS_WGU + (size_t)NEXP * 2048 * DM <= WS_AO, "ws overlays");
constexpr int CW_TMO = 0, CW_CODE = 1;
constexpr int CW_GCNT = 64;
constexpr int CW_BAR = 4096;

constexpr int LDS_BYTES = 163840;
constexpr int MISC_OFF = LDS_BYTES - 1024;
constexpr int RING_BYTES = 131072;

#define RLX_AGENT __ATOMIC_RELAXED, __HIP_MEMORY_SCOPE_AGENT
#define LDS_WAIT() asm volatile("s_waitcnt lgkmcnt(0)" ::: "memory")
#define VM_WAIT() asm volatile("s_waitcnt vmcnt(0)" ::: "memory")
typedef GAS unsigned gu32;

__device__ __forceinline__ unsigned cvtpk(float lo, float hi) { f32x2 v = {lo, hi}; bf16x2_t b = __builtin_convertvector(v, bf16x2_t); return __builtin_bit_cast(unsigned, b); }
__device__ __forceinline__ unsigned pk4_fp8(float a, float b, float c, float d) { int w = 0; w = __builtin_amdgcn_cvt_pk_fp8_f32(a, b, w, false); w = __builtin_amdgcn_cvt_pk_fp8_f32(c, d, w, true); return (unsigned)w; }
__device__ __forceinline__ void st16_wt(void* p, u32x4 v) { asm volatile("global_store_dwordx4 %0, %1, off sc1\n\ts_nop 1" :: "v"(p), "v"(v) : "memory"); }
__device__ __forceinline__ float bf2f(bf16_t h) { return __uint_as_float((unsigned)h << 16); }
__device__ __forceinline__ float bflo(unsigned w) { return __uint_as_float(w << 16); }
__device__ __forceinline__ float bfhi(unsigned w) { return __uint_as_float(w & 0xffff0000u); }
__device__ __forceinline__ float wave_sum(float v) {
#pragma unroll
    for (int o = 1; o < 64; o <<= 1) v += __shfl_xor(v, o);
    return v;
}
__device__ __forceinline__ float fsigmoid(float x) { return __builtin_amdgcn_rcpf(1.0f + __builtin_amdgcn_exp2f(-1.4426950408889634f * x)); }

namespace pg8 {
constexpr int BM = 256, BK = 64, HALF = 128, HTB = HALF * BK * 2, STAGE_BYTES = 8 * HTB, NXCD = 8, WGM = 8;
__host__ __device__ __forceinline__ int lds_byte(int r, int c) { const int st = (r >> 4) * 2 + (c >> 5), rr = r & 15, cc = c & 31, ob = rr * 64 + cc * 2; return st * 1024 + (ob ^ (((ob >> 9) & 1) << 5)); }
__host__ __device__ __forceinline__ void stage_rc(int b, int& R, int& C) { const int st = b / 1024, sb = b % 1024, swz = sb ^ (((sb >> 9) & 1) << 5); R = (st >> 1) * 16 + swz / 64; C = (st & 1) * 32 + (swz % 64) / 2; }
__host__ __device__ __forceinline__ int perm32(int rho) { const int n = rho >> 4, i = rho & 15; return 8 * (i >> 2) + 4 * n + (i & 3); }

struct Unit { int pm, pn, e, idx; };

struct DenseOrder {
    int nM, nN, nwg, G, c, K; const char* Bt;
    __device__ void init(int M, int N, int K_, int G_, int c_, const void* Bt_) { nM = M / BM; nN = N / BM; nwg = nM * nN; G = G_; c = c_; K = K_; Bt = (const char*)Bt_; }
    __device__ __forceinline__ bool next(int i, Unit& u) const {
        const long L = (long)i * G + c; if (L >= nwg) return false;
        int wgid = (int)L; { const int q = nwg / NXCD, r = nwg % NXCD, xcd = wgid % NXCD, off = wgid / NXCD; wgid = (xcd < r ? xcd * (q + 1) : r * (q + 1) + (xcd - r) * q) + off; }
        const int nig = WGM * nN, gid = wgid / nig, fm = gid * WGM, gsz = (nM - fm) < WGM ? (nM - fm) : WGM;
        u.pm = fm + ((wgid % nig) % gsz); u.pn = (wgid % nig) / gsz; u.e = 0; u.idx = i; return true;
    }
    __device__ __forceinline__ const char* b_base(const Unit& u) const { return Bt + (size_t)u.pn * BM * K * 2; }
    __device__ __forceinline__ void a_off(const Unit& u, unsigned (&v)[2][2]) const {
#pragma unroll
        for (int i = 0; i < 2; ++i) { int R, C; stage_rc((int)threadIdx.x * 16 + i * 8192, R, C);
#pragma unroll
            for (int h = 0; h < 2; ++h) v[h][i] = (unsigned)((u.pm * BM + h * HALF + R) * K + C) * 2u; }
    }
};
constexpr int PLAN_OFF = 131072, PLAN_UNITS = 12, PLAN_STRIDE = 2048, PLAN_DESC = PLAN_OFF + PLAN_UNITS * PLAN_STRIDE;
struct MoeOrder {
    const volatile LAS int* tp;
    const volatile LAS int* cnt;
    const int* list;
    const char* Bt; int NT, nrowB;
    int pitch;
    int vcu, G;
    LAS unsigned char* lds;
    __device__ __forceinline__ int tpu(int j) const { return __builtin_amdgcn_readfirstlane(tp[j]); }
    template <class BiasPtr> __device__ __forceinline__ void plan(const BiasPtr& biasptr, float bscale) const {
        const int tid = threadIdx.x, lane = tid & 63, li = lane < 32 ? lane : 32;
        const int vt = tp[li], vc = cnt[lane & 31];
        auto T = [&](int j) { return __builtin_amdgcn_readlane(vt, j); };
        const int per = G >> 3, x = vcu / per, c = vcu % per;
        const int Ltot = T(32) * NT, CH = (Ltot + 7) >> 3;
        int ce_ = 0, tl_ = 0, th_ = T(1);
        auto unit_of = [&](int i, Unit& u, int& t0) {
            const int loc = i * per + c, L = x * CH + loc; const bool ok = loc < CH && L < Ltot;
            u.e = 0; u.pn = 0; u.pm = 0; u.idx = i; t0 = 0;
            if (ok) {
                while (L >= th_ * NT && ce_ < NEXP - 1) { ++ce_; tl_ = th_; th_ = T(ce_ + 1); }
                const int q = L - tl_ * NT, te = th_ - tl_;
                const int pn = (int)(((float)q + 0.5f) * __builtin_amdgcn_rcpf((float)te));
                u.e = ce_; u.pn = pn; u.pm = q - pn * te; t0 = tl_; }
            return ok; };
        int val[PLAN_UNITS];
        if (tid < 256) {
#pragma unroll
            for (int i = 0; i < PLAN_UNITS; ++i) { Unit u; int t0; const bool ok = unit_of(i, u, t0);
                if (tid == 0) { volatile LAS int* d = (volatile LAS int*)(lds + PLAN_DESC) + 4 * i; d[0] = u.e; d[1] = u.pn; d[2] = u.pm; d[3] = ok ? 1 : 0; }
                const int ce = __builtin_amdgcn_readlane(vc, u.e), r = u.pm * BM + tid;
                val[i] = list ? 0 : t0 * BM + r;
                if (list && ok && r < ce) val[i] = list[u.e * NTOK + r]; }
#pragma unroll
            for (int i = 0; i < PLAN_UNITS; ++i) ((LAS int*)(lds + PLAN_OFF + i * PLAN_STRIDE))[tid] = val[i];
        } else {
#pragma unroll
            for (int i = 0; i < PLAN_UNITS; ++i) { Unit u; int t0; const bool ok = unit_of(i, u, t0);
                val[i] = 0; if (ok) val[i] = *(const int*)biasptr(u, tid - 256); }
#pragma unroll
            for (int i = 0; i < PLAN_UNITS; ++i) ((LAS float*)(lds + PLAN_OFF + i * PLAN_STRIDE))[tid] = __builtin_bit_cast(float, val[i]) * bscale;
        }
        __syncthreads();
    }
    __device__ __forceinline__ bool next(int i, Unit& u) const {
        if (i >= PLAN_UNITS) return false;
        const volatile LAS int* d = (const volatile LAS int*)(lds + PLAN_DESC) + 4 * i;
        if (__builtin_amdgcn_readfirstlane(d[3]) == 0) return false;
        u.e = __builtin_amdgcn_readfirstlane(d[0]); u.pn = __builtin_amdgcn_readfirstlane(d[1]); u.pm = __builtin_amdgcn_readfirstlane(d[2]); u.idx = i; return true;
    }
    __device__ __forceinline__ const char* b_base(const Unit& u) const { return Bt + ((size_t)u.e * nrowB + (size_t)u.pn * BM) * pitch * 2; }
    __device__ __forceinline__ void a_off(const Unit& u, unsigned (&v)[2][2]) const {
        const LAS int* rows = (const LAS int*)(lds + PLAN_OFF + u.idx * PLAN_STRIDE);
#pragma unroll
        for (int i = 0; i < 2; ++i) { int R, C; stage_rc((int)threadIdx.x * 16 + i * 8192, R, C);
#pragma unroll
            for (int h = 0; h < 2; ++h) v[h][i] = (unsigned)(rows[h * HALF + R] * pitch + C) * 2u; }
    }
    __device__ __forceinline__ void plan_bias(const Unit& u, int wc, int fq, f32x4 (&bv)[2][2]) const {
        const LAS float* pb = (const LAS float*)(lds + PLAN_OFF + u.idx * PLAN_STRIDE + 1024);
#pragma unroll
        for (int bj = 0; bj < 2; ++bj)
#pragma unroll
            for (int n = 0; n < 2; ++n) bv[bj][n] = *(const LAS f32x4*)(pb + bj * HALF + wc * 32 + 8 * fq + 4 * n);
    }
};

template <class Epi, class Sched, bool ALIGN_EPI, bool FP8 = false>
__device__ __forceinline__ void gemm_phase(LAS unsigned char* lds, const void* Abase_, int K, const Sched& S, const Epi& E) {
    const char* Abase = (const char*)Abase_;
    const int tid = threadIdx.x, wid = __builtin_amdgcn_readfirstlane(tid >> 6), lane = tid & 63, wr = wid >> 2, wc = wid & 3, fr = lane & 15, fq = lane >> 4;
    const int nt = K / BK;
    unsigned voffB[2];
#pragma unroll
    for (int i = 0; i < 2; ++i) { int R, C; stage_rc(tid * 16 + i * 8192, R, C); const int Rb = Epi::PERM ? ((R & ~31) + perm32(R & 31)) : R; voffB[i] = (unsigned)(Rb * K + C) * 2u; }
    const size_t kstep = (size_t)(BK * 2);
    const size_t hstep = (size_t)HALF * K * 2;
    const unsigned ldsw = (unsigned)wid * 1024u;
    const int aoff = lds_byte(wr * 64 + fr, fq * 8), boff = lds_byte(wc * 32 + fr, fq * 8);
#define PG8_SA(b, h) (((b) * 2 + (h)) * HTB)
#define PG8_SB(b, h) ((4 + (b) * 2 + (h)) * HTB)
#define PG8_UPTR(p) ((const char*)(((unsigned long long)(unsigned)__builtin_amdgcn_readfirstlane((int)((unsigned long long)(p) >> 32)) << 32) | (unsigned long long)(unsigned)__builtin_amdgcn_readfirstlane((int)(unsigned)(unsigned long long)(p))))
#define PG8_STAGEB(bufoff, gbase) do { const char* gb_ = PG8_UPTR(gbase); _Pragma("unroll") for (int _i = 0; _i < 2; ++_i) \
        __builtin_amdgcn_global_load_lds((const unsigned*)(gb_ + voffB[_i]), (LAS unsigned*)(lds + (bufoff) + ldsw + _i * 8192), 16, 0, 0); } while (0)
#define PG8_STAGEA(bufoff, vo, h, kb) do { const char* ga_ = PG8_UPTR(Abase + (kb)); _Pragma("unroll") for (int _i = 0; _i < 2; ++_i) \
        __builtin_amdgcn_global_load_lds((const unsigned*)(ga_ + (vo)[h][_i]), (LAS unsigned*)(lds + (bufoff) + ldsw + _i * 8192), 16, 0, 0); } while (0)
#define PG8_STAGEA2(bufoff, h, kb) do { const char* ga_ = PG8_UPTR(Abase + (kb)); _Pragma("unroll") for (int _i = 0; _i < 2; ++_i) \
        __builtin_amdgcn_global_load_lds((const unsigned*)(ga_ + (last ? vN[h][_i] : vA[h][_i])), (LAS unsigned*)(lds + (bufoff) + ldsw + _i * 8192), 16, 0, 0); } while (0)
#define PG8_LD8(addr_) __builtin_shufflevector(*(const LAS v4i_*)(addr_), *(const LAS v4i_*)((addr_) + 1024), 0, 1, 2, 3, 4, 5, 6, 7)
#define PG8_LDA(dst, b, h) do { _Pragma("unroll") for (int m = 0; m < 4; ++m) dst[m] = PG8_LD8(lds + PG8_SA(b, h) + aoff + m * 2048); } while (0)
#define PG8_LDB(dst, b, h) do { _Pragma("unroll") for (int n = 0; n < 2; ++n) dst[n] = PG8_LD8(lds + PG8_SB(b, h) + boff + n * 2048); } while (0)
#define PG8_LO(x) __builtin_bit_cast(bf16x8, __builtin_shufflevector(x, x, 0, 1, 2, 3))
#define PG8_HI(x) __builtin_bit_cast(bf16x8, __builtin_shufflevector(x, x, 4, 5, 6, 7))
#define PG8_MMA(ai, bj, At, Bt) do { if constexpr (FP8) __builtin_amdgcn_sched_barrier(0); __builtin_amdgcn_s_setprio(1); _Pragma("unroll") for (int m = 0; m < 4; ++m) _Pragma("unroll") for (int n = 0; n < 2; ++n) { \
        if constexpr (FP8) asm volatile("v_mfma_scale_f32_16x16x128_f8f6f4 %0, %1, %2, %0, %3, %3 op_sel_hi:[0,0,0]" : "+v"(acc[ai][bj][m][n]) : "v"(Bt[n]), "v"(At[m]), "v"(sc8));   \
        else { acc[ai][bj][m][n] = __builtin_amdgcn_mfma_f32_16x16x32_bf16(PG8_LO(Bt[n]), PG8_LO(At[m]), acc[ai][bj][m][n], 0, 0, 0); \
               acc[ai][bj][m][n] = __builtin_amdgcn_mfma_f32_16x16x32_bf16(PG8_HI(Bt[n]), PG8_HI(At[m]), acc[ai][bj][m][n], 0, 0, 0); } } \
        __builtin_amdgcn_s_setprio(0); if constexpr (FP8) __builtin_amdgcn_sched_barrier(0); } while (0)
#define PG8_WAIT_V(n) asm volatile("s_waitcnt vmcnt(" #n ")" ::: "memory")
#define PG8_WAIT_L(n) asm volatile("s_waitcnt lgkmcnt(" #n ")" ::: "memory")
#define PG8_BAR __builtin_amdgcn_s_barrier()
#define PG8_SCHED __builtin_amdgcn_sched_barrier(0)
    Unit cur, nxt; int ui = 0;
    if (!S.next(0, cur)) return;
    f32x4 acc[2][2][4][2], bvn[2][2];
    E.bias(cur, wc, fq, bvn);
#pragma unroll
    for (int a = 0; a < 2; ++a)
#pragma unroll
        for (int b = 0; b < 2; ++b)
#pragma unroll
            for (int m = 0; m < 4; ++m)
#pragma unroll
                for (int n = 0; n < 2; ++n) acc[a][b][m][n] = bvn[b][n];
    typedef int v4i_ __attribute__((ext_vector_type(4))); typedef int v8i_ __attribute__((ext_vector_type(8)));
    v8i_ At[4], B0[2], B1[2];
    int sc8 = 0x7f7f7f7f; asm volatile("" : "+v"(sc8));
    unsigned vA[2][2], vN[2][2];
    S.a_off(cur, vA);
    const char* cB = S.b_base(cur);
    PG8_STAGEB(PG8_SB(0, 0), cB); PG8_STAGEB(PG8_SB(0, 1), cB + hstep); PG8_STAGEA(PG8_SA(0, 0), vA, 0, 0); PG8_STAGEA(PG8_SA(0, 1), vA, 1, 0);
    if (wr == 1) PG8_BAR;
    PG8_WAIT_V(2); PG8_BAR;
    PG8_STAGEB(PG8_SB(1, 0), cB + kstep); PG8_STAGEA(PG8_SA(1, 0), vA, 0, kstep); PG8_STAGEB(PG8_SB(1, 1), cB + hstep + kstep);
    PG8_WAIT_V(6); PG8_BAR;
    for (;;) {
        const bool has_next = S.next(ui + 1, nxt);
        const char* nB = cB;
#pragma unroll
        for (int h = 0; h < 2; ++h)
#pragma unroll
            for (int i = 0; i < 2; ++i) vN[h][i] = vA[h][i];
        if (has_next) { S.a_off(nxt, vN); nB = S.b_base(nxt); }
#pragma unroll 1
        for (int t = 0; t < nt; t += 2) {
            const bool last = (t == nt - 2);
            const size_t k1 = (size_t)(t + 1) * kstep;
            const size_t k2 = last ? 0 : (size_t)(t + 2) * kstep, k3 = k2 + kstep;
            const char* b2 = last ? nB : cB + (size_t)(t + 2) * kstep; const char* b3 = b2 + kstep;
            PG8_LDB(B0, 0, 0); PG8_LDB(B1, 0, 1); PG8_SCHED; PG8_LDA(At, 0, 0); PG8_STAGEA(PG8_SA(1, 1), vA, 1, k1);
            PG8_WAIT_V(8); PG8_WAIT_L(0); PG8_BAR; PG8_MMA(0, 0, At, B0); PG8_MMA(0, 1, At, B1); PG8_BAR; PG8_SCHED;
            PG8_LDA(At, 0, 1); PG8_STAGEB(PG8_SB(0, 0), b2); PG8_STAGEB(PG8_SB(0, 1), b2 + hstep); PG8_STAGEA2(PG8_SA(0, 0), 0, k2);
            PG8_WAIT_V(8); PG8_WAIT_L(0); PG8_BAR; PG8_MMA(1, 0, At, B0); PG8_MMA(1, 1, At, B1); PG8_BAR; PG8_SCHED;
            PG8_LDB(B0, 1, 0); PG8_LDB(B1, 1, 1); PG8_SCHED; PG8_LDA(At, 1, 0); PG8_STAGEA2(PG8_SA(0, 1), 1, k2);
            PG8_WAIT_V(8); PG8_WAIT_L(0); PG8_BAR; PG8_MMA(0, 0, At, B0); PG8_MMA(0, 1, At, B1); PG8_BAR; PG8_SCHED;
            PG8_LDA(At, 1, 1); PG8_STAGEB(PG8_SB(1, 0), b3); PG8_STAGEB(PG8_SB(1, 1), b3 + hstep); PG8_STAGEA2(PG8_SA(1, 0), 0, k3);
            PG8_WAIT_V(8); PG8_WAIT_L(0); PG8_BAR; PG8_MMA(1, 0, At, B0); PG8_MMA(1, 1, At, B1); PG8_BAR; PG8_SCHED;
        }
        if constexpr (ALIGN_EPI) { if (wr == 0) PG8_BAR; }
        if constexpr (FP8) asm volatile("s_nop 15\n\ts_nop 7" ::: "memory");
        if (has_next) E.bias(nxt, wc, fq, bvn);
        if (!Epi::AFTER_DRAIN || has_next) E(acc, cur, wr, wc, fr, fq);
        if (!has_next) break;
#pragma unroll
        for (int a = 0; a < 2; ++a)
#pragma unroll
            for (int b = 0; b < 2; ++b)
#pragma unroll
                for (int m = 0; m < 4; ++m)
#pragma unroll
                    for (int n = 0; n < 2; ++n) acc[a][b][m][n] = bvn[b][n];
        cur = nxt; cB = nB; ++ui;
#pragma unroll
        for (int h = 0; h < 2; ++h)
#pragma unroll
            for (int i = 0; i < 2; ++i) vA[h][i] = vN[h][i];
        if constexpr (ALIGN_EPI) { if (wr == 1) PG8_BAR; }
    }
    PG8_WAIT_V(0);
    if constexpr (!ALIGN_EPI) { if (wr == 0) PG8_BAR; }
    PG8_BAR;
    if constexpr (Epi::AFTER_DRAIN) E(acc, cur, wr, wc, fr, fq);
#undef PG8_SA
#undef PG8_SB
#undef PG8_STAGEA
#undef PG8_UPTR
#undef PG8_STAGEA2
#undef PG8_STAGEB
#undef PG8_LDA
#undef PG8_LD8
#undef PG8_LO
#undef PG8_HI
#undef PG8_LDB
#undef PG8_MMA
#undef PG8_WAIT_V
#undef PG8_WAIT_L
#undef PG8_BAR
#undef PG8_SCHED
}

typedef const f32x4 (&AccRef)[2][2][4][2];
__device__ __forceinline__ u32x4 pack8(f32x4 a, f32x4 b) { u32x4 w; w.x = cvtpk(a[0], a[1]); w.y = cvtpk(a[2], a[3]); w.z = cvtpk(b[0], b[1]); w.w = cvtpk(b[2], b[3]); return w; }

struct EpiInProj {
    static constexpr bool PERM = true, AFTER_DRAIN = false;
    bf16_t *U, *Q, *Kb, *V; const float* rope;
    __device__ __forceinline__ void bias(const Unit&, int, int, f32x4 (&bv)[2][2]) const { bv[0][0] = bv[0][1] = bv[1][0] = bv[1][1] = (f32x4){0.f, 0.f, 0.f, 0.f}; }
    __device__ __forceinline__ void operator()(AccRef acc, const Unit& u, int wr, int wc, int fr, int fq) const {
        const int row0 = u.pm * BM + wr * 64 + fr;
        if (u.pn < 4) {
#pragma unroll
            for (int ai = 0; ai < 2; ++ai)
#pragma unroll
                for (int m = 0; m < 4; ++m) { const int row = row0 + ai * HALF + m * 16; f32x4 o[2];
#pragma unroll
                    for (int n = 0; n < 2; ++n)
#pragma unroll
                        for (int i = 0; i < 4; ++i) o[n][i] = acc[ai][0][m][n][i] * fsigmoid(acc[ai][1][m][n][i]);
                    st16_wt(U + (size_t)row * DCONV + u.pn * 128 + wc * 32 + 8 * fq, pack8(o[0], o[1])); }
        } else if (u.pn < 8) {
            const bool isq = u.pn < 6; bf16_t* dst = isq ? Q : Kb; const float sc = isq ? QSCALE : 1.0f;
            const int head = 4 * (u.pn & 1) + wc;
#pragma unroll
            for (int ai = 0; ai < 2; ++ai) { f32x4 cs[4][2], sn[4][2];
#pragma unroll
                for (int m = 0; m < 4; ++m) { const int row = row0 + ai * HALF + m * 16;
#pragma unroll
                    for (int n = 0; n < 2; ++n) { cs[m][n] = *(const f32x4*)(rope + (size_t)row * 32 + 8 * fq + 4 * n); sn[m][n] = *(const f32x4*)(rope + (size_t)NTOK * 32 + (size_t)row * 32 + 8 * fq + 4 * n); } }
#pragma unroll
                for (int m = 0; m < 4; ++m) { const int row = row0 + ai * HALF + m * 16; f32x4 lo[2], hi[2];
#pragma unroll
                    for (int n = 0; n < 2; ++n) { const f32x4 a = acc[ai][0][m][n], b = acc[ai][1][m][n];
                        lo[n] = (a * cs[m][n] - b * sn[m][n]) * sc; hi[n] = (b * cs[m][n] + a * sn[m][n]) * sc; }
                    bf16_t* p = dst + (size_t)row * DATT + head * 64 + 8 * fq;
                    st16_wt(p, pack8(lo[0], lo[1])); st16_wt(p + 32, pack8(hi[0], hi[1])); } }
        } else {
#pragma unroll
            for (int ai = 0; ai < 2; ++ai)
#pragma unroll
                for (int m = 0; m < 4; ++m) { const int row = row0 + ai * HALF + m * 16;
#pragma unroll
                    for (int bj = 0; bj < 2; ++bj) st16_wt(V + (size_t)row * DATT + (u.pn - 8) * 256 + bj * 128 + wc * 32 + 8 * fq, pack8(acc[ai][bj][m][0], acc[ai][bj][m][1])); }
        }
    }
};
struct EpiBiasBf16 {
    static constexpr bool PERM = true, AFTER_DRAIN = false;
    bf16_t* O; int ldc; const float* bvec;
    __device__ __forceinline__ void bias(const Unit& u, int wc, int fq, f32x4 (&bv)[2][2]) const {
        const int col0 = u.pn * BM + wc * 32 + 8 * fq;
#pragma unroll
        for (int bj = 0; bj < 2; ++bj)
#pragma unroll
            for (int n = 0; n < 2; ++n) bv[bj][n] = *(const f32x4*)(bvec + col0 + bj * HALF + 4 * n);
    }
    __device__ __forceinline__ void operator()(AccRef acc, const Unit& u, int wr, int wc, int fr, int fq) const {
        const int row0 = u.pm * BM + wr * 64 + fr, col0 = u.pn * BM + wc * 32 + 8 * fq;
#pragma unroll
        for (int ai = 0; ai < 2; ++ai)
#pragma unroll
            for (int m = 0; m < 4; ++m) { bf16_t* rowp = O + (size_t)(row0 + ai * HALF + m * 16) * ldc + col0;
#pragma unroll
                for (int bj = 0; bj < 2; ++bj) st16_wt(rowp + bj * HALF, pack8(acc[ai][bj][m][0], acc[ai][bj][m][1])); }
    }
};
struct EpiPlainBf16 {
    static constexpr bool PERM = true, AFTER_DRAIN = false;
    bf16_t* O; int ldc;
    __device__ __forceinline__ void bias(const Unit&, int, int, f32x4 (&bv)[2][2]) const { bv[0][0] = bv[0][1] = bv[1][0] = bv[1][1] = (f32x4){0.f, 0.f, 0.f, 0.f}; }
    __device__ __forceinline__ void operator()(AccRef acc, const Unit& u, int wr, int wc, int fr, int fq) const {
        const int row0 = u.pm * BM + wr * 64 + fr, col0 = u.pn * BM + wc * 32 + 8 * fq;
#pragma unroll
        for (int ai = 0; ai < 2; ++ai)
#pragma unroll
            for (int m = 0; m < 4; ++m) { bf16_t* rowp = O + (size_t)(row0 + ai * HALF + m * 16) * ldc + col0;
#pragma unroll
                for (int bj = 0; bj < 2; ++bj) st16_wt(rowp + bj * HALF, pack8(acc[ai][bj][m][0], acc[ai][bj][m][1])); }
    }
};
__device__ __forceinline__ u32x4 widen16(u32x2 a, u32x2 b) {
    const auto r0 = __builtin_amdgcn_permlane16_swap(a.x, b.x, false, false); const auto r1 = __builtin_amdgcn_permlane16_swap(a.y, b.y, false, false);
    u32x4 o; o.x = r0[0]; o.y = r1[0]; o.z = r0[1]; o.w = r1[1]; return o;
}
struct EpiSwiglu {
    static constexpr bool PERM = true, AFTER_DRAIN = false;
    unsigned char* H; const float *bg, *bu; const volatile LAS int* tp;
    const MoeOrder* S;
    __device__ __forceinline__ const float* bias_ptr(const Unit& u, int tc) const { return (tc < 128 ? bg + tc : bu + (tc - 128)) + (size_t)u.e * DFF + u.pn * 128; }
    __device__ __forceinline__ void bias(const Unit& u, int wc, int fq, f32x4 (&bv)[2][2]) const { S->plan_bias(u, wc, fq, bv); }
    __device__ __forceinline__ void operator()(AccRef acc, const Unit& u, int wr, int wc, int fr, int fq) const {
        const int row0 = __builtin_amdgcn_readfirstlane(tp[u.e]) * BM + u.pm * BM + wr * 64 + fr, col0 = u.pn * 128 + wc * 32 + 8 * fq;
#pragma unroll
        for (int ai = 0; ai < 2; ++ai) { u32x2 w8[4];
#pragma unroll
            for (int m = 0; m < 4; ++m) { f32x4 o[2];
#pragma unroll
                for (int n = 0; n < 2; ++n)
#pragma unroll
                    for (int i = 0; i < 4; i += 2) { const f32x2 ua = {acc[ai][1][m][n][i], acc[ai][1][m][n][i + 1]};
                        f32x2 gm; gm.x = __builtin_amdgcn_fmed3f(acc[ai][0][m][n][i], -3.0e38f, SWI_LIMIT * WSCALE8); gm.y = __builtin_amdgcn_fmed3f(acc[ai][0][m][n][i + 1], -3.0e38f, SWI_LIMIT * WSCALE8);
                        const f32x2 ea = gm * (-SWI_ALPHA * 1.4426950408889634f * WINV8);
                        f32x2 ex; ex.x = __builtin_amdgcn_exp2f(ea.x); ex.y = __builtin_amdgcn_exp2f(ea.y);
                        const f32x2 dn = ex + 1.0f; f32x2 rc; rc.x = __builtin_amdgcn_rcpf(dn.x); rc.y = __builtin_amdgcn_rcpf(dn.y);
                        f32x2 u1 = __builtin_elementwise_fma(ua, (f32x2){WINV8 * WINV8, WINV8 * WINV8}, (f32x2){WINV8, WINV8});
                        u1.x = __builtin_amdgcn_fmed3f(u1.x, (1.0f - SWI_LIMIT) * WINV8, (1.0f + SWI_LIMIT) * WINV8); u1.y = __builtin_amdgcn_fmed3f(u1.y, (1.0f - SWI_LIMIT) * WINV8, (1.0f + SWI_LIMIT) * WINV8);
                        const f32x2 r = (u1 * gm) * rc; o[n][i] = r.x; o[n][i + 1] = r.y; }
                w8[m].x = pk4_fp8(o[0][0], o[0][1], o[0][2], o[0][3]); w8[m].y = pk4_fp8(o[1][0], o[1][1], o[1][2], o[1][3]); }
#pragma unroll
            for (int mp = 0; mp < 2; ++mp) { const u32x4 v16 = widen16(w8[2 * mp], w8[2 * mp + 1]);
                *(u32x4*)(H + (size_t)(row0 + ai * HALF + (2 * mp + (fq & 1)) * 16) * DFF + (col0 - 8 * fq + 16 * (fq >> 1))) = v16; } }
    }
};
struct EpiDown {
    static constexpr bool PERM = true, AFTER_DRAIN = false;
    unsigned char* Y; const float* bd; const volatile LAS int* tp;
    const MoeOrder* S;
    __device__ __forceinline__ const float* bias_ptr(const Unit& u, int tc) const { return bd + (size_t)u.e * DM + u.pn * BM + tc; }
    __device__ __forceinline__ void bias(const Unit& u, int wc, int fq, f32x4 (&bv)[2][2]) const { S->plan_bias(u, wc, fq, bv); }
    __device__ __forceinline__ void operator()(AccRef acc, const Unit& u, int wr, int wc, int fr, int fq) const {
        const int row0 = __builtin_amdgcn_readfirstlane(tp[u.e]) * BM + u.pm * BM + wr * 64 + fr, col0 = u.pn * BM + wc * 32 + 8 * fq;
#pragma unroll
        for (int ai = 0; ai < 2; ++ai)
#pragma unroll
            for (int mp = 0; mp < 2; ++mp)
#pragma unroll
                for (int bj = 0; bj < 2; ++bj) { u32x2 w8[2];
#pragma unroll
                    for (int q = 0; q < 2; ++q) { const f32x4 y0 = acc[ai][bj][2 * mp + q][0] * WINV8, y1 = acc[ai][bj][2 * mp + q][1] * WINV8; w8[q].x = pk4_fp8(y0[0], y0[1], y0[2], y0[3]); w8[q].y = pk4_fp8(y1[0], y1[1], y1[2], y1[3]); }
                    *(u32x4*)(Y + (size_t)(row0 + ai * HALF + (2 * mp + (fq & 1)) * 16) * DM + (col0 - 8 * fq + 16 * (fq >> 1)) + bj * HALF) = widen16(w8[0], w8[1]); }
    }
};
}

#define XB_TMO      128
#define XB_XCNT(j)  (256  + 64 * (j))
#define XB_XSUB(j)  (1280 + 64 * (j))
#define XB_XGEN(j)  (2304 + 64 * (j))
#define XB_TOP      3328
#define XB_TOPGEN   3392
#define XCD_BAR_WORDS 3456
#define XB_SPIN_CAP (1u << 18)
__device__ __forceinline__ unsigned xb_ld(unsigned* p)              { return __hip_atomic_load(p, __ATOMIC_RELAXED, __HIP_MEMORY_SCOPE_AGENT); }
__device__ __forceinline__ unsigned xb_add(unsigned* p, unsigned v) { return __hip_atomic_fetch_add(p, v, __ATOMIC_RELAXED, __HIP_MEMORY_SCOPE_AGENT); }
__device__ __forceinline__ unsigned xb_xcc_id() { return (unsigned)__builtin_amdgcn_s_getreg((3 << 11) | 20) & 0xFu; }
#define XB_SPIN(cond, bar) do { unsigned _sp = 0; while (cond) { __builtin_amdgcn_s_sleep(1); \
    if ((++_sp & 255u) == 0u) { if (xb_ld(&(bar)[XB_TMO])) break; if (_sp > XB_SPIN_CAP) { atomicAdd(&(bar)[XB_TMO], 1u); break; } } } } while (0)
struct XcdBarrier { unsigned* bar; unsigned x; volatile LAS unsigned* st; };
__device__ __forceinline__ XcdBarrier xcd_barrier_post(unsigned* bar, volatile LAS unsigned* st) {
    XcdBarrier b; b.bar = bar; b.x = xb_xcc_id(); b.st = st;
    if (threadIdx.x == 0) (void)xb_add(&bar[XB_XCNT(b.x)], 1u);
    return b;
}
__device__ __forceinline__ void xcd_barrier_complete(unsigned* bar, unsigned x, unsigned& nloc, unsigned& nx) {
    const unsigned G = gridDim.x * gridDim.y * gridDim.z;
    unsigned sum, cnt, mine, sp = 0u;
    for (;;) {
        sum = 0u; cnt = 0u; mine = 0u;
#pragma unroll
        for (unsigned j = 0; j < 16; ++j) { const unsigned c = xb_ld(&bar[XB_XCNT(j)]); sum += c; cnt += (c > 0u) ? 1u : 0u; mine = (j == x) ? c : mine; }
        if (sum == G) break;
        __builtin_amdgcn_s_sleep(1);
        if ((++sp & 255u) == 0u) { if (xb_ld(&bar[XB_TMO])) break; if (sp > XB_SPIN_CAP) { atomicAdd(&bar[XB_TMO], 1u); break; } }
    }
    nloc = mine > 0u ? mine : 1u; nx = cnt > 0u ? cnt : 1u;
}
__device__ __forceinline__ void xcd_barrier(const XcdBarrier& b) {
    asm volatile("s_waitcnt vmcnt(0)" ::: "memory");
    __syncthreads();
    if (threadIdx.x == 0) {
        unsigned* bar = b.bar;
        __builtin_amdgcn_s_waitcnt(0);
        unsigned nloc = b.st[0], nx = b.st[1];
        if (nloc == 0u) { xcd_barrier_complete(bar, b.x, nloc, nx); b.st[0] = nloc; b.st[1] = nx; }
        const unsigned old = xb_add(&bar[XB_XSUB(b.x)], 1u);
        const unsigned gen = old / nloc;
        if (old + 1u == (gen + 1u) * nloc) {
            __builtin_amdgcn_fence(__ATOMIC_RELEASE, "agent");
            asm volatile("s_waitcnt vmcnt(0)" ::: "memory");
            const unsigned og = xb_add(&bar[XB_TOP], 1u);
            const unsigned tg = og / nx;
            if (og + 1u == (tg + 1u) * nx) xb_add(&bar[XB_TOPGEN], 1u);
            else XB_SPIN(xb_ld(&bar[XB_TOPGEN]) == tg, bar);
            __builtin_amdgcn_fence(__ATOMIC_ACQUIRE, "agent");
            xb_add(&bar[XB_XGEN(b.x)], 1u);
            asm volatile("s_waitcnt vmcnt(0)" ::: "memory");
        } else {
            XB_SPIN(xb_ld(&bar[XB_XGEN(b.x)]) == gen, bar);
            __builtin_amdgcn_fence(__ATOMIC_ACQUIRE, "agent");
            asm volatile("s_waitcnt vmcnt(0)" ::: "memory");
        }
    }
    __syncthreads();
}

struct Args { const void* in[22]; float* out; unsigned char* ws; int ph_lo, ph_hi, li, pad; };
struct Frame {
    LAS unsigned char* lds; volatile LAS unsigned* MISC; gu32* ctl;
    int tid, lane, wave, vcu, G;
    bool bg, conv; int wc8, cidx;
    unsigned char* ws;
};

template <class RowMap>
__device__ __forceinline__ void tr_item(const float* W, int N, int K, bf16_t* WT, const RowMap& rm, LAS float* scr, int k0, int n0, int lane) {
    const int n4 = lane & 15, kr = lane >> 4;
    f32x4 v[16];
#pragma unroll
    for (int i = 0; i < 16; ++i) v[i] = *(const GAS f32x4*)(W + (size_t)(k0 + kr + 4 * i) * N + n0 + 4 * n4);
#pragma unroll
    for (int i = 0; i < 16; ++i) { LAS float* p = scr + (kr + 4 * i) * 65 + 4 * n4; p[0] = v[i][0]; p[1] = v[i][1]; p[2] = v[i][2]; p[3] = v[i][3]; }
    LDS_WAIT(); asm volatile("" ::: "memory");
    const int c = (lane & 3) + 4 * (lane >> 5), nn = (lane >> 2) & 7;
#pragma unroll
    for (int it = 0; it < 8; ++it) { const int n = nn + 8 * it; const LAS float* s = scr + (8 * c) * 65 + n;
        u32x4 o; o.x = cvtpk(s[0], s[65]); o.y = cvtpk(s[2 * 65], s[3 * 65]); o.z = cvtpk(s[4 * 65], s[5 * 65]); o.w = cvtpk(s[6 * 65], s[7 * 65]);
        *(GAS u32x4*)(WT + (size_t)rm(n0 + n) * K + k0 + 8 * c) = o; }
    LDS_WAIT(); asm volatile("" ::: "memory");
}
template <class RowMap>
__device__ __forceinline__ void tr_item8(const float* W, int N, int K, unsigned char* WT, const RowMap& rm, LAS float* scr, int k0, int n0, int lane, float scale) {
    const int n4 = lane & 15, kr = lane >> 4;
    f32x4 v[16];
#pragma unroll
    for (int i = 0; i < 16; ++i) v[i] = *(const GAS f32x4*)(W + (size_t)(k0 + kr + 4 * i) * N + n0 + 4 * n4);
#pragma unroll
    for (int i = 0; i < 16; ++i) { LAS float* p = scr + (kr + 4 * i) * 65 + 4 * n4; p[0] = v[i][0] * scale; p[1] = v[i][1] * scale; p[2] = v[i][2] * scale; p[3] = v[i][3] * scale; }
    LDS_WAIT(); asm volatile("" ::: "memory");
    const int c = (lane & 1) + 2 * (lane >> 5), nn = (lane >> 1) & 15;
#pragma unroll
    for (int it = 0; it < 4; ++it) { const int n = nn + 16 * it; const LAS float* s = scr + (16 * c) * 65 + n;
        u32x4 o; o.x = pk4_fp8(s[0], s[65], s[2 * 65], s[3 * 65]); o.y = pk4_fp8(s[4 * 65], s[5 * 65], s[6 * 65], s[7 * 65]);
        o.z = pk4_fp8(s[8 * 65], s[9 * 65], s[10 * 65], s[11 * 65]); o.w = pk4_fp8(s[12 * 65], s[13 * 65], s[14 * 65], s[15 * 65]);
        *(GAS u32x4*)(WT + (size_t)rm(n0 + n) * K + k0 + 16 * c) = o; }
    LDS_WAIT(); asm volatile("" ::: "memory");
}
struct MapIdent { int off; __device__ __forceinline__ int operator()(int n) const { return off + n; } };
struct MapGateUp { int off; __device__ __forceinline__ int operator()(int n) const { return off + 256 * (n >> 7) + (n & 127); } };
struct MapInProj { __device__ __forceinline__ int operator()(int n) const {
    if (n < 512) return 256 * (n >> 7) + (n & 127);
    if (n < 1024) { const int c = n - 512; return 256 * (c >> 7) + 128 + (c & 127); }
    if (n < 2048) { const int c = (n - 1024) & 511, h = c >> 6, d = c & 63; return 256 * ((n < 1536 ? 4 : 6) + (h >> 2)) + 128 * (d >> 5) + (h & 3) * 32 + (d & 31); }
    return n; } };

__device__ __forceinline__ void sincos_d(double a, float& c, float& s) {
    const double TWO_PI = 6.283185307179586476925286766559, INV = 0.15915494309189533576888376337251;
    const double n = __builtin_rint(a * INV); double r = __builtin_fma(-n, TWO_PI, a); r = __builtin_fma(-n, 2.4492935982947064e-16, r) ;
    const double r2 = r * r; double sp = 0.0, cp = 0.0;
#pragma unroll
    for (int k = 13; k >= 1; --k) { sp = (sp + 1.0) * (r2 * (-1.0 / (double)((2 * k) * (2 * k + 1)))); cp = (cp + 1.0) * (r2 * (-1.0 / (double)((2 * k - 1) * (2 * k)))); }
    s = (float)(r * (1.0 + sp)); c = (float)(1.0 + cp);
}

constexpr int CV_I_IN = 16 * 40, CV_I_PW = 8 * 8, CV_I_OUT = 16 * 16, CV_I_E = 16 * 16;
constexpr int CV_NEXP = NEXP * 3 * CV_I_E, CV_NITEMS = CV_NEXP + CV_I_IN + CV_I_PW + CV_I_OUT;
constexpr int NCONVX = 4, NCONV = 8 * NCONVX, NWORK = 256 - NCONV;
#ifndef WD_P3_
#define WD_P3_ 1536
#endif
constexpr int WD_P3 = WD_P3_;
#ifndef P1_GT_
#define P1_GT_ 1280
#endif
constexpr int P1_GT = P1_GT_;
constexpr int P1_NG = 20;
#ifndef CV_NTAIL_
#define CV_NTAIL_ 6144
#endif
constexpr int CV_NTAIL = CV_NTAIL_;
#ifndef CV_S1_
#define CV_S1_ 5600
#define CV_S2_ 9400
#define CV_S3_ 11300
#endif
constexpr int CV_S1 = CV_S1_, CV_S2 = CV_S2_, CV_S3 = CV_S3_;
struct CvItem { const float* W; unsigned char* dst; int N, K, k0, n0, mode; };
__device__ __forceinline__ CvItem cv_decode(const Args& a, unsigned char* ws, int r) {
    CvItem c;
    if (r < CV_NEXP) {
        const int e = r / (3 * CV_I_E), q = r % (3 * CV_I_E), which = q / CV_I_E, t = q % CV_I_E; c.k0 = 64 * (t / 16); c.n0 = 64 * (t % 16); c.mode = which; c.N = DM; c.K = DM;
        if (which == 0) { c.W = (const float*)a.in[14] + (size_t)e * DM * DFF; c.dst = ws + WS_WGU + (size_t)e * 2048 * DM; }
        else if (which == 1) { c.W = (const float*)a.in[16] + (size_t)e * DM * DFF; c.dst = ws + WS_WGU + (size_t)e * 2048 * DM; }
        else { c.W = (const float*)a.in[18] + (size_t)e * DFF * DM; c.dst = ws + WS_WD + (size_t)e * DM * DFF; }
        return c; }
    r -= CV_NEXP;
    if (r < CV_I_IN) { c.W = (const float*)a.in[2]; c.dst = ws + WS_WIN; c.N = NPROJ; c.K = DM; c.k0 = 64 * (r / 40); c.n0 = 64 * (r % 40); c.mode = 3; return c; } r -= CV_I_IN;
    if (r < CV_I_PW) { c.W = (const float*)a.in[7]; c.dst = ws + WS_WPW; c.N = DCONV; c.K = DCONV; c.k0 = 64 * (r / 8); c.n0 = 64 * (r % 8); c.mode = 4; return c; } r -= CV_I_PW;
    c.W = (const float*)a.in[9]; c.dst = ws + WS_WOUT; c.N = DM; c.K = DM; c.k0 = 64 * (r / 16); c.n0 = 64 * (r % 16); c.mode = 5; return c;
}
__device__ __forceinline__ void cv_load(const CvItem& c, int lane, f32x4 (&v)[16]) {
    const int n4 = lane & 15, kr = lane >> 4;
#pragma unroll
    for (int i = 0; i < 16; ++i) v[i] = *(const GAS f32x4*)(c.W + (size_t)(c.k0 + kr + 4 * i) * c.N + c.n0 + 4 * n4);
}
__device__ __forceinline__ int cv_row(int mode, int n) {
    if (mode == 0) return 256 * (n >> 7) + (n & 127);
    if (mode == 1) return 128 + 256 * (n >> 7) + (n & 127);
    if (mode == 3) return MapInProj{}(n);
    return n;
}
template <int REMAP>
__device__ __forceinline__ int cv_remap(int j) { return REMAP == 1 ? (j >> 9) * 768 + (j & 511) : REMAP == 2 ? (j >> 8) * 768 + 512 + (j & 255) : j; }
template <int REMAP = 0>
__device__ __forceinline__ void convert_items(Frame& F, const Args& a, int first, int last, int wg, int NWG, int grp = 1) {
    const int lane = F.lane, p = F.wave & 3; const bool loader = F.wave < 4;
    const int stride = NWG * 4, base = first + wg * 4 + p;
    const int span = last - first - wg * 4; int nsteps = span <= 0 ? 0 : (span + stride - 1) / stride;
    if (grp == 2) { const int span1 = span - 4; nsteps += span1 <= 0 ? 0 : (span1 + stride - 1) / stride; }
    if (nsteps == 0) return;
#define CV_TILE(s_) (grp == 2 ? base + ((s_) >> 1) * stride + ((s_) & 1) * 4 : base + (s_) * stride)
    LAS float* slot0 = (LAS float*)(F.lds + (p * 2 + 0) * 16640); LAS float* slot1 = (LAS float*)(F.lds + (p * 2 + 1) * 16640);
    const int n4 = lane & 15, kr = lane >> 4;
    f32x4 vA[16], vB[16], vC[16]; CvItem cA, cB, cC; cA = cv_decode(a, F.ws, cv_remap<REMAP>(base < last ? base : first)); cB = cA; cC = cA; const int t1_ = CV_TILE(1), t2_ = CV_TILE(2);
    if (loader) { if (base < last) cv_load(cA, lane, vA); if (t1_ < last) { cB = cv_decode(a, F.ws, cv_remap<REMAP>(t1_)); cv_load(cB, lane, vB); }
                  if (t2_ < last) { cC = cv_decode(a, F.ws, cv_remap<REMAP>(t2_)); cv_load(cC, lane, vC); } }
#define CV_LOADER_STEP(vX, cX, slotX, s_) do { const int it_ = CV_TILE(s_), it3_ = CV_TILE((s_) + 3); if (it_ < last) { const float sc = cX.mode < 3 ? WSCALE8 : 1.0f; \
        _Pragma("unroll") for (int i = 0; i < 16; ++i) { LAS float* q_ = slotX + (kr + 4 * i) * 65 + 4 * n4; q_[0] = vX[i][0] * sc; q_[1] = vX[i][1] * sc; q_[2] = vX[i][2] * sc; q_[3] = vX[i][3] * sc; } \
        LDS_WAIT(); if (it3_ < last) { cX = cv_decode(a, F.ws, cv_remap<REMAP>(it3_)); cv_load(cX, lane, vX); } } } while (0)
#define CV_STORER_STEP(slotX, s_) do { const int it_ = CV_TILE(s_); if (it_ < last) { const CvItem cur = cv_decode(a, F.ws, cv_remap<REMAP>(it_)); \
        if (cur.mode < 3) { const int c = (lane & 1) + 2 * (lane >> 5), nn = (lane >> 1) & 15; \
            _Pragma("unroll") for (int q = 0; q < 4; ++q) { const int n = nn + 16 * q; const LAS float* s2 = slotX + (16 * c) * 65 + n; \
                u32x4 o; o.x = pk4_fp8(s2[0], s2[65], s2[2 * 65], s2[3 * 65]); o.y = pk4_fp8(s2[4 * 65], s2[5 * 65], s2[6 * 65], s2[7 * 65]); \
                o.z = pk4_fp8(s2[8 * 65], s2[9 * 65], s2[10 * 65], s2[11 * 65]); o.w = pk4_fp8(s2[12 * 65], s2[13 * 65], s2[14 * 65], s2[15 * 65]); \
                *(GAS u32x4*)(cur.dst + (size_t)cv_row(cur.mode, cur.n0 + n) * cur.K + cur.k0 + 16 * c) = o; } \
        } else { const int c = (lane & 3) + 4 * (lane >> 5), nn = (lane >> 2) & 7; \
            _Pragma("unroll") for (int q = 0; q < 8; ++q) { const int n = nn + 8 * q; const LAS float* s2 = slotX + (8 * c) * 65 + n; \
                u32x4 o; o.x = cvtpk(s2[0], s2[65]); o.y = cvtpk(s2[2 * 65], s2[3 * 65]); o.z = cvtpk(s2[4 * 65], s2[5 * 65]); o.w = cvtpk(s2[6 * 65], s2[7 * 65]); \
                *(GAS u32x4*)((bf16_t*)cur.dst + (size_t)cv_row(cur.mode, cur.n0 + n) * cur.K + cur.k0 + 8 * c) = o; } } \
        LDS_WAIT(); } } while (0)
#define CV_BAR() do { asm volatile("s_waitcnt lgkmcnt(0)" ::: "memory"); __builtin_amdgcn_s_barrier(); asm volatile("" ::: "memory"); } while (0)
    if (loader) {
        for (int s_ = 0; s_ < nsteps; s_ += 6) {
            CV_LOADER_STEP(vA, cA, slot0, s_); CV_BAR();
            if (s_ + 1 < nsteps) { CV_LOADER_STEP(vB, cB, slot1, s_ + 1); CV_BAR(); }
            if (s_ + 2 < nsteps) { CV_LOADER_STEP(vC, cC, slot0, s_ + 2); CV_BAR(); }
            if (s_ + 3 < nsteps) { CV_LOADER_STEP(vA, cA, slot1, s_ + 3); CV_BAR(); }
            if (s_ + 4 < nsteps) { CV_LOADER_STEP(vB, cB, slot0, s_ + 4); CV_BAR(); }
            if (s_ + 5 < nsteps) { CV_LOADER_STEP(vC, cC, slot1, s_ + 5); CV_BAR(); }
        }
    } else {
        for (int s_ = 0; s_ < nsteps; s_ += 2) {
            CV_BAR(); CV_STORER_STEP(slot0, s_);
            if (s_ + 1 < nsteps) { CV_BAR(); CV_STORER_STEP(slot1, s_ + 1); }
        }
    }
    CV_BAR();
#undef CV_LOADER_STEP
#undef CV_TILE
#undef CV_STORER_STEP
#undef CV_BAR
}
__device__ __forceinline__ void p0_prologue(Frame& F, const Args& a) {
    const int gw = F.vcu * 8 + F.wave, NGW = F.G * 8;
    const float* x = (const float*)a.in[0]; bf16_t* XB = (bf16_t*)(F.ws + WS_XB);
    const int* pos = (const int*)a.in[1]; float* rope = (float*)(F.ws + WS_ROPE);
    for (int m0 = gw; m0 < NTOK; m0 += 8 * NGW) {
        f32x4 v[8][4];
#pragma unroll
        for (int k = 0; k < 8; ++k) { const int m = m0 + k * NGW; if (m < NTOK) {
#pragma unroll
            for (int j = 0; j < 4; ++j) v[k][j] = ((const GAS f32x4*)(x + (size_t)m * DM) + F.lane)[64 * j]; } }
        if (m0 == gw) {
            const int i = F.tid & 31;
            double inv_freq = 1.0;
            for (int q = 0; q < i; ++q) inv_freq *= 0.7498942093324558;
            for (int idx = (F.vcu * 512 + F.tid); idx < NTOK * 32; idx += F.G * 512) {
                float c, s_; sincos_d((double)pos[idx >> 5] * inv_freq, c, s_);
                rope[idx] = c; rope[NTOK * 32 + idx] = s_;
            }
            const float* rw = (const float*)a.in[12]; bf16_t* WrT = (bf16_t*)(F.ws + WS_WRT);
            for (int idx = F.vcu * 512 + F.tid; idx < NEXP * DM; idx += F.G * 512) { const int e = idx >> 10, k = idx & 1023; const float wv = rw[k * NEXP + e]; const unsigned hb = cvtpk(wv, 0.f) & 0xffffu;
                WrT[idx] = (bf16_t)hb; WrT[NEXP * DM + idx] = (bf16_t)(cvtpk(wv - bf2f((bf16_t)hb), 0.f) & 0xffffu); }
        }
#pragma unroll
        for (int k = 0; k < 8; ++k) { const int m = m0 + k * NGW; if (m < NTOK) { GAS u32x2* o = (GAS u32x2*)(XB + (size_t)m * DM) + F.lane;
#pragma unroll
            for (int j = 0; j < 4; ++j) { u32x2 w; w.x = cvtpk(v[k][j][0], v[k][j][1]); w.y = cvtpk(v[k][j][2], v[k][j][3]); o[64 * j] = w; } } }
    }
    convert_items(F, a, F.G == 256 ? CV_NEXP : 0, CV_NITEMS, F.vcu, F.G);
}

namespace att {
constexpr int L_K = 0, L_V = 49152, L_WS = 98304, L_OST = L_WS + 8 * 256, L_END = L_OST + 8 * 4096;
__device__ __forceinline__ int crow(int r, int hi) { return (r & 3) + 8 * (r >> 2) + 4 * hi; }
__device__ __forceinline__ s16x4 vtr(const LAS char* p) { typedef short v4i16_t __attribute__((ext_vector_type(4))); return __builtin_bit_cast(s16x4, __builtin_amdgcn_ds_read_tr16_b64_v4i16((LAS v4i16_t*)p)); }
__device__ __forceinline__ void attn_unit(int b, int h, int br, int blk, const bf16_t* Q, const bf16_t* K, const bf16_t* V, bf16_t* OB, float* LSE, LAS unsigned char* lds) {
    const int tid = threadIdx.x, lane = tid & 63, r32 = lane & 31, hi = lane >> 5; const int wid = __builtin_amdgcn_readfirstlane(tid >> 6);
    const int d = 1 << (2 * br), per = 32 >> (2 * br), res = blk / per, i0 = 256 * (blk % per), kbase = i0 - 128;
    const int rowbase = b * SEQ + res;
#pragma unroll
    for (int T = 0; T < 6; ++T) {
        int sp = kbase + 64 * T + lane; sp = sp < 0 ? 0 : sp;
        const bf16_t* ks = K + (size_t)(rowbase + d * sp) * DATT + h * 64 + wid * 8;
        __builtin_amdgcn_global_load_lds((const unsigned*)ks, (LAS unsigned*)(lds + L_K + T * 8192 + wid * 1024), 16, 0, 0);
        int sv = kbase + 64 * T + 16 * (wid & 3) + (lane >> 2); sv = sv < 0 ? 0 : sv;
        const bf16_t* vs = V + (size_t)(rowbase + d * sv) * DATT + h * 64 + (wid >> 2) * 32 + (lane & 3) * 8;
        __builtin_amdgcn_global_load_lds((const unsigned*)vs, (LAS unsigned*)(lds + L_V + T * 8192 + wid * 1024), 16, 0, 0);
    }
    const int qsub = i0 + 32 * wid;
    const size_t qtok = (size_t)(rowbase + d * (qsub + r32));
    bf16x8 qr[4];
#pragma unroll
    for (int d0 = 0; d0 < 4; ++d0) qr[d0] = *(const bf16x8*)(Q + qtok * DATT + h * 64 + d0 * 16 + hi * 8);
    asm volatile("s_waitcnt vmcnt(0)" ::: "memory");
    __syncthreads();
    const int jmin = (i0 == 0) ? ((4 - wid) > 0 ? (4 - wid) : 0) : 0;
    f32x16 s[5];
    const float NEG = -INFINITY;
#pragma unroll
    for (int j = 0; j < 5; ++j) {
        if (j >= jmin) {
            const int tt = wid + j, T = tt >> 1, sub = tt & 1;
            const LAS unsigned char* kb = lds + L_K + T * 8192 + hi * 1024 + (32 * sub + r32) * 16;
            f32x16 acc = {};
#pragma unroll
            for (int d0 = 0; d0 < 4; ++d0) { const bf16x8 kf = *(const LAS bf16x8*)(kb + d0 * 2048); acc = __builtin_amdgcn_mfma_f32_32x32x16_bf16(kf, qr[d0], acc, 0, 0, 0); }
            if (j == 0) {
#pragma unroll
                for (int r = 0; r < 16; ++r) if (crow(r, hi) < r32) acc[r] = NEG;
            }
            if (j == 4) {
#pragma unroll
                for (int r = 0; r < 16; ++r) if (crow(r, hi) > r32) acc[r] = NEG;
            }
            s[j] = acc;
        } else {
#pragma unroll
            for (int r = 0; r < 16; ++r) s[j][r] = NEG;
        }
    }
    float m = NEG;
#pragma unroll
    for (int j = 0; j < 5; ++j)
#pragma unroll
        for (int r = 0; r < 16; ++r) m = fmaxf(m, s[j][r]);
    m = fmaxf(m, __shfl_xor(m, 32));
    float l = 0.f;
#pragma unroll
    for (int j = 0; j < 5; ++j)
#pragma unroll
        for (int r = 0; r < 16; ++r) { const float p = __builtin_amdgcn_exp2f(s[j][r] - m); s[j][r] = p; l += p; }
    l += __shfl_xor(l, 32);
    f32x16 o[2]; o[0] = f32x16{}; o[1] = f32x16{};
#pragma unroll
    for (int j = 0; j < 5; ++j) {
        if (j >= jmin) {
            const int tt = wid + j, T = tt >> 1, sub = tt & 1;
            const LAS char* vb = (const LAS char*)lds + L_V + T * 8192 + ((lane >> 4) & 1) * 32 + (lane & 3) * 8 + (32 * sub + 4 * hi + ((lane & 15) >> 2)) * 64;
#pragma unroll
            for (int ks = 0; ks < 2; ++ks) {
                u32x4 pw; pw.x = cvtpk(s[j][8 * ks + 0], s[j][8 * ks + 1]); pw.y = cvtpk(s[j][8 * ks + 2], s[j][8 * ks + 3]); pw.z = cvtpk(s[j][8 * ks + 4], s[j][8 * ks + 5]); pw.w = cvtpk(s[j][8 * ks + 6], s[j][8 * ks + 7]);
                const bf16x8 pa = __builtin_bit_cast(bf16x8, pw);
#pragma unroll
                for (int dh = 0; dh < 2; ++dh) {
                    const s16x4 lo = vtr(vb + dh * 4096 + ks * 1024), hi4 = vtr(vb + dh * 4096 + ks * 1024 + 512);
                    const bf16x8 vf = (bf16x8){lo[0], lo[1], lo[2], lo[3], hi4[0], hi4[1], hi4[2], hi4[3]};
                    o[dh] = __builtin_amdgcn_mfma_f32_32x32x16_bf16(pa, vf, o[dh], 0, 0, 0);
                }
            }
        }
    }
    LAS float* wsf = (LAS float*)(lds + L_WS) + wid * 64;
    if (hi == 0) wsf[r32] = __builtin_amdgcn_rcpf(l);
    LDS_WAIT(); asm volatile("" ::: "memory");
    LAS bf16_t* stg = (LAS bf16_t*)(lds + L_OST) + wid * 2048;
#pragma unroll
    for (int r = 0; r < 16; ++r) { const int orow = crow(r, hi); const float rl = wsf[orow];
#pragma unroll
        for (int dh = 0; dh < 2; ++dh) stg[orow * 64 + dh * 32 + r32] = (bf16_t)(cvtpk(o[dh][r] * rl, 0.f) & 0xffffu); }
    LDS_WAIT(); asm volatile("" ::: "memory");
    bf16_t* Ob = OB + (size_t)br * NTOK * DATT;
#pragma unroll
    for (int i = 0; i < 4; ++i) { const int row = i * 8 + (lane >> 3), ch = lane & 7; const u32x4 v = *(const LAS u32x4*)(stg + row * 64 + ch * 8);
        st16_wt(Ob + (size_t)(rowbase + d * (qsub + row)) * DATT + h * 64 + ch * 8, v); }
    if (hi == 0) LSE[((size_t)br * NTOK + qtok) * 8 + h] = m + __builtin_amdgcn_logf(l);
    __syncthreads();
}
struct UnitGeo { int rowbase, d, i0, h, br; };
__device__ __forceinline__ UnitGeo unit_geo(int j_in_xcd, int xcd) {
    const int bh = 2 * xcd + j_in_xcd / 96, jj = j_in_xcd % 96, br = jj >> 5, blk = jj & 31;
    UnitGeo g; g.br = br; g.h = bh & 7; g.d = 1 << (2 * br); const int per = 32 >> (2 * br); g.rowbase = (bh >> 3) * SEQ + blk / per; g.i0 = 256 * (blk % per); return g;
}
__device__ __forceinline__ void glds16(const void* gsrc, unsigned lds_dst) { unsigned keep;
    asm volatile("s_mov_b32 %0, m0\n\ts_mov_b32 m0, %2\n\ts_nop 0\n\tglobal_load_lds_dwordx4 %1, off\n\ts_mov_b32 m0, %0" : "=&s"(keep) : "v"(gsrc), "s"(lds_dst) : "memory"); }
__device__ __forceinline__ void dma_k(const UnitGeo& g, const bf16_t* K, unsigned ldsb, int wid, int lane) {
#pragma unroll
    for (int T = 0; T < 6; ++T) { int sp = g.i0 - 128 + 64 * T + lane; sp = sp < 0 ? 0 : sp;
        glds16(K + (size_t)(g.rowbase + g.d * sp) * DATT + g.h * 64 + wid * 8, (unsigned)__builtin_amdgcn_readfirstlane((int)(ldsb + L_K + T * 8192 + wid * 1024))); }
}
__device__ __forceinline__ void dma_v(const UnitGeo& g, const bf16_t* V, unsigned ldsb, int wid, int lane) {
#pragma unroll
    for (int T = 0; T < 6; ++T) { int sv = g.i0 - 128 + 64 * T + 16 * (wid & 3) + (lane >> 2); sv = sv < 0 ? 0 : sv;
        glds16(V + (size_t)(g.rowbase + g.d * sv) * DATT + g.h * 64 + (wid >> 2) * 32 + (lane & 3) * 8, (unsigned)__builtin_amdgcn_readfirstlane((int)(ldsb + L_V + T * 8192 + wid * 1024))); }
}
__device__ __forceinline__ void load_q(const UnitGeo& g, const bf16_t* Q, int wid, int r32, int hi, bf16x8 (&qr)[4]) {
    const bf16_t* qp = Q + (size_t)(g.rowbase + g.d * (g.i0 + 32 * wid + r32)) * DATT + g.h * 64 + hi * 8;
#pragma unroll
    for (int d0 = 0; d0 < 4; ++d0) asm volatile("global_load_dwordx4 %0, %1, off offset:%c2" : "=v"(qr[d0]) : "v"(qp), "i"(d0 * 32) : "memory");
}
__device__ __forceinline__ void attn_units(int j0, int jstep, int xcd, const bf16_t* Q, const bf16_t* K, const bf16_t* V, bf16_t* OB, float* LSE, LAS unsigned char* lds) {
    const int tid = threadIdx.x, lane = tid & 63, r32 = lane & 31, hi = lane >> 5; const int wid = __builtin_amdgcn_readfirstlane(tid >> 6);
    const unsigned ldsb = (unsigned)(size_t)lds;
    if (j0 >= 192) return;
    UnitGeo g = unit_geo(j0, xcd);
    bf16x8 qr[4];
    asm volatile("s_waitcnt vmcnt(0) lgkmcnt(0)" ::: "memory");
    dma_k(g, K, ldsb, wid, lane); load_q(g, Q, wid, r32, hi, qr);
    for (int j = j0; j < 192; j += jstep) {
        const int d = g.d, i0 = g.i0, h = g.h, br = g.br, rowbase = g.rowbase;
        dma_v(g, V, ldsb, wid, lane);
        asm volatile("s_waitcnt vmcnt(6)" : "+v"(qr[0]), "+v"(qr[1]), "+v"(qr[2]), "+v"(qr[3]) :: "memory");
        __builtin_amdgcn_s_barrier(); asm volatile("" ::: "memory");
        const int qsub = i0 + 32 * wid; const size_t qtok = (size_t)(rowbase + d * (qsub + r32));
        const int jmin = (i0 == 0) ? ((4 - wid) > 0 ? (4 - wid) : 0) : 0;
        f32x16 s[5]; const float NEG = -INFINITY;
#pragma unroll
        for (int t5 = 0; t5 < 5; ++t5) {
            const int tt = wid + t5, T = tt >> 1, sub = tt & 1;
            const LAS unsigned char* kb = lds + L_K + T * 8192 + hi * 1024 + (32 * sub + r32) * 16;
            bf16x8 kf[4];
#pragma unroll
            for (int d0 = 0; d0 < 4; ++d0) kf[d0] = *(const LAS bf16x8*)(kb + d0 * 2048);
            const float tbias = (t5 >= jmin) ? 0.f : NEG;
            f32x16 acc;
#pragma unroll
            for (int r = 0; r < 16; ++r) acc[r] = tbias;
#pragma unroll
            for (int d0 = 0; d0 < 4; ++d0) acc = __builtin_amdgcn_mfma_f32_32x32x16_bf16(kf[d0], qr[d0], acc, 0, 0, 0);
            if (t5 == 0) {
#pragma unroll
                for (int r = 0; r < 16; ++r) acc[r] = (crow(r, hi) < r32) ? NEG : acc[r];
            }
            if (t5 == 4) {
#pragma unroll
                for (int r = 0; r < 16; ++r) acc[r] = (crow(r, hi) > r32) ? NEG : acc[r];
            }
            s[t5] = acc;
        }
        float m = NEG;
#pragma unroll
        for (int t5 = 0; t5 < 5; ++t5)
#pragma unroll
            for (int r = 0; r < 16; ++r) m = fmaxf(m, s[t5][r]);
        m = fmaxf(m, __shfl_xor(m, 32));
        float l = 0.f;
#pragma unroll
        for (int t5 = 0; t5 < 5; ++t5)
#pragma unroll
            for (int r = 0; r < 16; ++r) { const float p = __builtin_amdgcn_exp2f(s[t5][r] - m); s[t5][r] = p; l += p; }
        l += __shfl_xor(l, 32);
        asm volatile("s_waitcnt vmcnt(0) lgkmcnt(0)" ::: "memory");
        __builtin_amdgcn_s_barrier(); asm volatile("" ::: "memory");
        const bool more = (j + jstep) < 192;
        UnitGeo gn = g;
        if (more) { gn = unit_geo(j + jstep, xcd); dma_k(gn, K, ldsb, wid, lane); load_q(gn, Q, wid, r32, hi, qr); }
        f32x16 o[2]; o[0] = f32x16{}; o[1] = f32x16{};
#pragma unroll
        for (int t5 = 0; t5 < 5; ++t5) {
            const int tt = wid + t5, T = tt >> 1, sub = tt & 1;
            const LAS char* vb = (const LAS char*)lds + L_V + T * 8192 + ((lane >> 4) & 1) * 32 + (lane & 3) * 8 + (32 * sub + 4 * hi + ((lane & 15) >> 2)) * 64;
            s16x4 lo[2][2], hi4[2][2];
#pragma unroll
            for (int ks = 0; ks < 2; ++ks)
#pragma unroll
                for (int dh = 0; dh < 2; ++dh) { lo[ks][dh] = vtr(vb + dh * 4096 + ks * 1024); hi4[ks][dh] = vtr(vb + dh * 4096 + ks * 1024 + 512); }
#pragma unroll
            for (int ks = 0; ks < 2; ++ks) {
                u32x4 pw; pw.x = cvtpk(s[t5][8 * ks + 0], s[t5][8 * ks + 1]); pw.y = cvtpk(s[t5][8 * ks + 2], s[t5][8 * ks + 3]); pw.z = cvtpk(s[t5][8 * ks + 4], s[t5][8 * ks + 5]); pw.w = cvtpk(s[t5][8 * ks + 6], s[t5][8 * ks + 7]);
                const bf16x8 pa = __builtin_bit_cast(bf16x8, pw);
#pragma unroll
                for (int dh = 0; dh < 2; ++dh) {
                    const bf16x8 vf = (bf16x8){lo[ks][dh][0], lo[ks][dh][1], lo[ks][dh][2], lo[ks][dh][3], hi4[ks][dh][0], hi4[ks][dh][1], hi4[ks][dh][2], hi4[ks][dh][3]};
                    o[dh] = __builtin_amdgcn_mfma_f32_32x32x16_bf16(pa, vf, o[dh], 0, 0, 0);
                }
            }
        }
        LAS float* wsf = (LAS float*)(lds + L_WS) + wid * 64;
        if (hi == 0) wsf[r32] = __builtin_amdgcn_rcpf(l);
        LDS_WAIT(); asm volatile("" ::: "memory");
        LAS bf16_t* stg = (LAS bf16_t*)(lds + L_OST) + wid * 2048;
#pragma unroll
        for (int r = 0; r < 16; ++r) { const int orow = crow(r, hi); const float rl = wsf[orow];
#pragma unroll
            for (int dh = 0; dh < 2; ++dh) stg[orow * 64 + dh * 32 + r32] = (bf16_t)(cvtpk(o[dh][r] * rl, 0.f) & 0xffffu); }
        LDS_WAIT(); asm volatile("" ::: "memory");
        bf16_t* Ob = OB + (size_t)br * NTOK * DATT;
#pragma unroll
        for (int i = 0; i < 4; ++i) { const int row = i * 8 + (lane >> 3), ch = lane & 7; const u32x4 v = *(const LAS u32x4*)(stg + row * 64 + ch * 8);
            st16_wt(Ob + (size_t)(rowbase + d * (qsub + row)) * DATT + h * 64 + ch * 8, v); }
        if (hi == 0) LSE[((size_t)br * NTOK + qtok) * 8 + h] = m + __builtin_amdgcn_logf(l);
        asm volatile("s_waitcnt lgkmcnt(0)" ::: "memory");
        __builtin_amdgcn_s_barrier(); asm volatile("" ::: "memory");
        g = gn;
    }
    asm volatile("s_waitcnt vmcnt(0)" ::: "memory");
}
}

__device__ __forceinline__ void conv_item(int item, const bf16_t* U, const float* cw, const float* cb, const float* lng, const float* lnb, bf16_t* S, LAS unsigned char* lds, int wave, int lane) {
    const int c = threadIdx.x, t0 = item * 64;
    LAS bf16_t* UT = (LAS bf16_t*)lds;
    LAS float* CT = (LAS float*)(lds + 32768);
    float w[31], x[62];
#pragma unroll
    for (int j = 0; j < 31; ++j) w[j] = cw[j * DCONV + c];
    const float bias = cb[c];
    const bool hist = (t0 % SEQ) != 0;
    const f32x4 g0 = *(const f32x4*)(lng + 8 * lane), g1 = *(const f32x4*)(lng + 8 * lane + 4), b0 = *(const f32x4*)(lnb + 8 * lane), b1 = *(const f32x4*)(lnb + 8 * lane + 4);
    u32x4 pre[4];
#define CV_ISSUE(tb) do { const int tb_ = (tb) < 0 ? 0 : (tb); _Pragma("unroll") for (int q = 0; q < 4; ++q) { const int idx = c + 512 * q; pre[q] = *(const u32x4*)(U + (size_t)(tb_ + (idx >> 6)) * DCONV + (idx & 63) * 8); } } while (0)
#define CV_WRITE() do { _Pragma("unroll") for (int q = 0; q < 4; ++q) { const int idx = c + 512 * q; *(LAS u32x4*)(UT + (idx >> 6) * DCONV + (idx & 63) * 8) = pre[q]; } } while (0)
    CV_ISSUE(t0 - 32);
    CV_WRITE();
    CV_ISSUE(t0);
    __syncthreads();
#pragma unroll
    for (int j = 0; j < 30; ++j) { const float v = bf2f(UT[(2 + j) * DCONV + c]); x[j] = hist ? v : 0.f; }
    for (int ch = 0; ch < 2; ++ch) {
        __syncthreads();
        CV_WRITE();
        if (ch == 0) CV_ISSUE(t0 + 32);
        __syncthreads();
#pragma unroll
        for (int j = 0; j < 32; ++j) x[30 + j] = bf2f(UT[j * DCONV + c]);
#pragma unroll
        for (int tt = 0; tt < 32; ++tt) { float y = bias;
#pragma unroll
            for (int j = 0; j < 31; ++j) y = __builtin_fmaf(w[j], x[tt + j], y);
            CT[tt * DCONV + c] = y; }
#pragma unroll
        for (int j = 0; j < 30; ++j) x[j] = x[32 + j];
        __syncthreads();
#pragma unroll
        for (int q = 0; q < 4; ++q) { const int tt = wave + 8 * q;
            const f32x4 v0 = *(const LAS f32x4*)(CT + tt * DCONV + 8 * lane), v1 = *(const LAS f32x4*)(CT + tt * DCONV + 8 * lane + 4);
            const float mean = wave_sum((v0[0] + v0[1]) + (v0[2] + v0[3]) + (v1[0] + v1[1]) + (v1[2] + v1[3])) * (1.f / DCONV);
            const f32x4 d0 = v0 - mean, d1 = v1 - mean;
            const float var = wave_sum((d0[0] * d0[0] + d0[1] * d0[1]) + (d0[2] * d0[2] + d0[3] * d0[3]) + (d1[0] * d1[0] + d1[1] * d1[1]) + (d1[2] * d1[2] + d1[3] * d1[3])) * (1.f / DCONV);
            const float rstd = 1.0f / sqrtf(var + LN_EPS);
            f32x4 y0 = d0 * rstd * g0 + b0, y1 = d1 * rstd * g1 + b1;
#pragma unroll
            for (int i = 0; i < 4; ++i) { y0[i] = y0[i] * fsigmoid(y0[i]); y1[i] = y1[i] * fsigmoid(y1[i]); }
            st16_wt(S + (size_t)(t0 + 32 * ch + tt) * DCONV + 8 * lane, pg8::pack8(y0, y1)); }
    }
    __syncthreads();
#undef CV_ISSUE
#undef CV_WRITE
}

__device__ __forceinline__ void combine_tokens(Frame& F, const bf16_t* OB, const float* LSE, bf16_t* AO, int gw, int NGW) {
    const int h = F.lane >> 3;
    for (int tok0 = gw * 4; tok0 < NTOK; tok0 += NGW * 4) {
        float ls[4][3]; u32x4 v[4][3];
#pragma unroll
        for (int t = 0; t < 4; ++t)
#pragma unroll
            for (int br = 0; br < 3; ++br) { ls[t][br] = LSE[((size_t)br * NTOK + tok0 + t) * 8 + h]; v[t][br] = *(const u32x4*)(OB + ((size_t)br * NTOK + tok0 + t) * DATT + 8 * F.lane); }
#pragma unroll
        for (int t = 0; t < 4; ++t) {
            const float mx = fmaxf(ls[t][0], fmaxf(ls[t][1], ls[t][2]));
            float wt[3]; float sum = 0.f;
#pragma unroll
            for (int br = 0; br < 3; ++br) { wt[br] = __builtin_amdgcn_exp2f(ls[t][br] - mx); sum += wt[br]; }
            const float rs = 1.0f / sum;
            f32x4 a0 = {0.f, 0.f, 0.f, 0.f}, a1 = {0.f, 0.f, 0.f, 0.f};
#pragma unroll
            for (int br = 0; br < 3; ++br) { const float wv = wt[br] * rs; const u32x4 q = v[t][br];
                a0[0] += wv * bflo(q.x); a0[1] += wv * bfhi(q.x); a0[2] += wv * bflo(q.y); a0[3] += wv * bfhi(q.y);
                a1[0] += wv * bflo(q.z); a1[1] += wv * bfhi(q.z); a1[2] += wv * bflo(q.w); a1[3] += wv * bfhi(q.w); }
            st16_wt(AO + (size_t)(tok0 + t) * DM + DCONV + 8 * F.lane, pg8::pack8(a0, a1));
        }
    }
}

constexpr int RT_X = 0, RT_XP = 2064;
constexpr int RT_LCNT = 147456, RT_BASE = RT_LCNT + 128, RT_TE = RT_BASE + 128, RT_TG = RT_TE + 1024, RT_END = RT_TG + 1024;
static_assert(64 * RT_XP <= RT_LCNT && 8 * 32 * 33 * 4 <= 64 * RT_XP, "route LDS map");
__device__ __forceinline__ void route_phase(Frame& F, const Args& a) {
    volatile LAS int* lcnt = (volatile LAS int*)(F.lds + RT_LCNT); volatile LAS int* lbase = (volatile LAS int*)(F.lds + RT_BASE);
    volatile LAS int* te = (volatile LAS int*)(F.lds + RT_TE); volatile LAS float* tg = (volatile LAS float*)(F.lds + RT_TG);
    const float* rb = (const float*)a.in[13]; const float* g1 = (const float*)a.in[10]; const float* b1 = (const float*)a.in[11];
    const bf16_t* MIXb = (const bf16_t*)(F.ws + WS_Z); const float* Xin = (const float*)a.in[0]; bf16_t* X1B = (bf16_t*)(F.ws + WS_X1B); unsigned char* X18 = F.ws + WS_X1F8;
    const bf16_t* WrT = (const bf16_t*)(F.ws + WS_WRT);
    int* TOKE = (int*)(F.ws + WS_TOKE); float* TOKG = (float*)(F.ws + WS_TOKG); int* LIST = (int*)(F.ws + WS_LIST);
    const int r32 = F.lane & 31, hi = F.lane >> 5;
    f32x4 gv[4], bv[4];
#pragma unroll
    for (int j = 0; j < 4; ++j) { gv[j] = *(const f32x4*)(g1 + 4 * F.lane + 256 * j); bv[j] = *(const f32x4*)(b1 + 4 * F.lane + 256 * j); }
    for (int tb = F.vcu; tb < NTOK / 64; tb += F.G) {
        if (F.tid < 32) lcnt[F.tid] = 0;
        for (int it = 0; it < 8; ++it) {
            const int tl = F.wave * 8 + it, tok = tb * 64 + tl;
            f32x4 xv[4]; float sum = 0.f;
#pragma unroll
            for (int j = 0; j < 4; ++j) { const u32x2 mx = *(const u32x2*)(MIXb + (size_t)tok * DM + 4 * F.lane + 256 * j);
                xv[j] = *(const f32x4*)(Xin + (size_t)tok * DM + 4 * F.lane + 256 * j) * DN_ALPHA + (f32x4){bflo(mx.x), bfhi(mx.x), bflo(mx.y), bfhi(mx.y)}; sum += (xv[j][0] + xv[j][1]) + (xv[j][2] + xv[j][3]); }
            const float mean = wave_sum(sum) * (1.f / DM); float sq = 0.f;
#pragma unroll
            for (int j = 0; j < 4; ++j) { xv[j] = xv[j] - mean; sq += (xv[j][0] * xv[j][0] + xv[j][1] * xv[j][1]) + (xv[j][2] * xv[j][2] + xv[j][3] * xv[j][3]); }
            const float rstd = 1.0f / sqrtf(wave_sum(sq) * (1.f / DM) + LN_EPS);
#pragma unroll
            for (int j = 0; j < 4; ++j) { xv[j] = xv[j] * rstd * gv[j] + bv[j];
                u32x2 w; w.x = cvtpk(xv[j][0], xv[j][1]); w.y = cvtpk(xv[j][2], xv[j][3]); *(u32x2*)(X1B + (size_t)tok * DM + 4 * F.lane + 256 * j) = w;
                *(LAS u32x2*)(F.lds + RT_X + tl * RT_XP + (4 * F.lane + 256 * j) * 2) = w;
                *(unsigned*)(X18 + (size_t)tok * DM + 4 * F.lane + 256 * j) = pk4_fp8(xv[j][0], xv[j][1], xv[j][2], xv[j][3]); }
        }
        __syncthreads();
        const int mb = F.wave & 1, kq = F.wave >> 1;
        f32x16 acc = {};
        {
            bf16x8 bfr[16], bfl[16];
#pragma unroll
            for (int s_ = 0; s_ < 16; ++s_) { bfr[s_] = *(const bf16x8*)(WrT + (size_t)r32 * DM + 16 * (kq * 16 + s_) + 8 * hi); bfl[s_] = *(const bf16x8*)(WrT + (size_t)NEXP * DM + (size_t)r32 * DM + 16 * (kq * 16 + s_) + 8 * hi); }
#pragma unroll
            for (int s_ = 0; s_ < 16; ++s_) { const bf16x8 af = *(const LAS bf16x8*)(F.lds + RT_X + (32 * mb + r32) * RT_XP + (16 * (kq * 16 + s_) + 8 * hi) * 2);
                acc = __builtin_amdgcn_mfma_f32_32x32x16_bf16(af, bfr[s_], acc, 0, 0, 0); acc = __builtin_amdgcn_mfma_f32_32x32x16_bf16(af, bfl[s_], acc, 0, 0, 0); }
        }
        __syncthreads();
        {
            LAS float* P = (LAS float*)(F.lds + RT_X) + (size_t)(mb * 4 + kq) * 32 * 33;
#pragma unroll
            for (int r = 0; r < 16; ++r) P[((r & 3) + 8 * (r >> 2) + 4 * hi) * 33 + r32] = acc[r];
        }
        __syncthreads();
        if (F.wave == 0) {
            const LAS float* P = (const LAS float*)(F.lds + RT_X) + (size_t)((F.lane >> 5) * 4) * 32 * 33 + (F.lane & 31) * 33;
            float l[32];
#pragma unroll
            for (int e = 0; e < 32; ++e) l[e] = ((P[e] + P[32 * 33 + e]) + (P[2 * 32 * 33 + e] + P[3 * 32 * 33 + e])) + rb[e];
            float tv[4]; int ti[4];
#pragma unroll
            for (int k = 0; k < 4; ++k) { float best = l[0]; int bi = 0;
#pragma unroll
                for (int e = 1; e < 32; ++e) { const bool gt = l[e] > best; best = gt ? l[e] : best; bi = gt ? e : bi; }
                tv[k] = best; ti[k] = bi;
#pragma unroll
                for (int e = 0; e < 32; ++e) l[e] = (e == bi) ? -INFINITY : l[e]; }
            float ex[4], es = 0.f;
#pragma unroll
            for (int k = 0; k < 4; ++k) { ex[k] = __builtin_amdgcn_exp2f((tv[k] - tv[0]) * 1.4426950408889634f); es += ex[k]; }
            const float ies = 1.0f / es;
#pragma unroll
            for (int k = 0; k < 4; ++k) { const int lr = __hip_atomic_fetch_add((LAS int*)(F.lds + RT_LCNT) + ti[k], 1, __ATOMIC_RELAXED, __HIP_MEMORY_SCOPE_WORKGROUP);
                te[F.lane * 4 + k] = ti[k] | (lr << 5); tg[F.lane * 4 + k] = ex[k] * ies; }
        }
        __syncthreads();
        if (F.tid < 32) lbase[F.tid] = (int)__hip_atomic_fetch_add((unsigned*)(F.ctl + CW_GCNT + 64 * F.tid), (unsigned)lcnt[F.tid], RLX_AGENT);
        __syncthreads();
        if (F.tid < 256) { const int tl = F.tid >> 2, k = F.tid & 3, tok = tb * 64 + tl; const int w = te[tl * 4 + k], e = w & 31, rank = lbase[e] + (w >> 5);
            LIST[e * NTOK + rank] = tok; TOKE[tok * 4 + k] = e | (rank << 5); TOKG[tok * 4 + k] = tg[tl * 4 + k]; }
        __syncthreads();
    }
}
__device__ __forceinline__ void moe_prefix(Frame& F) {
    if (F.tid < 64) {
        const int c = (F.lane < 32) ? (int)__hip_atomic_load(F.ctl + CW_GCNT + 64 * (F.lane & 31), RLX_AGENT) : 0;
        const int t = (c + 255) >> 8; int incl = t;
#pragma unroll
        for (int o = 1; o < 32; o <<= 1) { const int y = __shfl_up(incl, o); if (F.lane >= o) incl += y; }
        if (F.lane < 32) { F.MISC[80 + F.lane] = (unsigned)c; F.MISC[32 + F.lane] = (unsigned)(incl - t); }
        if (F.lane == 31) F.MISC[64] = (unsigned)incl;
    }
    __syncthreads();
}

__device__ __forceinline__ void final_phase(Frame& F, const Args& a) {
    const int gw = F.vcu * 8 + F.wave, NGW = F.G * 8;
    const bf16_t* X1B = (const bf16_t*)(F.ws + WS_X1B); const unsigned char* Y = F.ws + WS_Y;
    const int* TOKE = (const int*)(F.ws + WS_TOKE); const float* TOKG = (const float*)(F.ws + WS_TOKG);
    const float* g2 = (const float*)a.in[20]; const float* b2 = (const float*)a.in[21];
    f32x4 gv[4], bv[4];
#pragma unroll
    for (int j = 0; j < 4; ++j) { gv[j] = *(const f32x4*)(g2 + 4 * F.lane + 256 * j); bv[j] = *(const f32x4*)(b2 + 4 * F.lane + 256 * j); }
    typedef int i32x4 __attribute__((ext_vector_type(4)));
    unsigned yn[4][4]; u32x2 xn[4]; f32x4 gn = {0.f, 0.f, 0.f, 0.f}; i32x4 inn = {0, 0, 0, 0}; f32x4 gnn = {0.f, 0.f, 0.f, 0.f};
#define FP_ROWS(tok_, iw_) do { _Pragma("unroll") for (int k = 0; k < 4; ++k) { const int w_ = (iw_)[k]; const size_t slot = (size_t)F.MISC[32 + (w_ & 31)] * 256 + (w_ >> 5); \
        _Pragma("unroll") for (int j = 0; j < 4; ++j) yn[k][j] = *(const unsigned*)(Y + slot * DM + 4 * F.lane + 256 * j); } \
        _Pragma("unroll") for (int j = 0; j < 4; ++j) xn[j] = *(const u32x2*)(X1B + (size_t)(tok_) * DM + 4 * F.lane + 256 * j); } while (0)
    if (gw < NTOK) { const i32x4 i0 = *(const i32x4*)(TOKE + (size_t)gw * 4); gn = *(const f32x4*)(TOKG + (size_t)gw * 4); FP_ROWS(gw, i0); }
    if (gw + NGW < NTOK) { inn = *(const i32x4*)(TOKE + (size_t)(gw + NGW) * 4); gnn = *(const f32x4*)(TOKG + (size_t)(gw + NGW) * 4); }
    for (int tok = gw; tok < NTOK; tok += NGW) {
        f32x4 v[4];
#pragma unroll
        for (int j = 0; j < 4; ++j) { v[j][0] = DN_ALPHA * bflo(xn[j].x); v[j][1] = DN_ALPHA * bfhi(xn[j].x); v[j][2] = DN_ALPHA * bflo(xn[j].y); v[j][3] = DN_ALPHA * bfhi(xn[j].y); }
#pragma unroll
        for (int k = 0; k < 4; ++k) { const float g = gn[k];
#pragma unroll
            for (int j = 0; j < 4; ++j) { const f32x2 ylo = __builtin_amdgcn_cvt_pk_f32_fp8((int)yn[k][j], false), yhi = __builtin_amdgcn_cvt_pk_f32_fp8((int)yn[k][j], true);
                v[j][0] += g * ylo[0]; v[j][1] += g * ylo[1]; v[j][2] += g * yhi[0]; v[j][3] += g * yhi[1]; } }
        if (tok + NGW < NTOK) { gn = gnn; FP_ROWS(tok + NGW, inn); }
        if (tok + 2 * NGW < NTOK) { inn = *(const i32x4*)(TOKE + (size_t)(tok + 2 * NGW) * 4); gnn = *(const f32x4*)(TOKG + (size_t)(tok + 2 * NGW) * 4); }
        float sum = 0.f;
#pragma unroll
        for (int j = 0; j < 4; ++j) sum += (v[j][0] + v[j][1]) + (v[j][2] + v[j][3]);
        const float mean = wave_sum(sum) * (1.f / DM); float sq = 0.f;
#pragma unroll
        for (int j = 0; j < 4; ++j) { v[j] = v[j] - mean; sq += (v[j][0] * v[j][0] + v[j][1] * v[j][1]) + (v[j][2] * v[j][2] + v[j][3] * v[j][3]); }
        const float rstd = 1.0f / sqrtf(wave_sum(sq) * (1.f / DM) + LN_EPS);
#pragma unroll
        for (int j = 0; j < 4; ++j) { f32x4 o = v[j] * rstd * gv[j] + bv[j];
            if (TS_A >= 0 && blockIdx.x == 0) { const float tus = 0.01f * (float)(F.MISC[121 + (TS_A >= 0 ? TS_A : 0)] - F.MISC[120 + (TS_A >= 0 ? TS_A : 0)]); o = o + sqrtf(256e-6f * tus); }
            if (TS_B >= 0 && blockIdx.x == 0 && tok == gw && F.wave == 0 && F.lane == 0 && j == 0) { const float tus = 0.01f * (float)(F.MISC[121 + (TS_B >= 0 ? TS_B : 0)] - F.MISC[120 + (TS_B >= 0 ? TS_B : 0)]); o[0] += 1.0f + 0.1f * tus; }
            *(f32x4*)(a.out + (size_t)tok * DM + 4 * F.lane + 256 * j) = o; }
    }
#undef FP_ROWS
}

__global__ void __launch_bounds__(512, 2) mega_fwd(Args args) {
    extern __shared__ __attribute__((aligned(16))) unsigned char lds[];
    Frame F;
    F.lds = (LAS unsigned char*)lds;
    F.MISC = (volatile LAS unsigned*)(F.lds + MISC_OFF);
    F.tid = threadIdx.x; F.lane = F.tid & 63; F.wave = __builtin_amdgcn_readfirstlane(F.tid >> 6);
    F.G = gridDim.x; { const int bx = blockIdx.x; F.vcu = (F.G % 8 == 0) ? (bx % 8) * (F.G / 8) + bx / 8 : bx; }
    { GAS unsigned char* wsg = (GAS unsigned char*)args.ws; asm volatile("" : "+s"(wsg)); F.ws = (unsigned char*)wsg; }
    F.ctl = (gu32*)(F.ws + WS_CTL);
    F.bg = false; { const int xg = F.vcu >> 5, lc = F.vcu & 31; F.conv = F.bg && lc >= 32 - NCONVX; F.wc8 = lc * 8 + xg; F.cidx = xg * NCONVX + (lc - (32 - NCONVX)); }
    for (int u = F.tid; u < 256; u += 512) F.MISC[u] = 0u;
    __syncthreads();
    XcdBarrier bar; bar.bar = (unsigned*)(F.ctl + CW_BAR); bar.x = 0; bar.st = nullptr;
    if (N_LAUNCHES != PER_PHASE) bar = xcd_barrier_post((unsigned*)(F.ctl + CW_BAR), F.MISC + 8);
#define GRID_BAR(seam) do { if (N_LAUNCHES == PER_PHASE) { if (F.tid == 0) __hip_atomic_store(F.ctl + CW_TMO, 0xBADBA0u | (unsigned)(seam), RLX_AGENT); } else { xcd_barrier(bar); } } while (0)
#define STAMP(k) do { if (TS_A >= 0 || TS_B >= 0) { if (blockIdx.x == 0 && F.tid == 0) F.MISC[120 + (k)] = (unsigned)__builtin_amdgcn_s_memrealtime(); } } while (0)
    STAMP(0);
    const int lo = args.ph_lo, hi = args.ph_hi;
#define IN(k) (lo <= (k) && (k) < hi)
#define BOTH(k) (IN(k) && IN((k) + 1))
    unsigned char* ws = F.ws;
    bf16_t* XB = (bf16_t*)(ws + WS_XB); bf16_t* Ub = (bf16_t*)(ws + WS_U); bf16_t* Qb = (bf16_t*)(ws + WS_Q); bf16_t* Kb = (bf16_t*)(ws + WS_K); bf16_t* Vb = (bf16_t*)(ws + WS_V);
    bf16_t* Sb = (bf16_t*)(ws + WS_S); bf16_t* OB = (bf16_t*)(ws + WS_OB); float* LSE = (float*)(ws + WS_LSE); bf16_t* AO = (bf16_t*)(ws + WS_AO);
    bf16_t* MIXb = (bf16_t*)(ws + WS_Z); unsigned char* X18 = ws + WS_X1F8; unsigned char* H8 = ws + WS_H; unsigned char* Yb = ws + WS_Y;

    if (IN(0)) { p0_prologue(F, args); if (BOTH(0)) GRID_BAR(0); STAMP(1); }
    if (IN(1)) {
        if (F.G == 256) {
            const int xg = F.vcu >> 5, lc = F.vcu & 31;
            if (lc >= P1_NG) convert_items<1>(F, args, P1_GT, NEXP * 2 * CV_I_E, xg * (32 - P1_NG) + (lc - P1_NG), 8 * (32 - P1_NG));
            else {
                pg8::DenseOrder S; S.init(NTOK, NPROJ, DM, 8 * P1_NG, lc * 8 + xg, ws + WS_WIN);
                pg8::EpiInProj E{Ub, Qb, Kb, Vb, (const float*)(ws + WS_ROPE)};
                pg8::gemm_phase<pg8::EpiInProj, pg8::DenseOrder, true>(F.lds, XB, DM, S, E);
                convert_items<1>(F, args, 0, P1_GT, lc * 8 + xg, 8 * P1_NG);
            }
        } else {
            pg8::DenseOrder S; S.init(NTOK, NPROJ, DM, F.G, (int)blockIdx.x, ws + WS_WIN);
            pg8::EpiInProj E{Ub, Qb, Kb, Vb, (const float*)(ws + WS_ROPE)};
            pg8::gemm_phase<pg8::EpiInProj, pg8::DenseOrder, true>(F.lds, XB, DM, S, E);
        }
        if (BOTH(1)) GRID_BAR(1); STAMP(2);
    }
    if (IN(2)) {
        const int per = F.G / 8, xcd = F.vcu / per, loc = F.vcu % per;
        if (F.bg) {
            if (!F.conv) for (int j = loc; j < 192; j += 32 - NCONVX) { const int bh = 2 * xcd + j / 96, jj = j % 96; att::attn_unit(bh >> 3, bh & 7, jj >> 5, jj & 31, Qb, Kb, Vb, OB, LSE, F.lds); }
        } else if (F.G == 256) {
            att::attn_units(loc, per, xcd, Qb, Kb, Vb, OB, LSE, F.lds);
            __syncthreads();
        } else if (F.G % 8 == 0 && per >= 1) {
            for (int j = loc; j < 192; j += per) { const int bh = 2 * xcd + j / 96, jj = j % 96; att::attn_unit(bh >> 3, bh & 7, jj >> 5, jj & 31, Qb, Kb, Vb, OB, LSE, F.lds); }
        } else {
            for (int j = F.vcu; j < 1536; j += F.G) { const int bh = j / 96, jj = j % 96; att::attn_unit(bh >> 3, bh & 7, jj >> 5, jj & 31, Qb, Kb, Vb, OB, LSE, F.lds); }
        }
        for (int it = F.vcu; it < NTOK / 64; it += F.G)
            conv_item(it, Ub, (const float*)args.in[3], (const float*)args.in[4], (const float*)args.in[5], (const float*)args.in[6], Sb, F.lds, F.wave, F.lane);
        if (F.conv) convert_items(F, args, CV_S1, CV_S2, F.cidx, NCONV);
        if (BOTH(2)) GRID_BAR(2); STAMP(3);
    }
    if (IN(3)) {
        constexpr int NPW = (NTOK / 256) * (DCONV / 256);
        const int wid_ = F.bg ? F.wc8 : (int)blockIdx.x, nw_ = F.bg ? NWORK : (int)F.G;
        if (F.conv) convert_items(F, args, CV_S2, CV_S3, F.cidx, NCONV);
        else {
            if (nw_ > NPW) { if (wid_ >= NPW) { combine_tokens(F, OB, LSE, AO, (wid_ - NPW) * 8 + F.wave, (nw_ - NPW) * 8);
                if (F.G == 256) { __syncthreads(); convert_items<2>(F, args, 0, WD_P3, wid_ - NPW, 128); } } }
            else combine_tokens(F, OB, LSE, AO, wid_ * 8 + F.wave, nw_ * 8);
            pg8::DenseOrder S; S.init(NTOK, DCONV, DCONV, nw_, wid_, ws + WS_WPW);
            pg8::EpiBiasBf16 E{AO, DM, (const float*)args.in[8]};
            pg8::gemm_phase<pg8::EpiBiasBf16, pg8::DenseOrder, true>(F.lds, Sb, DCONV, S, E);
        }
        if (BOTH(3)) GRID_BAR(3); STAMP(4);
    }
    if (IN(4)) {
        pg8::DenseOrder S; S.init(NTOK, DM, DM, F.G, (int)blockIdx.x, ws + WS_WOUT);
        pg8::EpiPlainBf16 E{MIXb, DM};
        pg8::gemm_phase<pg8::EpiPlainBf16, pg8::DenseOrder, true>(F.lds, AO, DM, S, E);
        if (BOTH(4)) GRID_BAR(4); STAMP(5);
    }
    if (IN(5)) { route_phase(F, args); if (BOTH(5)) GRID_BAR(5); STAMP(6); }
    if (IN(6)) {
        const bool dsplit = (F.G == 256);
        moe_prefix(F);
        {
            pg8::MoeOrder S{(const volatile LAS int*)(F.MISC + 32), (const volatile LAS int*)(F.MISC + 80), (const int*)(ws + WS_LIST), (const char*)(ws + WS_WGU), 8, 2048, DM / 2, F.vcu, F.G, F.lds};
            pg8::EpiSwiglu E{H8, (const float*)args.in[15], (const float*)args.in[17], (const volatile LAS int*)(F.MISC + 32), &S};
            S.plan([&](const pg8::Unit& u, int tc) { return E.bias_ptr(u, tc); }, WSCALE8);
            pg8::gemm_phase<pg8::EpiSwiglu, pg8::MoeOrder, true, true>(F.lds, X18, DM / 2, S, E);
        }
        if (dsplit) {
            const int Ltot = (int)F.MISC[64] * 8, CH = (Ltot + 7) >> 3, k = CH & 31, c = F.vcu & 31, V = 64 - k;
            const int v0 = c < k ? c : k + 2 * (c - k);
            convert_items<2>(F, args, WD_P3, NEXP * CV_I_E, (F.vcu >> 5) * V + v0, 8 * V, c < k ? 1 : 2);
        }
        if (BOTH(6)) GRID_BAR(6); STAMP(7);
    }
    if (IN(7)) {
        moe_prefix(F);
        pg8::MoeOrder S{(const volatile LAS int*)(F.MISC + 32), (const volatile LAS int*)(F.MISC + 80), nullptr, (const char*)(ws + WS_WD), 4, 1024, DFF / 2, F.vcu, F.G, F.lds};
        pg8::EpiDown E{Yb, (const float*)args.in[19], (const volatile LAS int*)(F.MISC + 32), &S};
        S.plan([&](const pg8::Unit& u, int tc) { return E.bias_ptr(u, tc); }, WSCALE8);
        pg8::gemm_phase<pg8::EpiDown, pg8::MoeOrder, true, true>(F.lds, H8, DFF / 2, S, E);
        if (BOTH(7)) GRID_BAR(7); STAMP(8);
    }
    if (IN(8)) { moe_prefix(F); final_phase(F, args); }
#undef IN
#undef BOTH
}

extern "C" void kernel_launch(void* const* d_in, const int* in_sizes, int n_in, void* d_out, int out_size, void* d_ws, size_t ws_size, hipStream_t stream) {
    static int grid = 0;
    if (grid == 0) {
        if (n_in != 22 || out_size != NTOK * DM || ws_size < WS_END) { fprintf(stderr, "kernel_launch: unexpected problem (n_in %d out %d ws %zu need %zu)\n", n_in, out_size, ws_size, (size_t)WS_END); grid = -1; return; }
        int dev = 0, cus = 0;
        if (hipGetDevice(&dev) != hipSuccess || hipDeviceGetAttribute(&cus, hipDeviceAttributeMultiprocessorCount, dev) != hipSuccess) { grid = -1; return; }
        if (hipFuncSetAttribute((const void*)mega_fwd, hipFuncAttributeMaxDynamicSharedMemorySize, LDS_BYTES) != hipSuccess) { fprintf(stderr, "kernel_launch: hipFuncSetAttribute failed\n"); grid = -1; return; }
        (void)hipGetLastError();
        grid = cus;
    }
    if (grid < 0) return;
    if (hipMemsetAsync((char*)d_ws + WS_CTL, 0, CTL_ZERO_BYTES, stream) != hipSuccess) return;
    Args a{};
    for (int i = 0; i < 22; ++i) a.in[i] = d_in[i];
    a.out = (float*)d_out; a.ws = (unsigned char*)d_ws;
    for (int li = 0; li < N_LAUNCHES; ++li) {
        a.ph_lo = (N_LAUNCHES == PER_PHASE) ? li : 0; a.ph_hi = (N_LAUNCHES == PER_PHASE) ? li + 1 : PER_PHASE; a.li = li;
        hipLaunchKernelGGL(mega_fwd, dim3(grid), dim3(512), LDS_BYTES, stream, a);
    }
}
```
